# Optimizing an MI355X kernel written in HIP

```python
import math
import jax
import jax.numpy as jnp
from jax import lax
import numpy as np

D_MODEL = 1024
BATCH = 8
SEQ = 4096
DEPTH = 2

GRID_W = 64
CTX_LEN = 256
ATTN_BLOCK = 128
ROPE_BASE = 10000.0
RMS_EPS = 1e-6

DIFF_HEADS = 4
DIFF_HEAD_DIM = 64
NA_HEADS = 8
NA_HEAD_DIM = 64
NA_WIN_ROWS_MAX = 8
NA_WIN_COLS = 16
MLA_HEADS = 8
MLA_Q_RANK = 256
MLA_KV_RANK = 128
MLA_NOPE_DIM = 64
MLA_ROPE_DIM = 32
MLA_V_DIM = 64
RET_HEADS = 4
RET_QK_DIM = 64
RET_V_DIM = 128
RET_CHUNK = 128
N_EXPERTS = 16
EC_CAPACITY_FACTOR = 2
EXPERT_FF = 1024

DIFF_WIDTH = DIFF_HEADS * 2 * DIFF_HEAD_DIM
NA_WIDTH = NA_HEADS * NA_HEAD_DIM
EVEN_IN = 3 * DIFF_WIDTH + 3 * NA_WIDTH
EVEN_OUT = DIFF_WIDTH + NA_WIDTH
MLA_QK_DIM = MLA_NOPE_DIM + MLA_ROPE_DIM
MLA_WIDTH = MLA_HEADS * MLA_V_DIM
RET_QK_WIDTH = RET_HEADS * RET_QK_DIM
RET_V_WIDTH = RET_HEADS * RET_V_DIM
ODD_IN = MLA_Q_RANK + MLA_KV_RANK + MLA_ROPE_DIM + 2 * RET_QK_WIDTH + 2 * RET_V_WIDTH
ODD_OUT = MLA_WIDTH + RET_V_WIDTH
N_EVEN = (DEPTH + 1) // 2
N_ODD = DEPTH // 2

kernel_name = 'hybrid_diffusion_diffattn_natten_mla_retention_ecmoe'


def rms_norm(x, gain=None):
    xf = x.astype(jnp.float32)
    y = xf * lax.rsqrt(jnp.mean(xf * xf, axis=-1, keepdims=True) + RMS_EPS)
    if gain is not None:
        y = y * gain.astype(jnp.float32)
    return y.astype(x.dtype)


def split_cols(p, widths):
    idx, acc = [], 0
    for w in widths[:-1]:
        acc += w
        idx.append(acc)
    return jnp.split(p, idx, axis=-1)


def axial_angles(n_tokens, rot_dim):
    t = jnp.arange(n_tokens)
    rows = (t // GRID_W).astype(jnp.float32)
    cols = (t % GRID_W).astype(jnp.float32)
    m = rot_dim // 4
    freqs = ROPE_BASE ** (-jnp.arange(m, dtype=jnp.float32) / m)
    return rows[:, None] * freqs, cols[:, None] * freqs


def rope_half(x, ang):
    a, b = jnp.split(x, 2, axis=-1)
    cos = jnp.cos(ang).astype(x.dtype)
    sin = jnp.sin(ang).astype(x.dtype)
    return jnp.concatenate([a * cos - b * sin, b * cos + a * sin], axis=-1)


def apply_axial_rope(x, ang_r, ang_c):
    shape = ang_r.shape[:1] + (1,) * (x.ndim - 3) + ang_r.shape[1:]
    xr, xc = jnp.split(x, 2, axis=-1)
    return jnp.concatenate([rope_half(xr, ang_r.reshape(shape)), rope_half(xc, ang_c.reshape(shape))], axis=-1)


def sweep_query_blocks(fn, queries):
    B, L = queries[0].shape[:2]
    nb = L // ATTN_BLOCK
    blocks = tuple(jnp.moveaxis(q.reshape((B, nb, ATTN_BLOCK) + q.shape[2:]), 1, 0) for q in queries)
    out = jnp.moveaxis(lax.map(fn, blocks), 0, 1)
    return out.reshape((B, L) + out.shape[3:])


def softmax_attention(q, k, v, q_rope=None, k_rope=None):
    d = q.shape[-1] + (0 if q_rope is None else q_rope.shape[-1])
    scale = d ** -0.5

    def block(qs):
        s = jnp.einsum('bqhd,bkhd->bhqk', qs[0], k).astype(jnp.float32)
        if q_rope is not None:
            s = s + jnp.einsum('bqhr,bkr->bhqk', qs[1], k_rope).astype(jnp.float32)
        p = jax.nn.softmax(s * scale, axis=-1).astype(v.dtype)
        return jnp.einsum('bhqk,bkhe->bqhe', p, v)

    queries = (q,) if q_rope is None else (q, q_rope)
    return sweep_query_blocks(block, queries)


def diff_attention(q, k, v, lam):
    scale = DIFF_HEAD_DIM ** -0.5

    def block(qs):
        s = jnp.einsum('bqhcd,bkhcd->bhcqk', qs[0], k).astype(jnp.float32) * scale
        p = jax.nn.softmax(s, axis=-1)
        a = p[:, :, 0] - lam * p[:, :, 1]
        return jnp.einsum('bhqk,bkhe->bqhe', a.astype(v.dtype), v)

    return sweep_query_blocks(block, (q,))


def neighbourhood_attention(q, k, v, k_ctx, v_ctx, rpb):
    B, L, H, d = q.shape
    rows = L // GRID_W
    wr = min(NA_WIN_ROWS_MAX, rows)
    wc = NA_WIN_COLS
    scale = d ** -0.5
    qg = q.reshape(B, rows, GRID_W, H, d)
    kg = k.reshape(B, rows, GRID_W, H, d)
    vg = v.reshape(B, rows, GRID_W, H, d)
    cols = jnp.arange(GRID_W)
    col_start = jnp.clip(cols - wc // 2, 0, GRID_W - wc)
    col_idx = col_start[:, None] + jnp.arange(wc)[None, :]
    col_bias = rpb[:, :, col_idx - cols[:, None] + (NA_WIN_COLS - 1)]

    def row_block(r):
        rs = jnp.clip(r - wr // 2, 0, rows - wr)
        q_row = lax.dynamic_index_in_dim(qg, r, axis=1, keepdims=False)
        k_win = lax.dynamic_slice_in_dim(kg, rs, wr, axis=1)[:, :, col_idx]
        v_win = lax.dynamic_slice_in_dim(vg, rs, wr, axis=1)[:, :, col_idx]
        row_off = rs + jnp.arange(wr) - r + (NA_WIN_ROWS_MAX - 1)
        bias = jnp.transpose(jnp.take(col_bias, row_off, axis=1), (0, 2, 1, 3))
        s_loc = jnp.einsum('bqhd,brqwhd->bhqrw', q_row, k_win).astype(jnp.float32) * scale + bias[None].astype(jnp.float32)
        s_ctx = jnp.einsum('bqhd,bkhd->bhqk', q_row, k_ctx).astype(jnp.float32) * scale
        s = jnp.concatenate([s_loc.reshape(B, H, GRID_W, wr * wc), s_ctx], axis=-1)
        p = jax.nn.softmax(s, axis=-1).astype(v.dtype)
        p_loc = p[..., :wr * wc].reshape(B, H, GRID_W, wr, wc)
        p_ctx = p[..., wr * wc:]
        return jnp.einsum('bhqrw,brqwhd->bqhd', p_loc, v_win) + jnp.einsum('bhqk,bkhd->bqhd', p_ctx, v_ctx)

    out = lax.map(row_block, jnp.arange(rows))
    return jnp.moveaxis(out, 0, 1).reshape(B, L, H, d)


def retention_chunkwise(q, k, v, log_gamma, s0, include_diag):
    B, H, L, _ = q.shape
    dv = v.shape[-1]
    C = RET_CHUNK
    n = L // C
    pos = jnp.arange(C, dtype=jnp.float32)
    rel = pos[:, None] - pos[None, :]
    mask = (rel >= 0) if include_diag else (rel > 0)
    decay_in = jnp.where(mask, jnp.exp(log_gamma[:, None, None] * jnp.where(mask, rel, 0.0)), 0.0)
    decay_q = jnp.exp(log_gamma[:, None] * (pos + 1.0))[..., None]
    decay_k = jnp.exp(log_gamma[:, None] * (C - 1.0 - pos))[..., None]
    decay_chunk = jnp.exp(log_gamma * C)[:, None, None]

    def to_chunks(t):
        return jnp.moveaxis(t.reshape(B, H, n, C, t.shape[-1]), 2, 0)

    def step(state, blk):
        qb, kb, vb = blk
        inner = jnp.einsum('bhij,bhjv->bhiv', jnp.einsum('bhid,bhjd->bhij', qb, kb) * decay_in, vb)
        cross = jnp.einsum('bhid,bhdv->bhiv', qb * decay_q, state)
        new_state = decay_chunk * state + jnp.einsum('bhjd,bhjv->bhdv', kb * decay_k, vb)
        return new_state, inner + cross

    _, out = lax.scan(step, s0, (to_chunks(q), to_chunks(k), to_chunks(v)))
    return jnp.moveaxis(out, 0, 2).reshape(B, H, L, dv)


def retention_final_state(k, v, log_gamma):
    L = k.shape[2]
    w = jnp.exp(log_gamma[:, None] * (L - 1.0 - jnp.arange(L, dtype=jnp.float32)))
    return jnp.einsum('hl,bhld,bhlv->bhdv', w, k, v)


def retention_bidir(q, k, v, q_c, k_c, v_c, decay_logit, need_ctx):
    def to_bhld(t):
        return jnp.moveaxis(t, 2, 1).astype(jnp.float32)

    def flip(t):
        return jnp.flip(t, axis=2)

    kscale = RET_QK_DIM ** -0.5
    q, v, q_c, v_c = to_bhld(q), to_bhld(v), to_bhld(q_c), to_bhld(v_c)
    k, k_c = to_bhld(k) * kscale, to_bhld(k_c) * kscale
    log_g = jax.nn.log_sigmoid(decay_logit.astype(jnp.float32))
    lg_f, lg_b = log_g[0], log_g[1]
    s_f = retention_final_state(k_c, v_c, lg_f)
    s_b = retention_final_state(flip(k_c), flip(v_c), lg_b)
    out = retention_chunkwise(q, k, v, lg_f, s_f, True) + flip(retention_chunkwise(flip(q), flip(k), flip(v), lg_b, s_b, False))
    out = jnp.moveaxis(out, 1, 2)
    if not need_ctx:
        return out, None
    zero = jnp.zeros_like(s_f)
    out_c = retention_chunkwise(q_c, k_c, v_c, lg_f, zero, True) + flip(retention_chunkwise(flip(q_c), flip(k_c), flip(v_c), lg_b, zero, False))
    return out, jnp.moveaxis(out_c, 1, 2)


def even_layer(h, hc, w_in, w_out, lam_params, subln, rpb, layer_idx, need_ctx):
    B, L, _ = h.shape
    Lc = hc.shape[1]
    widths = (DIFF_WIDTH,) * 3 + (NA_WIDTH,) * 3
    aq, ak, av, nq, nk, nv = split_cols(h @ w_in, widths)
    aqc, akc, avc, nqc, nkc, nvc = split_cols(hc @ w_in, widths)

    def dh(t):
        return t.reshape(t.shape[:2] + (DIFF_HEADS, 2, DIFF_HEAD_DIM))

    def dvh(t):
        return t.reshape(t.shape[:2] + (DIFF_HEADS, 2 * DIFF_HEAD_DIM))

    def nh(t):
        return t.reshape(t.shape[:2] + (NA_HEADS, NA_HEAD_DIM))

    ang_r, ang_c = axial_angles(L, DIFF_HEAD_DIM)
    lam_init = 0.8 - 0.6 * math.exp(-0.3 * layer_idx)
    lq1, lk1, lq2, lk2 = lam_params
    lam = jnp.exp(jnp.sum(lq1 * lk1)) - jnp.exp(jnp.sum(lq2 * lk2)) + lam_init

    k_all = jnp.concatenate([apply_axial_rope(dh(ak), ang_r, ang_c), dh(akc)], axis=1)
    v_all = jnp.concatenate([dvh(av), dvh(avc)], axis=1)
    a = diff_attention(apply_axial_rope(dh(aq), ang_r, ang_c), k_all, v_all, lam)
    a = (rms_norm(a, subln) * (1.0 - lam_init)).reshape(B, L, DIFF_WIDTH)
    nb = neighbourhood_attention(nh(nq), nh(nk), nh(nv), nh(nkc), nh(nvc), rpb).reshape(B, L, NA_WIDTH)
    y = jnp.concatenate([a, nb], axis=-1) @ w_out
    if not need_ctx:
        return y, None
    ac = diff_attention(dh(aqc), dh(akc), dvh(avc), lam)
    ac = (rms_norm(ac, subln) * (1.0 - lam_init)).reshape(B, Lc, DIFF_WIDTH)
    nc = softmax_attention(nh(nqc), nh(nkc), nh(nvc)).reshape(B, Lc, NA_WIDTH)
    yc = jnp.concatenate([ac, nc], axis=-1) @ w_out
    return y, yc


def odd_layer(h, hc, w_in, w_out, q_norm, w_uq, kv_norm, w_ukv, decay_logit, need_ctx):
    B, L, _ = h.shape
    Lc = hc.shape[1]
    widths = (MLA_Q_RANK, MLA_KV_RANK, MLA_ROPE_DIM, RET_QK_WIDTH, RET_QK_WIDTH, RET_V_WIDTH, RET_V_WIDTH)
    cq, ckv, kr, rq, rk, rv, rg = split_cols(h @ w_in, widths)
    cqc, ckvc, krc, rqc, rkc, rvc, rgc = split_cols(hc @ w_in, widths)

    def mla_up(cq_, ckv_):
        n = cq_.shape[:2]
        qh = (rms_norm(cq_, q_norm) @ w_uq).reshape(n + (MLA_HEADS, MLA_QK_DIM))
        kvh = (rms_norm(ckv_, kv_norm) @ w_ukv).reshape(n + (MLA_HEADS, MLA_NOPE_DIM + MLA_V_DIM))
        return qh[..., :MLA_NOPE_DIM], qh[..., MLA_NOPE_DIM:], kvh[..., :MLA_NOPE_DIM], kvh[..., MLA_NOPE_DIM:]

    def rh(t, d):
        return t.reshape(t.shape[:2] + (RET_HEADS, d))

    qn, qr, kn, vm = mla_up(cq, ckv)
    qnc, qrc, knc, vmc = mla_up(cqc, ckvc)
    ang_r, ang_c = axial_angles(L, MLA_ROPE_DIM)
    k_rope_all = jnp.concatenate([apply_axial_rope(kr, ang_r, ang_c), krc], axis=1)
    m = softmax_attention(qn, jnp.concatenate([kn, knc], axis=1), jnp.concatenate([vm, vmc], axis=1),
                          apply_axial_rope(qr, ang_r, ang_c), k_rope_all).reshape(B, L, MLA_WIDTH)
    r, r_c = retention_bidir(rh(rq, RET_QK_DIM), rh(rk, RET_QK_DIM), rh(rv, RET_V_DIM),
                             rh(rqc, RET_QK_DIM), rh(rkc, RET_QK_DIM), rh(rvc, RET_V_DIM), decay_logit, need_ctx)
    r = rms_norm(r.astype(h.dtype)).reshape(B, L, RET_V_WIDTH) * jax.nn.silu(rg)
    y = jnp.concatenate([m, r], axis=-1) @ w_out
    if not need_ctx:
        return y, None
    mc = softmax_attention(qnc, knc, vmc, qrc, krc).reshape(B, Lc, MLA_WIDTH)
    rc = rms_norm(r_c.astype(hc.dtype)).reshape(B, Lc, RET_V_WIDTH) * jax.nn.silu(rgc)
    yc = jnp.concatenate([mc, rc], axis=-1) @ w_out
    return y, yc


def expert_choice_ffn(h, w_router, w1, w3, w2):
    B, T, _ = h.shape
    cap = (EC_CAPACITY_FACTOR * T) // N_EXPERTS
    aff = jax.nn.softmax((h @ w_router).astype(jnp.float32), axis=-1)
    gate, idx = lax.top_k(jnp.swapaxes(aff, 1, 2), cap)
    bidx = jnp.arange(B)[:, None, None]
    xe = h[bidx, idx]
    hid = jax.nn.silu(jnp.einsum('becd,edf->becf', xe, w1)) * jnp.einsum('becd,edf->becf', xe, w3)
    ye = jnp.einsum('becf,efd->becd', hid, w2) * gate[..., None].astype(h.dtype)
    return jnp.zeros_like(h).at[bidx, idx].add(ye)


def setup_inputs(seed: int = 0) -> dict:
    key = jax.random.key(seed)
    ks = jax.random.split(key, 25)
    f32 = jnp.float32

    def nrm(k, shape, scale):
        return jax.random.normal(k, shape, f32) * scale

    def gain(k, shape):
        return 1.0 + 0.02 * jax.random.normal(k, shape, f32)

    decay_init = jnp.log(2.0 ** (5.0 + jnp.arange(RET_HEADS, dtype=f32)) - 1.0)
    return {
        'x': nrm(ks[0], (BATCH, SEQ, D_MODEL), 1.0),
        'c': nrm(ks[1], (BATCH, D_MODEL), 1.0),
        'ctx': nrm(ks[2], (BATCH, CTX_LEN, D_MODEL), 1.0),
        'c_ctx': nrm(ks[3], (D_MODEL,), 1.0),
        'ada_w': nrm(ks[4], (DEPTH, D_MODEL, 6 * D_MODEL), 0.5 * D_MODEL ** -0.5),
        'ada_b': nrm(ks[5], (DEPTH, 6 * D_MODEL), 0.01),
        'norm_mix': gain(ks[6], (DEPTH, D_MODEL)),
        'norm_ffn': gain(ks[7], (DEPTH, D_MODEL)),
        'final_norm': gain(ks[8], (D_MODEL,)),
        'even_w_in': nrm(ks[9], (N_EVEN, D_MODEL, EVEN_IN), D_MODEL ** -0.5),
        'even_w_out': nrm(ks[10], (N_EVEN, EVEN_OUT, D_MODEL), EVEN_OUT ** -0.5),
        'diff_lambda': nrm(ks[11], (N_EVEN, 4, DIFF_HEAD_DIM), 0.1),
        'diff_subln': gain(ks[12], (N_EVEN, 2 * DIFF_HEAD_DIM)),
        'na_rpb': nrm(ks[13], (N_EVEN, NA_HEADS, 2 * NA_WIN_ROWS_MAX - 1, 2 * NA_WIN_COLS - 1), 0.02),
        'odd_w_in': nrm(ks[14], (N_ODD, D_MODEL, ODD_IN), D_MODEL ** -0.5),
        'odd_w_out': nrm(ks[15], (N_ODD, ODD_OUT, D_MODEL), ODD_OUT ** -0.5),
        'mla_q_norm': gain(ks[16], (N_ODD, MLA_Q_RANK)),
        'mla_w_uq': nrm(ks[17], (N_ODD, MLA_Q_RANK, MLA_HEADS * MLA_QK_DIM), MLA_Q_RANK ** -0.5),
        'mla_kv_norm': gain(ks[18], (N_ODD, MLA_KV_RANK)),
        'mla_w_ukv': nrm(ks[19], (N_ODD, MLA_KV_RANK, MLA_HEADS * (MLA_NOPE_DIM + MLA_V_DIM)), MLA_KV_RANK ** -0.5),
        'ret_decay_logit': jnp.broadcast_to(decay_init, (N_ODD, 2, RET_HEADS)) + nrm(ks[20], (N_ODD, 2, RET_HEADS), 0.05),
        'moe_router': nrm(ks[21], (DEPTH, D_MODEL, N_EXPERTS), D_MODEL ** -0.5),
        'moe_w1': nrm(ks[22], (DEPTH, N_EXPERTS, D_MODEL, EXPERT_FF), D_MODEL ** -0.5),
        'moe_w3': nrm(ks[23], (DEPTH, N_EXPERTS, D_MODEL, EXPERT_FF), D_MODEL ** -0.5),
        'moe_w2': nrm(ks[24], (DEPTH, N_EXPERTS, EXPERT_FF, D_MODEL), EXPERT_FF ** -0.5),
    }


def reference(x, c, ctx, c_ctx, ada_w, ada_b, norm_mix, norm_ffn, final_norm, even_w_in, even_w_out,
              diff_lambda, diff_subln, na_rpb, odd_w_in, odd_w_out, mla_q_norm, mla_w_uq, mla_kv_norm,
              mla_w_ukv, ret_decay_logit, moe_router, moe_w1, moe_w3, moe_w2):
    xc = ctx
    silu_c = jax.nn.silu(c)
    silu_cc = jax.nn.silu(c_ctx)
    for l in range(DEPTH):
        need_ctx = l < DEPTH - 1
        mods = jnp.split(silu_c @ ada_w[l] + ada_b[l], 6, axis=-1)
        sh1, sc1, g1, sh2, sc2, g2 = [m[:, None, :] for m in mods]
        sh1c, sc1c, g1c, sh2c, sc2c, g2c = jnp.split(silu_cc @ ada_w[l] + ada_b[l], 6, axis=-1)
        h = rms_norm(x, norm_mix[l]) * (1.0 + sc1) + sh1
        hc = rms_norm(xc, norm_mix[l]) * (1.0 + sc1c) + sh1c
        i = l // 2
        if l % 2 == 0:
            y, yc = even_layer(h, hc, even_w_in[i], even_w_out[i], diff_lambda[i], diff_subln[i], na_rpb[i], l, need_ctx)
        else:
            y, yc = odd_layer(h, hc, odd_w_in[i], odd_w_out[i], mla_q_norm[i], mla_w_uq[i], mla_kv_norm[i],
                              mla_w_ukv[i], ret_decay_logit[i], need_ctx)
        x = x + g1 * y
        h2 = rms_norm(x, norm_ffn[l]) * (1.0 + sc2) + sh2
        x = x + g2 * expert_choice_ffn(h2, moe_router[l], moe_w1[l], moe_w3[l], moe_w2[l])
        if need_ctx:
            xc = xc + g1c * yc
            hc2 = rms_norm(xc, norm_ffn[l]) * (1.0 + sc2c) + sh2c
            xc = xc + g2c * expert_choice_ffn(hc2, moe_router[l], moe_w1[l], moe_w3[l], moe_w2[l])
    return rms_norm(x, final_norm)
```

```cpp
#include <hip/hip_runtime.h>
#include <hip/hip_cooperative_groups.h>
#include <cstdio>
#include <cstdint>
namespace cg = cooperative_groups;

#define LAS __attribute__((address_space(3)))
typedef unsigned short bf16_t;
typedef short bf16x8 __attribute__((ext_vector_type(8)));
typedef short s16x4 __attribute__((ext_vector_type(4)));
typedef float f32x4 __attribute__((ext_vector_type(4)));
typedef float f32x16 __attribute__((ext_vector_type(16)));
typedef unsigned u32x4 __attribute__((ext_vector_type(4)));
typedef unsigned u32x2 __attribute__((ext_vector_type(2)));

constexpr int NTHREADS = 512;
constexpr int LDS_BYTES = 147456;
constexpr int LDS_CTL_OFF = 147456 - 64;

constexpr int NB = 8, SEQ = 4096, LC = 256, DM = 1024;
constexpr int M_LAT = NB * SEQ, M_CTX = NB * LC, M_ALL = M_LAT + M_CTX;
constexpr int EVEN_IN = 3072, ODD_IN = 1952;
constexpr float RMS_EPS = 1e-6f;
constexpr float LOG2E = 1.4426950408889634f;

constexpr size_t MiB = 1u << 20;
constexpr size_t WS_CTL = 0;
constexpr size_t WS_MODS = 1 * MiB;
constexpr size_t WS_ROPE16 = 1 * MiB + 512 * 1024;
constexpr size_t WS_ROPE8 = WS_ROPE16 + 8192;
constexpr size_t WS_MISC = WS_ROPE8 + 4096;
constexpr size_t WS_PARTQ = 2 * MiB;
constexpr size_t WS_PARTKV = 3 * MiB;
constexpr size_t WS_AFF_LAT = 4 * MiB;
constexpr size_t WS_AFF_CTX = 6 * MiB;
constexpr size_t WS_IDX = 7 * MiB;
constexpr size_t WS_GATE = 7 * MiB + 512 * 1024;
constexpr size_t WS_INV = 8 * MiB;
constexpr size_t WS_XC = 11 * MiB;
constexpr size_t WS_W_EIN = 20 * MiB;
constexpr size_t WS_W_EOUT = 26 * MiB;
constexpr size_t WS_W_OIN = 28 * MiB;
constexpr size_t WS_W_OOUT = 32 * MiB;
constexpr size_t WS_W_UQ = 34 * MiB;
constexpr size_t WS_W_UKV = 34 * MiB + 512 * 1024;
constexpr size_t WS_W13 = 36 * MiB;
constexpr size_t WS_W2T = 100 * MiB;
constexpr size_t WS_H = 132 * MiB;
constexpr size_t WS_BIG = 200 * MiB;
constexpr size_t WS_ATT = 404 * MiB;
constexpr size_t WS_RET = 472 * MiB;
constexpr size_t WS_END = 540 * MiB;
constexpr size_t WS_PROJ = WS_BIG;
constexpr size_t WS_KVM = WS_BIG + 130 * MiB;
constexpr size_t WS_KR = WS_BIG + 198 * MiB;
constexpr size_t WS_QM = WS_H;
constexpr size_t WS_XE = WS_BIG;
constexpr size_t WS_HID = WS_BIG + 136 * MiB;
constexpr size_t WS_Y = WS_XE;
static_assert((size_t)M_ALL * 1952 * 2 <= 130 * MiB, "PROJ fits");
static_assert(WS_HID + (size_t)16 * 4352 * 1024 * 2 <= WS_RET, "HID fits");

enum { I_X = 0, I_C, I_CTX, I_CCTX, I_ADAW, I_ADAB, I_NMIX, I_NFFN, I_FNORM, I_EWIN, I_EWOUT, I_DLAM, I_SUBLN, I_RPB, I_OWIN, I_OWOUT,
       I_QNORM, I_WUQ, I_KVNORM, I_WUKV, I_DECAY, I_ROUTER, I_W1, I_W3, I_W2 };

struct Params {
    const float* in[25];
    float* out;
    unsigned char* ws;
    unsigned long long pad;
};

__device__ __forceinline__ int opaque_tid() { int t = threadIdx.x; asm volatile("" : "+v"(t)); return t; }
__device__ __forceinline__ unsigned f2bf(float f) { unsigned u = __builtin_bit_cast(unsigned, f); return (u + 0x7fffu + ((u >> 16) & 1u)) >> 16; }
__device__ __forceinline__ unsigned pk2(float lo, float hi) { return f2bf(lo) | (f2bf(hi) << 16); }
__device__ __forceinline__ unsigned cvtpk(float lo, float hi) { unsigned r; asm volatile("v_cvt_pk_bf16_f32 %0, %1, %2" : "=v"(r) : "v"(lo), "v"(hi)); return r; }
__device__ __forceinline__ float bf_lo(unsigned w) { return __uint_as_float(w << 16); }
__device__ __forceinline__ float bf_hi(unsigned w) { return __uint_as_float(w & 0xffff0000u); }
__device__ __forceinline__ float bf2f(bf16_t x) { return __uint_as_float(((unsigned)x) << 16); }
__device__ __forceinline__ float wave_sum(float v) {
#pragma unroll
    for (int o = 1; o < 64; o <<= 1) v += __shfl_xor(v, o);
    return v;
}
__device__ __forceinline__ float silu_f(float v) { return v / (1.0f + __expf(-v)); }
__device__ __forceinline__ int crow(int r, int hi) { return (r & 3) + 8 * (r >> 2) + 4 * hi; }
__device__ __forceinline__ int sigma32(int p) { return (p < 8 || p >= 24) ? p : (p < 16 ? p + 8 : p - 8); }

#define XB_TMO      128
#define XB_XCNT(j)  (256  + 64 * (j))
#define XB_XSUB(j)  (1280 + 64 * (j))
#define XB_XGEN(j)  (2304 + 64 * (j))
#define XB_TOP      3328
#define XB_TOPGEN   3392
#define XCD_BAR_WORDS 3456
#define XB_SPIN_CAP (1u << 21)
__device__ __forceinline__ unsigned xb_ld(unsigned* p)              { return __hip_atomic_load(p, __ATOMIC_RELAXED, __HIP_MEMORY_SCOPE_AGENT); }
__device__ __forceinline__ unsigned xb_add(unsigned* p, unsigned v) { return __hip_atomic_fetch_add(p, v, __ATOMIC_RELAXED, __HIP_MEMORY_SCOPE_AGENT); }
__device__ __forceinline__ unsigned xb_xcc_id() { return (unsigned)__builtin_amdgcn_s_getreg((3 << 11) | 20) & 0xFu; }
#define XB_SPIN(cond, bar) do { unsigned _sp = 0; while (cond) { __builtin_amdgcn_s_sleep(1); \
    if ((++_sp & 255u) == 0u) { if (xb_ld(&(bar)[XB_TMO])) break; if (_sp > XB_SPIN_CAP) { atomicAdd(&(bar)[XB_TMO], 1u); break; } } } } while (0)
struct XcdBarrier { unsigned* bar; unsigned x; volatile LAS unsigned* st; };
__device__ __forceinline__ XcdBarrier xcd_barrier_post(unsigned* bar, volatile LAS unsigned* st) {
    XcdBarrier b; b.bar = bar; b.x = xb_xcc_id(); b.st = st;
    if (threadIdx.x == 0) (void)xb_add(&bar[XB_XCNT(b.x)], 1u);
    return b;
}
__device__ __forceinline__ void xcd_barrier_complete(unsigned* bar, unsigned x, unsigned& nloc, unsigned& nx) {
    const unsigned G = gridDim.x * gridDim.y * gridDim.z;
    unsigned sum, cnt, mine, sp = 0u;
    for (;;) {
        sum = 0u; cnt = 0u; mine = 0u;
#pragma unroll
        for (unsigned j = 0; j < 16; ++j) { const unsigned c = xb_ld(&bar[XB_XCNT(j)]); sum += c; cnt += (c > 0u) ? 1u : 0u; mine = (j == x) ? c : mine; }
        if (sum == G) break;
        __builtin_amdgcn_s_sleep(1);
        if ((++sp & 255u) == 0u) { if (xb_ld(&bar[XB_TMO])) break; if (sp > XB_SPIN_CAP) { atomicAdd(&bar[XB_TMO], 1u); break; } }
    }
    nloc = mine > 0u ? mine : 1u; nx = cnt > 0u ? cnt : 1u;
}
__device__ __forceinline__ void xcd_barrier(const XcdBarrier& b) {
    asm volatile("s_waitcnt vmcnt(0)" ::: "memory");
    __syncthreads();
    if (threadIdx.x == 0) {
        unsigned* bar = b.bar;
        __builtin_amdgcn_s_waitcnt(0);
        unsigned nloc = b.st[0], nx = b.st[1];
        if (nloc == 0u) { xcd_barrier_complete(bar, b.x, nloc, nx); b.st[0] = nloc; b.st[1] = nx; }
        const unsigned old = xb_add(&bar[XB_XSUB(b.x)], 1u);
        const unsigned gen = old / nloc;
        if (old + 1u == (gen + 1u) * nloc) {
            __builtin_amdgcn_fence(__ATOMIC_RELEASE, "agent");
            asm volatile("s_waitcnt vmcnt(0)" ::: "memory");
            const unsigned og = xb_add(&bar[XB_TOP], 1u);
            const unsigned tg = og / nx;
            if (og + 1u == (tg + 1u) * nx) xb_add(&bar[XB_TOPGEN], 1u);
            else XB_SPIN(xb_ld(&bar[XB_TOPGEN]) == tg, bar);
            __builtin_amdgcn_fence(__ATOMIC_ACQUIRE, "agent");
            xb_add(&bar[XB_XGEN(b.x)], 1u);
            asm volatile("s_waitcnt vmcnt(0)" ::: "memory");
        } else {
            XB_SPIN(xb_ld(&bar[XB_XGEN(b.x)]) == gen, bar);
            __builtin_amdgcn_fence(__ATOMIC_ACQUIRE, "agent");
            asm volatile("s_waitcnt vmcnt(0)" ::: "memory");
        }
    }
    __syncthreads();
}

__device__ __forceinline__ int maprow(int n, int mode) {
    if (mode == 1) return (n >> 7) * 256 + (n & 127);
    if (mode == 2) return (n >> 7) * 256 + 128 + (n & 127);
    if (mode == 3) return (n >= 384 && n < 416) ? 384 + sigma32(n - 384) : n;
    if (mode == 4) { const int h = n / 96, j = n - h * 96; return (j >= 64) ? h * 96 + 64 + sigma32(j - 64) : n; }
    return n;
}
__device__ __forceinline__ void transpose_tile(const float* __restrict__ src, int ldsrc, int Nvalid, int k0, int n0,
                                               bf16_t* __restrict__ dst, int lddst, int mode, const float* __restrict__ kscale, LAS float* tile, int tid) {
#pragma unroll
    for (int i = 0; i < 2; ++i) {
        const int k = (tid >> 4) + 32 * i, n4 = (tid & 15) * 4;
        f32x4 v = {0.f, 0.f, 0.f, 0.f};
        if (n0 + n4 < Nvalid) v = *(const f32x4*)(src + (size_t)(k0 + k) * ldsrc + n0 + n4);
        if (kscale) { const float s = kscale[k0 + k]; v = v * s; }
        LAS float* t = tile + k * 65 + n4;
        t[0] = v[0]; t[1] = v[1]; t[2] = v[2]; t[3] = v[3];
    }
    __syncthreads();
    {
        const int n = tid >> 3, kc = (tid & 7) * 8;
        if (n0 + n < Nvalid) {
            const LAS float* t = tile + kc * 65 + n;
            u32x4 w;
            w.x = pk2(t[0 * 65], t[1 * 65]); w.y = pk2(t[2 * 65], t[3 * 65]); w.z = pk2(t[4 * 65], t[5 * 65]); w.w = pk2(t[6 * 65], t[7 * 65]);
            *(u32x4*)(dst + (size_t)maprow(n0 + n, mode) * lddst + k0 + kc) = w;
        }
    }
    __syncthreads();
}
constexpr int SMALL_TILES = 768 + 256 + 496 + 256 + 48 + 32;
__device__ __forceinline__ void convert_small_item(const Params& P, int idx, LAS float* tile, int tid) {
    unsigned char* ws = P.ws;
    if (idx < 768) { transpose_tile(P.in[I_EWIN], 3072, 3072, (idx / 48) * 64, (idx % 48) * 64, (bf16_t*)(ws + WS_W_EIN), 1024, 0, nullptr, tile, tid); return; } idx -= 768;
    if (idx < 256) { transpose_tile(P.in[I_EWOUT], 1024, 1024, (idx / 16) * 64, (idx % 16) * 64, (bf16_t*)(ws + WS_W_EOUT), 1024, 0, nullptr, tile, tid); return; } idx -= 256;
    if (idx < 496) { transpose_tile(P.in[I_OWIN], 1952, 1952, (idx / 31) * 64, (idx % 31) * 64, (bf16_t*)(ws + WS_W_OIN), 1024, 3, nullptr, tile, tid); return; } idx -= 496;
    if (idx < 256) { transpose_tile(P.in[I_OWOUT], 1024, 1024, (idx / 16) * 64, (idx % 16) * 64, (bf16_t*)(ws + WS_W_OOUT), 1024, 0, nullptr, tile, tid); return; } idx -= 256;
    if (idx < 48) { transpose_tile(P.in[I_WUQ], 768, 768, (idx / 12) * 64, (idx % 12) * 64, (bf16_t*)(ws + WS_W_UQ), 256, 4, P.in[I_QNORM], tile, tid); return; } idx -= 48;
    transpose_tile(P.in[I_WUKV], 1024, 1024, (idx / 16) * 64, (idx % 16) * 64, (bf16_t*)(ws + WS_W_UKV), 128, 0, P.in[I_KVNORM], tile, tid);
}
constexpr int MOE_TILES = 16 * 3 * 256;
__device__ __forceinline__ void convert_moe_item(const Params& P, int layer, int idx, LAS float* tile, int tid) {
    const int e = idx / 768, r = idx - e * 768, which = r >> 8, t = r & 255, k0 = (t >> 4) * 64, n0 = (t & 15) * 64;
    const size_t moff = ((size_t)layer * 16 + e) * 1024 * 1024;
    if (which == 0) transpose_tile(P.in[I_W1] + moff, 1024, 1024, k0, n0, (bf16_t*)(P.ws + WS_W13) + (size_t)e * 2048 * 1024, 1024, 1, nullptr, tile, tid);
    else if (which == 1) transpose_tile(P.in[I_W3] + moff, 1024, 1024, k0, n0, (bf16_t*)(P.ws + WS_W13) + (size_t)e * 2048 * 1024, 1024, 2, nullptr, tile, tid);
    else transpose_tile(P.in[I_W2] + moff, 1024, 1024, k0, n0, (bf16_t*)(P.ws + WS_W2T) + (size_t)e * 1024 * 1024, 1024, 0, nullptr, tile, tid);
}
__device__ __forceinline__ void mods_item(const Params& P, int item, LAS float* S, LAS float* red, int tid) {
    const int l = item / 96, n0 = (item % 96) * 64;
    for (int i = tid; i < 9 * 1024; i += NTHREADS) { const int r = i >> 10, k = i & 1023; const float v = (r < 8) ? P.in[I_C][r * 1024 + k] : P.in[I_CCTX][k]; S[i] = v / (1.0f + expf(-v)); }
    __syncthreads();
    const int kk = tid >> 6, col = tid & 63;
    float acc[9];
#pragma unroll
    for (int r = 0; r < 9; ++r) acc[r] = 0.f;
    const float* w = P.in[I_ADAW] + (size_t)l * 1024 * 6144 + n0 + col;
#pragma unroll 4
    for (int k = kk; k < 1024; k += 8) { const float wv = w[(size_t)k * 6144];
#pragma unroll
        for (int r = 0; r < 9; ++r) acc[r] += S[r * 1024 + k] * wv; }
#pragma unroll
    for (int r = 0; r < 9; ++r) red[(kk * 9 + r) * 64 + col] = acc[r];
    __syncthreads();
    float* mods = (float*)(P.ws + WS_MODS);
    for (int i = tid; i < 9 * 64; i += NTHREADS) { const int r = i >> 6, c = i & 63; float s = 0.f;
#pragma unroll
        for (int q = 0; q < 8; ++q) s += red[(q * 9 + r) * 64 + c];
        mods[(size_t)(l * 9 + r) * 6144 + n0 + c] = s + P.in[I_ADAB][l * 6144 + n0 + c]; }
    __syncthreads();
}
__device__ __forceinline__ void tables_item(const Params& P, int tid) {
    float* r16 = (float*)(P.ws + WS_ROPE16); float* r8 = (float*)(P.ws + WS_ROPE8); float* misc = (float*)(P.ws + WS_MISC);
    for (int i = tid; i < 64 * 16; i += NTHREADS) { const int pos = i >> 4, f = i & 15; const float fr = exp2f(-(float)f * (13.287712379549449f / 16.0f)); const float ang = (float)pos * fr;
        r16[2 * i] = cosf(ang); r16[2 * i + 1] = sinf(ang); }
    for (int i = tid; i < 64 * 8; i += NTHREADS) { const int pos = i >> 3, f = i & 7; const float fr = exp2f(-(float)f * (13.287712379549449f / 8.0f)); const float ang = (float)pos * fr;
        r8[2 * i] = cosf(ang); r8[2 * i + 1] = sinf(ang); }
    if (tid == 0) { const float* dl = P.in[I_DLAM]; float s1 = 0.f, s2 = 0.f;
        for (int i = 0; i < 64; ++i) { s1 += dl[i] * dl[64 + i]; s2 += dl[128 + i] * dl[192 + i]; }
        misc[0] = expf(s1) - expf(s2) + 0.2f; }
    if (tid >= 64 && tid < 72) { const float x = P.in[I_DECAY][tid - 64]; const float lg = -log1pf(expf(-x)); misc[8 + tid - 64] = lg * 1.4426950408889634f; }
}

struct Row16 { float v[16]; };
__device__ __forceinline__ Row16 ld_row_f32(const float* p, int lane) {
    Row16 r; const f32x4 a = *(const f32x4*)(p + lane * 8), b = *(const f32x4*)(p + lane * 8 + 4), c = *(const f32x4*)(p + 512 + lane * 8), d = *(const f32x4*)(p + 512 + lane * 8 + 4);
#pragma unroll
    for (int j = 0; j < 4; ++j) { r.v[j] = a[j]; r.v[4 + j] = b[j]; r.v[8 + j] = c[j]; r.v[12 + j] = d[j]; }
    return r;
}
__device__ __forceinline__ void st_row_f32(float* p, int lane, const Row16& r) {
    *(f32x4*)(p + lane * 8) = (f32x4){r.v[0], r.v[1], r.v[2], r.v[3]}; *(f32x4*)(p + lane * 8 + 4) = (f32x4){r.v[4], r.v[5], r.v[6], r.v[7]};
    *(f32x4*)(p + 512 + lane * 8) = (f32x4){r.v[8], r.v[9], r.v[10], r.v[11]}; *(f32x4*)(p + 512 + lane * 8 + 4) = (f32x4){r.v[12], r.v[13], r.v[14], r.v[15]};
}
__device__ __forceinline__ void st_row_bf16(bf16_t* p, int lane, const Row16& r) {
    u32x4 a, b; a.x = pk2(r.v[0], r.v[1]); a.y = pk2(r.v[2], r.v[3]); a.z = pk2(r.v[4], r.v[5]); a.w = pk2(r.v[6], r.v[7]);
    b.x = pk2(r.v[8], r.v[9]); b.y = pk2(r.v[10], r.v[11]); b.z = pk2(r.v[12], r.v[13]); b.w = pk2(r.v[14], r.v[15]);
    *(u32x4*)(p + lane * 8) = a; *(u32x4*)(p + 512 + lane * 8) = b;
}
__device__ __forceinline__ void add_row_bf16(Row16& r, const bf16_t* p, int lane, float s) {
    const u32x4 a = *(const u32x4*)(p + lane * 8), b = *(const u32x4*)(p + 512 + lane * 8);
    r.v[0] += s * bf_lo(a.x); r.v[1] += s * bf_hi(a.x); r.v[2] += s * bf_lo(a.y); r.v[3] += s * bf_hi(a.y);
    r.v[4] += s * bf_lo(a.z); r.v[5] += s * bf_hi(a.z); r.v[6] += s * bf_lo(a.w); r.v[7] += s * bf_hi(a.w);
    r.v[8] += s * bf_lo(b.x); r.v[9] += s * bf_hi(b.x); r.v[10] += s * bf_lo(b.y); r.v[11] += s * bf_hi(b.y);
    r.v[12] += s * bf_lo(b.z); r.v[13] += s * bf_hi(b.z); r.v[14] += s * bf_lo(b.w); r.v[15] += s * bf_hi(b.w);
}
__device__ __forceinline__ float row_rstd(const Row16& r) {
    float ss = 0.f;
#pragma unroll
    for (int j = 0; j < 16; ++j) ss += r.v[j] * r.v[j];
    ss = wave_sum(ss);
    return rsqrtf(ss * (1.0f / 1024.0f) + RMS_EPS);
}
__device__ __forceinline__ Row16 moe_combine(const Params& P, int row, int slots_per_e, int lane) {
    Row16 c;
#pragma unroll
    for (int j = 0; j < 16; ++j) c.v[j] = 0.f;
    const int* inv = (const int*)(P.ws + WS_INV) + (size_t)row * 16;
    const int mine = (lane < 16) ? inv[lane] : -1;
    const bf16_t* Y = (const bf16_t*)(P.ws + WS_Y);
    for (int e = 0; e < 16; ++e) {
        const int slot = __shfl(mine, e);
        if (slot >= 0) add_row_bf16(c, Y + ((size_t)e * slots_per_e + slot) * 1024, lane, 1.0f);
    }
    return c;
}
__device__ __forceinline__ void phase_norm1(const Params& P, int layer) {
    const int tid = opaque_tid(), wid = tid >> 6, lane = tid & 63;
    const int gw = blockIdx.x * 8 + wid, nw = gridDim.x * 8;
    const float* mods = (const float*)(P.ws + WS_MODS);
    bf16_t* H = (bf16_t*)(P.ws + WS_H);
    const Row16 gain = ld_row_f32(P.in[I_NMIX] + layer * 1024, lane);
    for (int row = gw; row < M_ALL; row += nw) {
        const bool lat = row < M_LAT; const int r9 = lat ? (row >> 12) : 8;
        Row16 x;
        if (layer == 0) x = ld_row_f32(lat ? P.in[I_X] + (size_t)row * 1024 : P.in[I_CTX] + (size_t)(row - M_LAT) * 1024, lane);
        else {
            float* xp = lat ? P.out + (size_t)row * 1024 : (float*)(P.ws + WS_XC) + (size_t)(row - M_LAT) * 1024;
            x = ld_row_f32(xp, lane);
            const Row16 cmb = moe_combine(P, row, 4352, lane);
            const Row16 g2 = ld_row_f32(mods + (size_t)(0 * 9 + r9) * 6144 + 5120, lane);
#pragma unroll
            for (int j = 0; j < 16; ++j) x.v[j] += g2.v[j] * cmb.v[j];
            st_row_f32(xp, lane, x);
        }
        const float rs = row_rstd(x);
        const Row16 sh = ld_row_f32(mods + (size_t)(layer * 9 + r9) * 6144 + 0, lane), sc = ld_row_f32(mods + (size_t)(layer * 9 + r9) * 6144 + 1024, lane);
        Row16 h;
#pragma unroll
        for (int j = 0; j < 16; ++j) h.v[j] = x.v[j] * rs * gain.v[j] * (1.0f + sc.v[j]) + sh.v[j];
        st_row_bf16(H + (size_t)row * 1024, lane, h);
    }
}
__device__ __forceinline__ void phase_final(const Params& P) {
    const int tid = opaque_tid(), wid = tid >> 6, lane = tid & 63;
    const int gw = blockIdx.x * 8 + wid, nw = gridDim.x * 8;
    const float* mods = (const float*)(P.ws + WS_MODS);
    const Row16 gain = ld_row_f32(P.in[I_FNORM], lane);
    for (int row = gw; row < M_LAT; row += nw) {
        float* xp = P.out + (size_t)row * 1024;
        Row16 x = ld_row_f32(xp, lane);
        const Row16 cmb = moe_combine(P, row, 4096, lane);
        const Row16 g2 = ld_row_f32(mods + (size_t)(1 * 9 + (row >> 12)) * 6144 + 5120, lane);
#pragma unroll
        for (int j = 0; j < 16; ++j) x.v[j] += g2.v[j] * cmb.v[j];
        const float rs = row_rstd(x);
#pragma unroll
        for (int j = 0; j < 16; ++j) x.v[j] = x.v[j] * rs * gain.v[j];
        st_row_f32(xp, lane, x);
    }
}
__device__ __forceinline__ int wr_off(int c) { return c * 20; }
__device__ __forceinline__ void phase_norm2(const Params& P, int layer, LAS unsigned char* lds) {
    const int tid = opaque_tid(), wid = tid >> 6, lane = tid & 63;
    const int gw = blockIdx.x * 8 + wid, nw = gridDim.x * 8;
    LAS float* wr = (LAS float*)lds;
    LAS float* hs = (LAS float*)(lds + 81920) + wid * 1024;
    const float* wsrc = P.in[I_ROUTER] + (size_t)layer * 1024 * 16;
    for (int i = tid; i < 1024 * 4; i += NTHREADS) { const int c = i >> 2, q = i & 3; const f32x4 v = *(const f32x4*)(wsrc + c * 16 + q * 4); *(LAS f32x4*)(wr + wr_off(c) + q * 4) = v; }
    __syncthreads();
    const float* mods = (const float*)(P.ws + WS_MODS);
    bf16_t* H = (bf16_t*)(P.ws + WS_H);
    const Row16 gain = ld_row_f32(P.in[I_NFFN] + layer * 1024, lane);
    const int nrows = (layer == 0) ? M_ALL : M_LAT;
    for (int row = gw; row < nrows; row += nw) {
        const bool lat = row < M_LAT; const int r9 = lat ? (row >> 12) : 8;
        const float* xp = lat ? P.out + (size_t)row * 1024 : (const float*)(P.ws + WS_XC) + (size_t)(row - M_LAT) * 1024;
        const Row16 x = ld_row_f32(xp, lane);
        const float rs = row_rstd(x);
        const Row16 sh = ld_row_f32(mods + (size_t)(layer * 9 + r9) * 6144 + 3072, lane), sc = ld_row_f32(mods + (size_t)(layer * 9 + r9) * 6144 + 4096, lane);
        Row16 h;
#pragma unroll
        for (int j = 0; j < 16; ++j) h.v[j] = x.v[j] * rs * gain.v[j] * (1.0f + sc.v[j]) + sh.v[j];
        st_row_bf16(H + (size_t)row * 1024, lane, h);
        *(LAS f32x4*)(hs + lane * 8) = (f32x4){h.v[0], h.v[1], h.v[2], h.v[3]}; *(LAS f32x4*)(hs + lane * 8 + 4) = (f32x4){h.v[4], h.v[5], h.v[6], h.v[7]};
        *(LAS f32x4*)(hs + 512 + lane * 8) = (f32x4){h.v[8], h.v[9], h.v[10], h.v[11]}; *(LAS f32x4*)(hs + 512 + lane * 8 + 4) = (f32x4){h.v[12], h.v[13], h.v[14], h.v[15]};
        asm volatile("s_waitcnt lgkmcnt(0)" ::: "memory");
        float lg[16];
#pragma unroll
        for (int e = 0; e < 16; ++e) lg[e] = 0.f;
#pragma unroll 2
        for (int i = 0; i < 16; ++i) {
            const int c = lane + 64 * i;
            const float hv = hs[c];
            const LAS f32x4* wp = (const LAS f32x4*)(wr + wr_off(c));
            const f32x4 w0 = wp[0], w1 = wp[1], w2 = wp[2], w3 = wp[3];
#pragma unroll
            for (int q = 0; q < 4; ++q) { lg[q] += hv * w0[q]; lg[4 + q] += hv * w1[q]; lg[8 + q] += hv * w2[q]; lg[12 + q] += hv * w3[q]; }
        }
        asm volatile("s_waitcnt lgkmcnt(0)" ::: "memory");
        float mx = -1e30f;
#pragma unroll
        for (int e = 0; e < 16; ++e) { lg[e] = wave_sum(lg[e]); mx = fmaxf(mx, lg[e]); }
        float den = 0.f;
#pragma unroll
        for (int e = 0; e < 16; ++e) { lg[e] = expf(lg[e] - mx); den += lg[e]; }
        const float inv = 1.0f / den;
        float mine = 0.f;
#pragma unroll
        for (int e = 0; e < 16; ++e) mine = (lane == e) ? lg[e] * inv : mine;
        if (lane < 16) {
            if (lat) ((float*)(P.ws + WS_AFF_LAT))[((size_t)((row >> 12) * 16 + lane)) * 4096 + (row & 4095)] = mine;
            else { const int rc = row - M_LAT; ((float*)(P.ws + WS_AFF_CTX))[((size_t)((rc >> 8) * 16 + lane)) * 256 + (rc & 255)] = mine; }
        }
    }
}
__device__ __forceinline__ void topk_item(const Params& P, int group, int slots_per_e, LAS unsigned char* lds) {
    const int tid = opaque_tid(), wid = tid >> 6, lane = tid & 63;
    LAS unsigned* hist = (LAS unsigned*)lds;
    LAS unsigned* suf = hist + 256;
    LAS unsigned* ctl = suf + 256;
    LAS int* sel = (LAS int*)(ctl + 16);
    const bool isctx = group >= 128; const int g = group & 127, b = g >> 4, e = g & 15;
    const int T = isctx ? 256 : 4096, cap = T >> 3;
    const float* aff = isctx ? (const float*)(P.ws + WS_AFF_CTX) + (size_t)g * 256 : (const float*)(P.ws + WS_AFF_LAT) + (size_t)g * 4096;
    unsigned v[8];
#pragma unroll
    for (int i = 0; i < 8; ++i) { const int t = tid + NTHREADS * i; v[i] = (t < T) ? __float_as_uint(aff[t]) : 0u; }
    unsigned prefix = 0u, mask = 0u; int k = cap;
    for (int pass = 3; pass >= 0; --pass) {
        const int shift = pass * 8;
        if (tid < 256) hist[tid] = 0u;
        __syncthreads();
#pragma unroll
        for (int i = 0; i < 8; ++i) { const int t = tid + NTHREADS * i; if (t < T && (v[i] & mask) == prefix) atomicAdd((unsigned*)&hist[(v[i] >> shift) & 255u], 1u); }
        __syncthreads();
        if (tid < 256) suf[tid] = hist[tid];
        __syncthreads();
        for (int off = 1; off < 256; off <<= 1) {
            unsigned t2 = 0u;
            if (tid < 256 && tid + off < 256) t2 = suf[tid + off];
            __syncthreads();
            if (tid < 256) suf[tid] += t2;
            __syncthreads();
        }
        if (tid < 256) { const unsigned sj = suf[tid], sj1 = (tid < 255) ? suf[tid + 1] : 0u; if (sj >= (unsigned)k && sj1 < (unsigned)k) { ctl[0] = (unsigned)tid; ctl[1] = (unsigned)k - sj1; } }
        __syncthreads();
        prefix |= ctl[0] << shift; mask |= 255u << shift; k = (int)ctl[1];
        __syncthreads();
    }
    const unsigned thr = prefix; const int krem = k, ngt = cap - krem;
    int cgt = 0, ceq = 0;
#pragma unroll
    for (int i = 0; i < 8; ++i) { const int t = tid + NTHREADS * i; if (t < T) { cgt += (v[i] > thr) ? 1 : 0; ceq += (v[i] == thr) ? 1 : 0; } }
    int packed = cgt | (ceq << 16), incl = packed;
#pragma unroll
    for (int o = 1; o < 64; o <<= 1) { const int t2 = __shfl_up(incl, o); if (lane >= o) incl += t2; }
    if (lane == 63) ctl[4 + wid] = (unsigned)incl;
    __syncthreads();
    int base = incl - packed;
    for (int w = 0; w < wid; ++w) base += (int)ctl[4 + w];
    int bgt = base & 0xffff, beq = base >> 16;
    int* IDX = (int*)(P.ws + WS_IDX); float* GATE = (float*)(P.ws + WS_GATE); int* INV = (int*)(P.ws + WS_INV);
    const int gslot0 = isctx ? 4096 + b * 32 : b * 512;
#pragma unroll
    for (int i = 0; i < 8; ++i) {
        const int t = tid + NTHREADS * i;
        if (t < T) {
            int slot = -1;
            if (v[i] > thr) slot = bgt++;
            else if (v[i] == thr) { const int r = beq++; if (r < krem) slot = ngt + r; }
            const int row = isctx ? M_LAT + b * 256 + t : b * 4096 + t;
            INV[(size_t)row * 16 + e] = (slot >= 0) ? gslot0 + slot : -1;
            if (slot >= 0) { IDX[e * slots_per_e + gslot0 + slot] = row; GATE[e * slots_per_e + gslot0 + slot] = __uint_as_float(v[i]); sel[slot] = row; }
        }
    }
    __syncthreads();
    const bf16_t* H = (const bf16_t*)(P.ws + WS_H); bf16_t* XE = (bf16_t*)(P.ws + WS_XE);
    for (int s = wid; s < cap; s += 8) {
        const int row = sel[s];
        const u32x4* src = (const u32x4*)(H + (size_t)row * 1024); u32x4* dst = (u32x4*)(XE + ((size_t)e * slots_per_e + gslot0 + s) * 1024);
        const u32x4 a = src[lane], c = src[64 + lane];
        dst[lane] = a; dst[64 + lane] = c;
    }
    __syncthreads();
}
namespace pg8 {
constexpr int BM = 256, BK = 64, HALF = 128, HTB = HALF * BK * 2, STAGE_BYTES = 8 * HTB;
__device__ __forceinline__ int lds_byte(int r, int c) { const int st = (r >> 4) * 2 + (c >> 5), rr = r & 15, cc = c & 31, ob = rr * 64 + cc * 2; return st * 1024 + (ob ^ (((ob >> 9) & 1) << 5)); }
__device__ __forceinline__ void stage_rc(int b, int& R, int& C) { const int st = b / 1024, sb = b % 1024, swz = sb ^ (((sb >> 9) & 1) << 5); R = (st >> 1) * 16 + swz / 64; C = (st & 1) * 32 + (swz % 64) / 2; }
__device__ __forceinline__ int perm32(int rho) { const int n = rho >> 4, i = rho & 15; return 8 * (i >> 2) + 4 * n + (i & 3); }
struct Unit { int pm, pn; };
struct Gemm { const bf16_t* A; const bf16_t* Bt; int lda, ldb, K; };
struct Sched {
    int nUnits, tM, nN, G, c;
    __device__ __forceinline__ void init(int groups, int tM_, int nN_) { tM = tM_; nN = nN_; nUnits = groups * tM_ * nN_; G = gridDim.x; c = blockIdx.x; }
    __device__ __forceinline__ bool next(int i, Unit& u) const {
        const int L = i * G + c; if (L >= nUnits) return false;
        const int per = tM * nN, e = L / per, r = L - e * per, pml = r / nN, pnl = r - pml * nN;
        u.pm = e * tM + pml; u.pn = e * nN + pnl; return true;
    }
};
enum { EPI_EVEN_IN = 0, EPI_OUT = 1, EPI_ODD_IN = 2, EPI_UPQ = 3, EPI_UPKV = 4, EPI_MOE_UP = 5, EPI_MOE_DOWN = 6 };
struct Epi { int mode; int layer; int nNe; int slots; };

__device__ __forceinline__ void epilogue(const Params& P, const Epi& E, const f32x4 (&acc)[2][2][4][2], const Unit& u) {
    const int tid_ = opaque_tid(), wid_ = __builtin_amdgcn_readfirstlane(tid_ >> 6), lane_ = tid_ & 63, wr = wid_ >> 2, wc = wid_ & 3, fr = lane_ & 15, fq = lane_ >> 4;
    unsigned char* ws = P.ws;
    if (E.mode == EPI_EVEN_IN) {
        bf16_t* O = (bf16_t*)(ws + WS_BIG); const float* rope = (const float*)(ws + WS_ROPE16);
#pragma unroll
        for (int ai = 0; ai < 2; ++ai)
#pragma unroll
            for (int m = 0; m < 4; ++m) {
                const int row = u.pm * BM + ai * HALF + wr * 64 + m * 16 + fr;
                const bool rot = (row < M_LAT) && (u.pn < 4);
                const int t = row & 4095, pos = (wc & 1) ? (t & 63) : (t >> 6);
                f32x4 c01 = {1.f, 0.f, 1.f, 0.f}, c23 = {1.f, 0.f, 1.f, 0.f};
                if (rot) { const f32x4* tp = (const f32x4*)(rope + (size_t)(pos * 16 + 4 * fq) * 2); c01 = tp[0]; c23 = tp[1]; }
                const float cs[4] = {c01[0], c01[2], c23[0], c23[2]}, sn[4] = {c01[1], c01[3], c23[1], c23[3]};
                bf16_t* rowp = O + (size_t)row * EVEN_IN + u.pn * BM + wc * 32 + 4 * fq;
#pragma unroll
                for (int bj = 0; bj < 2; ++bj) {
                    const f32x4 a = acc[ai][bj][m][0], b = acc[ai][bj][m][1]; float ra[4], rb[4];
#pragma unroll
                    for (int j = 0; j < 4; ++j) { ra[j] = a[j] * cs[j] - b[j] * sn[j]; rb[j] = b[j] * cs[j] + a[j] * sn[j]; }
                    u32x2 wa, wb; wa.x = cvtpk(ra[0], ra[1]); wa.y = cvtpk(ra[2], ra[3]); wb.x = cvtpk(rb[0], rb[1]); wb.y = cvtpk(rb[2], rb[3]);
                    *(u32x2*)(rowp + bj * HALF) = wa; *(u32x2*)(rowp + bj * HALF + 16) = wb;
                }
            }
    } else if (E.mode == EPI_OUT) {
        const float* mods = (const float*)(ws + WS_MODS);
#pragma unroll
        for (int ai = 0; ai < 2; ++ai)
#pragma unroll
            for (int m = 0; m < 4; ++m) {
                const int row = u.pm * BM + ai * HALF + wr * 64 + m * 16 + fr;
                const bool lat = row < M_LAT; const int r9 = lat ? (row >> 12) : 8;
                const float* g1 = mods + (size_t)(E.layer * 9 + r9) * 6144 + 2048;
                const float* res; float* outp;
                if (lat) { outp = P.out + (size_t)row * 1024; res = (E.layer == 0) ? P.in[I_X] + (size_t)row * 1024 : outp; }
                else { outp = (float*)(ws + WS_XC) + (size_t)(row - M_LAT) * 1024; res = (E.layer == 0) ? P.in[I_CTX] + (size_t)(row - M_LAT) * 1024 : outp; }
                const int col0 = u.pn * BM + wc * 32 + 4 * fq;
#pragma unroll
                for (int bj = 0; bj < 2; ++bj)
#pragma unroll
                    for (int n = 0; n < 2; ++n) { const int c = col0 + bj * HALF + n * 16;
                        const f32x4 rv = *(const f32x4*)(res + c), gv = *(const f32x4*)(g1 + c);
                        *(f32x4*)(outp + c) = rv + gv * acc[ai][bj][m][n]; }
            }
    } else if (E.mode == EPI_ODD_IN) {
        bf16_t* O = (bf16_t*)(ws + WS_PROJ); bf16_t* KR = (bf16_t*)(ws + WS_KR); const float* rope = (const float*)(ws + WS_ROPE8);
        float* partq = (float*)(ws + WS_PARTQ); float* partkv = (float*)(ws + WS_PARTKV);
#pragma unroll
        for (int ai = 0; ai < 2; ++ai)
#pragma unroll
            for (int m = 0; m < 4; ++m) {
                const int row = u.pm * BM + ai * HALF + wr * 64 + m * 16 + fr;
                if (u.pn == 0) {
                    float s = 0.f;
#pragma unroll
                    for (int bj = 0; bj < 2; ++bj)
#pragma unroll
                        for (int n = 0; n < 2; ++n) { const f32x4 x = acc[ai][bj][m][n]; s += (x[0] * x[0] + x[1] * x[1]) + (x[2] * x[2] + x[3] * x[3]); }
                    s += __shfl_xor(s, 16); s += __shfl_xor(s, 32);
                    if (fq == 0) partq[(size_t)row * 4 + wc] = s;
                }
                if (u.pn == 1) {
                    float s = 0.f;
#pragma unroll
                    for (int n = 0; n < 2; ++n) { const f32x4 x = acc[ai][0][m][n]; s += (x[0] * x[0] + x[1] * x[1]) + (x[2] * x[2] + x[3] * x[3]); }
                    s += __shfl_xor(s, 16); s += __shfl_xor(s, 32);
                    if (fq == 0) partkv[(size_t)row * 4 + wc] = s;
                }
#pragma unroll
                for (int bj = 0; bj < 2; ++bj) {
                    const int colg = u.pn * BM + bj * HALF + wc * 32;
                    if (colg == 384) {
                        const bool rot = row < M_LAT; const int t = row & 4095, pos = (fq >= 2) ? (t & 63) : (t >> 6);
                        f32x4 c01 = {1.f, 0.f, 1.f, 0.f}, c23 = {1.f, 0.f, 1.f, 0.f};
                        if (rot) { const f32x4* tp = (const f32x4*)(rope + (size_t)(pos * 8 + 4 * (fq & 1)) * 2); c01 = tp[0]; c23 = tp[1]; }
                        const float cs[4] = {c01[0], c01[2], c23[0], c23[2]}, sn[4] = {c01[1], c01[3], c23[1], c23[3]};
                        const f32x4 a = acc[ai][bj][m][0], b = acc[ai][bj][m][1]; float ra[4], rb[4];
#pragma unroll
                        for (int j = 0; j < 4; ++j) { ra[j] = a[j] * cs[j] - b[j] * sn[j]; rb[j] = b[j] * cs[j] + a[j] * sn[j]; }
                        u32x2 wa, wb; wa.x = cvtpk(ra[0], ra[1]); wa.y = cvtpk(ra[2], ra[3]); wb.x = cvtpk(rb[0], rb[1]); wb.y = cvtpk(rb[2], rb[3]);
                        const int ca = (fq < 2) ? 4 * fq : 4 * fq + 8, cb = (fq < 2) ? 4 * fq + 8 : 4 * fq + 16;
                        *(u32x2*)(KR + (size_t)row * 32 + ca) = wa; *(u32x2*)(KR + (size_t)row * 32 + cb) = wb;
                    } else {
#pragma unroll
                        for (int n = 0; n < 2; ++n) { const int c = colg + n * 16 + 4 * fq;
                            if (c < ODD_IN) { const f32x4 x = acc[ai][bj][m][n]; u32x2 w; w.x = cvtpk(x[0], x[1]); w.y = cvtpk(x[2], x[3]); *(u32x2*)(O + (size_t)row * ODD_IN + c) = w; } }
                    }
                }
            }
    } else if (E.mode == EPI_UPQ) {
        bf16_t* O = (bf16_t*)(ws + WS_QM); const float* rope = (const float*)(ws + WS_ROPE8); const float* partq = (const float*)(ws + WS_PARTQ);
#pragma unroll
        for (int ai = 0; ai < 2; ++ai)
#pragma unroll
            for (int m = 0; m < 4; ++m) {
                const int row = u.pm * BM + ai * HALF + wr * 64 + m * 16 + fr;
                const f32x4 pq = *(const f32x4*)(partq + (size_t)row * 4);
                const float rs = rsqrtf(((pq[0] + pq[1]) + (pq[2] + pq[3])) * (1.0f / 256.0f) + RMS_EPS);
                const int t = row & 4095, pos = (fq >= 2) ? (t & 63) : (t >> 6);
                const f32x4* tp = (const f32x4*)(rope + (size_t)(pos * 8 + 4 * (fq & 1)) * 2); const f32x4 c01 = tp[0], c23 = tp[1];
                const float cs[4] = {c01[0], c01[2], c23[0], c23[2]}, sn[4] = {c01[1], c01[3], c23[1], c23[3]};
#pragma unroll
                for (int bj = 0; bj < 2; ++bj) {
                    const int colg = u.pn * BM + bj * HALF + wc * 32, grp = colg >> 5;
                    const f32x4 a = acc[ai][bj][m][0] * rs, b = acc[ai][bj][m][1] * rs;
                    bf16_t* rowp = O + (size_t)row * 768 + colg;
                    if (grp % 3 == 2) {
                        float ra[4], rb[4];
#pragma unroll
                        for (int j = 0; j < 4; ++j) { ra[j] = a[j] * cs[j] - b[j] * sn[j]; rb[j] = b[j] * cs[j] + a[j] * sn[j]; }
                        u32x2 wa, wb; wa.x = cvtpk(ra[0], ra[1]); wa.y = cvtpk(ra[2], ra[3]); wb.x = cvtpk(rb[0], rb[1]); wb.y = cvtpk(rb[2], rb[3]);
                        const int ca = (fq < 2) ? 4 * fq : 4 * fq + 8, cb = (fq < 2) ? 4 * fq + 8 : 4 * fq + 16;
                        *(u32x2*)(rowp + ca) = wa; *(u32x2*)(rowp + cb) = wb;
                    } else {
                        u32x2 wa, wb; wa.x = cvtpk(a[0], a[1]); wa.y = cvtpk(a[2], a[3]); wb.x = cvtpk(b[0], b[1]); wb.y = cvtpk(b[2], b[3]);
                        *(u32x2*)(rowp + 4 * fq) = wa; *(u32x2*)(rowp + 16 + 4 * fq) = wb;
                    }
                }
            }
    } else if (E.mode == EPI_UPKV) {
        bf16_t* O = (bf16_t*)(ws + WS_KVM); const float* partkv = (const float*)(ws + WS_PARTKV);
#pragma unroll
        for (int ai = 0; ai < 2; ++ai)
#pragma unroll
            for (int m = 0; m < 4; ++m) {
                const int row = u.pm * BM + ai * HALF + wr * 64 + m * 16 + fr;
                const f32x4 pq = *(const f32x4*)(partkv + (size_t)row * 4);
                const float rs = rsqrtf(((pq[0] + pq[1]) + (pq[2] + pq[3])) * (1.0f / 128.0f) + RMS_EPS);
                bf16_t* rowp = O + (size_t)row * 1024 + u.pn * BM + wc * 32 + 4 * fq;
#pragma unroll
                for (int bj = 0; bj < 2; ++bj)
#pragma unroll
                    for (int n = 0; n < 2; ++n) { const f32x4 x = acc[ai][bj][m][n] * rs; u32x2 w; w.x = cvtpk(x[0], x[1]); w.y = cvtpk(x[2], x[3]); *(u32x2*)(rowp + bj * HALF + n * 16) = w; }
            }
    } else if (E.mode == EPI_MOE_UP) {
        bf16_t* O = (bf16_t*)(ws + WS_HID); const int pnl = u.pn % E.nNe;
#pragma unroll
        for (int ai = 0; ai < 2; ++ai)
#pragma unroll
            for (int m = 0; m < 4; ++m) {
                const int row = u.pm * BM + ai * HALF + wr * 64 + m * 16 + fr;
                float hv[8];
#pragma unroll
                for (int n = 0; n < 2; ++n)
#pragma unroll
                    for (int j = 0; j < 4; ++j) { const float a = acc[ai][0][m][n][j], b = acc[ai][1][m][n][j]; hv[n * 4 + j] = a * __builtin_amdgcn_rcpf(1.0f + __builtin_amdgcn_exp2f(-a * LOG2E)) * b; }
                u32x4 w; w.x = cvtpk(hv[0], hv[1]); w.y = cvtpk(hv[2], hv[3]); w.z = cvtpk(hv[4], hv[5]); w.w = cvtpk(hv[6], hv[7]);
                *(u32x4*)(O + (size_t)row * 1024 + pnl * 128 + wc * 32 + 8 * fq) = w;
            }
    } else {
        bf16_t* O = (bf16_t*)(ws + WS_Y); const float* gate = (const float*)(ws + WS_GATE); const int pnl = u.pn % E.nNe;
#pragma unroll
        for (int ai = 0; ai < 2; ++ai)
#pragma unroll
            for (int m = 0; m < 4; ++m) {
                const int row = u.pm * BM + ai * HALF + wr * 64 + m * 16 + fr;
                const float gt = gate[row];
#pragma unroll
                for (int bj = 0; bj < 2; ++bj) { const f32x4 x0 = acc[ai][bj][m][0] * gt, x1 = acc[ai][bj][m][1] * gt;
                    u32x4 w; w.x = cvtpk(x0[0], x0[1]); w.y = cvtpk(x0[2], x0[3]); w.z = cvtpk(x1[0], x1[1]); w.w = cvtpk(x1[2], x1[3]);
                    *(u32x4*)(O + (size_t)row * 1024 + pnl * BM + bj * HALF + wc * 32 + 8 * fq) = w; }
            }
    }
}

__device__ __forceinline__ void gemm_phase(LAS unsigned char* lds, const Gemm g, const Sched& S, const Params& P, const Epi& E) {
    const int tid = opaque_tid(), wid = __builtin_amdgcn_readfirstlane(tid >> 6), lane = tid & 63, wr = wid >> 2, wc = wid & 3, fr = lane & 15, fq = lane >> 4;
    const int K = g.K, nt = K / BK;
    const bool perm = E.mode >= EPI_MOE_UP;
    unsigned voffA[2], voffB[2];
#pragma unroll
    for (int i = 0; i < 2; ++i) { int R, C; stage_rc(tid * 16 + i * 8192, R, C); const int Rb = perm ? ((R & ~31) + perm32(R & 31)) : R;
        voffA[i] = (unsigned)(R * g.lda + C) * 2u; voffB[i] = (unsigned)(Rb * g.ldb + C) * 2u; }
    const size_t kstep = (size_t)(BK * 2);
    const size_t hstepA = (size_t)HALF * g.lda * 2, hstepB = (size_t)HALF * g.ldb * 2;
    const size_t tstepA = 2 * hstepA, tstepB = 2 * hstepB;
    const unsigned ldsw = (unsigned)wid * 1024u;
    const int aoff = lds_byte(wr * 64 + fr, fq * 8), boff = lds_byte(wc * 32 + fr, fq * 8);
#define PG8_SA(b, h) (((b) * 2 + (h)) * HTB)
#define PG8_SB(b, h) ((4 + (b) * 2 + (h)) * HTB)
#define PG8_STAGE(bufoff, gbase, voff) do { _Pragma("unroll") for (int _i = 0; _i < 2; ++_i) \
        __builtin_amdgcn_global_load_lds((const unsigned*)((const char*)(gbase) + (voff)[_i]), (LAS unsigned*)(lds + (bufoff) + ldsw + _i * 8192), 16, 0, 0); } while (0)
#define PG8_LDA(dst, b, h) do { _Pragma("unroll") for (int m = 0; m < 4; ++m) _Pragma("unroll") for (int k = 0; k < 2; ++k) dst[m][k] = *(const LAS bf16x8*)(lds + PG8_SA(b, h) + aoff + m * 2048 + k * 1024); } while (0)
#define PG8_LDB(dst, b, h) do { _Pragma("unroll") for (int n = 0; n < 2; ++n) _Pragma("unroll") for (int k = 0; k < 2; ++k) dst[n][k] = *(const LAS bf16x8*)(lds + PG8_SB(b, h) + boff + n * 2048 + k * 1024); } while (0)
#define PG8_MMA(ai, bj, At, Bt) do { __builtin_amdgcn_s_setprio(1); _Pragma("unroll") for (int m = 0; m < 4; ++m) _Pragma("unroll") for (int n = 0; n < 2; ++n) _Pragma("unroll") for (int k = 0; k < 2; ++k) \
        acc[ai][bj][m][n] = __builtin_amdgcn_mfma_f32_16x16x32_bf16(Bt[n][k], At[m][k], acc[ai][bj][m][n], 0, 0, 0); __builtin_amdgcn_s_setprio(0); } while (0)
#define PG8_WAIT_V(n) asm volatile("s_waitcnt vmcnt(" #n ")" ::: "memory")
#define PG8_WAIT_L(n) asm volatile("s_waitcnt lgkmcnt(" #n ")" ::: "memory")
#define PG8_BAR __builtin_amdgcn_s_barrier()
#define PG8_SCHED __builtin_amdgcn_sched_barrier(0)
    Unit cur, nxt; int ui = 0;
    if (!S.next(0, cur)) return;
    f32x4 acc[2][2][4][2];
#pragma unroll
    for (int a = 0; a < 2; ++a)
#pragma unroll
        for (int b = 0; b < 2; ++b)
#pragma unroll
            for (int m = 0; m < 4; ++m)
#pragma unroll
                for (int n = 0; n < 2; ++n) acc[a][b][m][n] = (f32x4){0.f, 0.f, 0.f, 0.f};
    bf16x8 At[4][2], B0[2][2], B1[2][2];
    const char* cA = (const char*)g.A + (size_t)cur.pm * tstepA; const char* cB = (const char*)g.Bt + (size_t)cur.pn * tstepB;
    PG8_STAGE(PG8_SB(0, 0), cB, voffB); PG8_STAGE(PG8_SB(0, 1), cB + hstepB, voffB); PG8_STAGE(PG8_SA(0, 0), cA, voffA); PG8_STAGE(PG8_SA(0, 1), cA + hstepA, voffA);
    if (wr == 1) PG8_BAR;
    PG8_WAIT_V(2); PG8_BAR;
    PG8_STAGE(PG8_SB(1, 0), cB + kstep, voffB); PG8_STAGE(PG8_SA(1, 0), cA + kstep, voffA); PG8_STAGE(PG8_SB(1, 1), cB + hstepB + kstep, voffB);
    PG8_WAIT_V(6); PG8_BAR;
    for (;;) {
        const bool has_next = S.next(ui + 1, nxt);
        const char* nA = has_next ? (const char*)g.A + (size_t)nxt.pm * tstepA : cA; const char* nB = has_next ? (const char*)g.Bt + (size_t)nxt.pn * tstepB : cB;
        for (int t = 0; t < nt; t += 2) {
            const bool last = (t == nt - 2);
            const char* a1 = cA + (size_t)(t + 1) * kstep;
            const char* a2 = last ? nA : cA + (size_t)(t + 2) * kstep; const char* b2 = last ? nB : cB + (size_t)(t + 2) * kstep;
            const char* a3 = a2 + kstep; const char* b3 = b2 + kstep;
            PG8_LDB(B0, 0, 0); PG8_LDB(B1, 0, 1); PG8_SCHED; PG8_LDA(At, 0, 0); PG8_STAGE(PG8_SA(1, 1), a1 + hstepA, voffA);
            PG8_WAIT_V(8); PG8_WAIT_L(0); PG8_BAR; PG8_MMA(0, 0, At, B0); PG8_MMA(0, 1, At, B1); PG8_BAR; PG8_SCHED;
            PG8_LDA(At, 0, 1); PG8_STAGE(PG8_SB(0, 0), b2, voffB); PG8_STAGE(PG8_SB(0, 1), b2 + hstepB, voffB); PG8_STAGE(PG8_SA(0, 0), a2, voffA);
            PG8_WAIT_V(8); PG8_WAIT_L(0); PG8_BAR; PG8_MMA(1, 0, At, B0); PG8_MMA(1, 1, At, B1); PG8_BAR; PG8_SCHED;
            PG8_LDB(B0, 1, 0); PG8_LDB(B1, 1, 1); PG8_SCHED; PG8_LDA(At, 1, 0); PG8_STAGE(PG8_SA(0, 1), a2 + hstepA, voffA);
            PG8_WAIT_V(8); PG8_WAIT_L(0); PG8_BAR; PG8_MMA(0, 0, At, B0); PG8_MMA(0, 1, At, B1); PG8_BAR; PG8_SCHED;
            PG8_LDA(At, 1, 1); PG8_STAGE(PG8_SB(1, 0), b3, voffB); PG8_STAGE(PG8_SB(1, 1), b3 + hstepB, voffB); PG8_STAGE(PG8_SA(1, 0), a3, voffA);
            PG8_WAIT_V(8); PG8_WAIT_L(0); PG8_BAR; PG8_MMA(1, 0, At, B0); PG8_MMA(1, 1, At, B1); PG8_BAR; PG8_SCHED;
        }
        if (wr == 0) PG8_BAR;
        epilogue(P, E, acc, cur);
        if (!has_next) break;
#pragma unroll
        for (int a = 0; a < 2; ++a)
#pragma unroll
            for (int b = 0; b < 2; ++b)
#pragma unroll
                for (int m = 0; m < 4; ++m)
#pragma unroll
                    for (int n = 0; n < 2; ++n) acc[a][b][m][n] = (f32x4){0.f, 0.f, 0.f, 0.f};
        cur = nxt; cA = nA; cB = nB; ++ui;
        if (wr == 1) PG8_BAR;
    }
    PG8_WAIT_V(0);
    PG8_BAR;
#undef PG8_SA
#undef PG8_SB
#undef PG8_STAGE
#undef PG8_LDA
#undef PG8_LDB
#undef PG8_MMA
#undef PG8_WAIT_V
#undef PG8_WAIT_L
#undef PG8_BAR
#undef PG8_SCHED
}
}
namespace att {
#define SBAR() __builtin_amdgcn_sched_barrier(0)
template <int OFF> __device__ __forceinline__ s16x4 tr_read(unsigned vb) {
    s16x4 r; asm volatile("ds_read_b64_tr_b16 %0, %1 offset:%2" : "=&v"(r) : "v"(vb), "i"(OFF) : "memory"); return r;
}
template <int DV> __device__ __forceinline__ int v_st(int k, int c) {
    const int kk = (k & ~0xC) | ((k & 4) << 1) | ((k & 8) >> 1);
    return ((kk >> 3) * (DV / 32) + (c >> 5)) * 512 + ((kk & 7) * 32 + (c & 31)) * 2;
}
__device__ __forceinline__ int v_rd_base(int lane) { return ((lane & 3) << 3) | (((lane >> 2) & 3) << 6) | (((lane >> 4) & 1) << 5) | (((lane >> 5) & 1) << 8); }
template <int DV> constexpr int v_rd_off(int d0, int ks, int half) { return d0 * 512 + ks * (DV / 32) * 1024 + half * (DV / 32) * 512; }
#define PK8(L, H) (bf16x8){L[0], L[1], L[2], L[3], H[0], H[1], H[2], H[3]}
template <int DV, int D0> __device__ __forceinline__ void pv_one(f32x16& od, unsigned vb, bf16x8 pa0, bf16x8 pa1, bf16x8 pa2, bf16x8 pa3) {
    const s16x4 l0 = tr_read<v_rd_off<DV>(D0, 0, 0)>(vb), h0 = tr_read<v_rd_off<DV>(D0, 0, 1)>(vb), l1 = tr_read<v_rd_off<DV>(D0, 1, 0)>(vb), h1 = tr_read<v_rd_off<DV>(D0, 1, 1)>(vb);
    const s16x4 l2 = tr_read<v_rd_off<DV>(D0, 2, 0)>(vb), h2 = tr_read<v_rd_off<DV>(D0, 2, 1)>(vb), l3 = tr_read<v_rd_off<DV>(D0, 3, 0)>(vb), h3 = tr_read<v_rd_off<DV>(D0, 3, 1)>(vb);
    asm volatile("s_waitcnt lgkmcnt(0)" ::: "memory"); SBAR();
    od = __builtin_amdgcn_mfma_f32_32x32x16_bf16(pa0, PK8(l0, h0), od, 0, 0, 0);
    od = __builtin_amdgcn_mfma_f32_32x32x16_bf16(pa1, PK8(l1, h1), od, 0, 0, 0);
    od = __builtin_amdgcn_mfma_f32_32x32x16_bf16(pa2, PK8(l2, h2), od, 0, 0, 0);
    od = __builtin_amdgcn_mfma_f32_32x32x16_bf16(pa3, PK8(l3, h3), od, 0, 0, 0);
}
#define PK4(P, BASE, OUT) do { unsigned a0 = cvtpk(P[BASE + 0], P[BASE + 1]), a1 = cvtpk(P[BASE + 2], P[BASE + 3]);   \
    unsigned b0 = cvtpk(P[BASE + 4], P[BASE + 5]), b1 = cvtpk(P[BASE + 6], P[BASE + 7]);                              \
    auto r0 = __builtin_amdgcn_permlane32_swap(a0, b0, false, false); auto r1 = __builtin_amdgcn_permlane32_swap(a1, b1, false, false); \
    u32x4 w = {r0[0], r1[0], r0[1], r1[1]}; OUT = __builtin_bit_cast(bf16x8, w); } while (0)
__device__ __forceinline__ void pack_p(const f32x16& p0, const f32x16& p1, bf16x8& pa0, bf16x8& pa1, bf16x8& pa2, bf16x8& pa3) {
    PK4(p0, 0, pa0); PK4(p0, 8, pa1); PK4(p1, 0, pa2); PK4(p1, 8, pa3);
}
__device__ __forceinline__ float half_swap_max(float x) { auto rr = __builtin_amdgcn_permlane32_swap(__float_as_uint(x), __float_as_uint(x), false, false); return fmaxf(__uint_as_float(rr[0]), __uint_as_float(rr[1])); }
__device__ __forceinline__ float half_swap_add(float x) { auto rr = __builtin_amdgcn_permlane32_swap(__float_as_uint(x), __float_as_uint(x), false, false); return __uint_as_float(rr[0]) + __uint_as_float(rr[1]); }

template <int DQK> constexpr int KROW = DQK * 2 + 16;
template <int DQK, int DV> struct Lay {
    static constexpr int KB = 64 * KROW<DQK>, VB = 64 * DV * 2;
    static constexpr int K_OFF = 0, V_OFF = 2 * KB, SCR_OFF = 2 * KB + 2 * VB;
    static constexpr int TAB_OFF = SCR_OFF + 8 * 256, END = TAB_OFF + 2048;
};
struct KVSrc {
    const bf16_t* k0; int ldk0;
    const bf16_t* k1; int ldk1;
    const bf16_t* v; int ldv;
    int row_lat0, n_lat, row_ctx0;
};
__device__ __forceinline__ int tile_row0(const KVSrc& s, int j) { return (j < s.n_lat) ? s.row_lat0 + 64 * j : s.row_ctx0 + 64 * (j - s.n_lat); }

template <int DQK, int DV> struct Stage {
    static constexpr int KC = DQK / 8, VC = DV / 8;
    static constexpr int NK = (64 * KC + 511) / 512, NV = (64 * VC + 511) / 512;
    u32x4 kr[NK], vr[NV];
    __device__ __forceinline__ void load(const KVSrc& s, int j, int tid) {
        const int row0 = tile_row0(s, j);
#pragma unroll
        for (int i = 0; i < NK; ++i) { const int c = tid + 512 * i;
            if (c < 64 * KC) { const int key = c / KC, part = c - key * KC;
                const bf16_t* p = (DQK == 96 && part >= 8) ? s.k1 + (size_t)(row0 + key) * s.ldk1 + (part - 8) * 8 : s.k0 + (size_t)(row0 + key) * s.ldk0 + part * 8;
                kr[i] = *(const u32x4*)p; } }
#pragma unroll
        for (int i = 0; i < NV; ++i) { const int c = tid + 512 * i; const int key = c / VC, c8 = c - key * VC;
            vr[i] = *(const u32x4*)(s.v + (size_t)(row0 + key) * s.ldv + c8 * 8); }
    }
    __device__ __forceinline__ void write(LAS unsigned char* kbuf, LAS unsigned char* vbuf, int tid) const {
#pragma unroll
        for (int i = 0; i < NK; ++i) { const int c = tid + 512 * i;
            if (c < 64 * KC) { const int key = c / KC, part = c - key * KC; *(LAS u32x4*)(kbuf + key * KROW<DQK> + part * 16) = kr[i]; } }
#pragma unroll
        for (int i = 0; i < NV; ++i) { const int c = tid + 512 * i; const int key = c / VC, c8 = c - key * VC; *(LAS u32x4*)(vbuf + v_st<DV>(key, c8 * 8)) = vr[i]; }
    }
};
template <int DQK> __device__ __forceinline__ void qkt(f32x16& p0, f32x16& p1, const LAS unsigned char* kbuf, const bf16x8 (&qr)[DQK / 16], int r32, int hi) {
    p0 = (f32x16){}; p1 = (f32x16){};
#pragma unroll
    for (int d0 = 0; d0 < DQK / 16; ++d0) {
        const bf16x8 b0 = *(const LAS bf16x8*)(kbuf + r32 * KROW<DQK> + d0 * 32 + hi * 16);
        const bf16x8 b1 = *(const LAS bf16x8*)(kbuf + (32 + r32) * KROW<DQK> + d0 * 32 + hi * 16);
        p0 = __builtin_amdgcn_mfma_f32_32x32x16_bf16(b0, qr[d0], p0, 0, 0, 0);
        p1 = __builtin_amdgcn_mfma_f32_32x32x16_bf16(b1, qr[d0], p1, 0, 0, 0);
    }
}
template <int DV> __device__ __forceinline__ void pv_all(f32x16 (&o)[DV / 32], unsigned vb, bf16x8 pa0, bf16x8 pa1, bf16x8 pa2, bf16x8 pa3) {
    pv_one<DV, 0>(o[0], vb, pa0, pa1, pa2, pa3); pv_one<DV, 1>(o[1], vb, pa0, pa1, pa2, pa3);
    if constexpr (DV == 128) { pv_one<DV, 2>(o[2], vb, pa0, pa1, pa2, pa3); pv_one<DV, 3>(o[3], vb, pa0, pa1, pa2, pa3); }
}
constexpr float THR2 = 10.0f;
template <int DV> __device__ __forceinline__ void softmax_step(f32x16& p0, f32x16& p1, float& m_reg, float& l_reg, f32x16 (&o)[DV / 32], LAS float* al_l, int r32, int hi,
                                                               bf16x8& pa0, bf16x8& pa1, bf16x8& pa2, bf16x8& pa3) {
    float pmax = p0[0];
#pragma unroll
    for (int r = 1; r < 16; ++r) pmax = fmaxf(pmax, p0[r]);
#pragma unroll
    for (int r = 0; r < 16; ++r) pmax = fmaxf(pmax, p1[r]);
    pmax = half_swap_max(pmax);
    if (!__all(pmax - m_reg <= THR2)) {
        const float mn = fmaxf(m_reg, pmax), alpha = __builtin_amdgcn_exp2f(m_reg - mn);
        m_reg = mn; l_reg *= alpha;
        if (hi == 0) al_l[r32] = alpha;
        asm volatile("s_waitcnt lgkmcnt(0)" ::: "memory");
#pragma unroll
        for (int r = 0; r < 16; ++r) { const float a = al_l[crow(r, hi)];
#pragma unroll
            for (int d = 0; d < DV / 32; ++d) o[d][r] *= a; }
        asm volatile("s_waitcnt lgkmcnt(0)" ::: "memory");
    }
    float ps = 0.f;
#pragma unroll
    for (int r = 0; r < 16; ++r) { p0[r] = __builtin_amdgcn_exp2f(p0[r] - m_reg); ps += p0[r]; }
#pragma unroll
    for (int r = 0; r < 16; ++r) { p1[r] = __builtin_amdgcn_exp2f(p1[r] - m_reg); ps += p1[r]; }
    l_reg += half_swap_add(ps);
    pack_p(p0, p1, pa0, pa1, pa2, pa3);
}
struct NaWave { int active_lo, active_hi;
                int dr0;
                int c, cs; };
template <int DQK, int DV, int MODE>
__device__ __forceinline__ void flash_loop(LAS unsigned char* lds, const KVSrc& src, int nt, const bf16x8 (&qr)[DQK / 16], float C,
                                           f32x16 (&o)[DV / 32], float& m_reg, float& l_reg, const NaWave& nw) {
    typedef Lay<DQK, DV> L;
    const int tid = opaque_tid(), wid = tid >> 6, lane = tid & 63, r32 = lane & 31, hi = lane >> 5;
    LAS unsigned char* kb = lds + L::K_OFF; LAS unsigned char* vbuf = lds + L::V_OFF;
    LAS float* al_l = (LAS float*)(lds + L::SCR_OFF) + wid * 64;
    const LAS float* tab = (const LAS float*)(lds + L::TAB_OFF);
    const unsigned vbase = (unsigned)(uintptr_t)vbuf + (unsigned)v_rd_base(lane);
    Stage<DQK, DV> st;
    st.load(src, 0, tid); st.write(kb, vbuf, tid);
    __syncthreads();
    for (int j = 0; j < nt; ++j) {
        const int cur = j & 1;
        if (j + 1 < nt) st.load(src, j + 1, tid);
        bool act = true;
        if (MODE == 1) act = (j >= src.n_lat) || (j >= nw.active_lo && j <= nw.active_hi);
        if (act) {
            f32x16 p0, p1;
            qkt<DQK>(p0, p1, kb + cur * L::KB, qr, r32, hi);
            if (MODE == 1 && j < src.n_lat) {
                const LAS float* brow = tab + (nw.dr0 + j) * 31 + 15 - nw.c;
#pragma unroll
                for (int r = 0; r < 16; ++r) { const int kj = crow(r, hi);
                    p0[r] = (kj >= nw.cs && kj < nw.cs + 16) ? fmaf(p0[r], C, brow[kj]) : -1e30f;
                    const int kj1 = 32 + kj;
                    p1[r] = (kj1 >= nw.cs && kj1 < nw.cs + 16) ? fmaf(p1[r], C, brow[kj1]) : -1e30f; }
            } else {
#pragma unroll
                for (int r = 0; r < 16; ++r) { p0[r] *= C; p1[r] *= C; }
            }
            bf16x8 pa0, pa1, pa2, pa3;
            softmax_step<DV>(p0, p1, m_reg, l_reg, o, al_l, r32, hi, pa0, pa1, pa2, pa3);
            pv_all<DV>(o, vbase + cur * L::VB, pa0, pa1, pa2, pa3);
        }
        if (j + 1 < nt) st.write(kb + (cur ^ 1) * L::KB, vbuf + (cur ^ 1) * L::VB, tid);
        __syncthreads();
    }
}
__device__ __forceinline__ void row_recips(float l_reg, LAS float* li_l, int r32, int hi, float (&rl)[16]) {
    if (hi == 0) li_l[r32] = l_reg;
    asm volatile("s_waitcnt lgkmcnt(0)" ::: "memory");
#pragma unroll
    for (int r = 0; r < 16; ++r) rl[r] = __builtin_amdgcn_rcpf(li_l[crow(r, hi)]);
    asm volatile("s_waitcnt lgkmcnt(0)" ::: "memory");
}
template <int DQK> __device__ __forceinline__ void load_q(bf16x8 (&qr)[DQK / 16], const bf16_t* qrow, int hi) {
#pragma unroll
    for (int d0 = 0; d0 < DQK / 16; ++d0) qr[d0] = *(const bf16x8*)(qrow + d0 * 16 + hi * 8);
}
template <int DV> __device__ __forceinline__ void store_o(const f32x16 (&o)[DV / 32], const float (&rl)[16], bf16_t* O, int ldo, int row0, int col0, int r32, int hi) {
#pragma unroll
    for (int r = 0; r < 16; ++r) { bf16_t* rp = O + (size_t)(row0 + crow(r, hi)) * ldo + col0 + r32;
#pragma unroll
        for (int d = 0; d < DV / 32; ++d) rp[d * 32] = (bf16_t)f2bf(o[d][r] * rl[r]); }
}

__device__ __forceinline__ void diff_unit(const Params& P, LAS unsigned char* lds, int b, int h, int qb, bool isctx) {
    typedef Lay<64, 128> L;
    const int tid = opaque_tid(), wid = tid >> 6, lane = tid & 63, r32 = lane & 31, hi = lane >> 5;
    const bf16_t* QKV = (const bf16_t*)(P.ws + WS_BIG); bf16_t* ATT = (bf16_t*)(P.ws + WS_ATT);
    const float lam = ((const float*)(P.ws + WS_MISC))[0];
    const int qrow0 = isctx ? M_LAT + b * 256 + wid * 32 : b * 4096 + qb * 256 + wid * 32;
    LAS float* scr = (LAS float*)(lds + L::SCR_OFF) + wid * 64;
    NaWave nw{}; unsigned o1pk[4][8]; float rl[16];
    f32x16 o[4];
#pragma unroll 1
    for (int map = 0; map < 2; ++map) {
        KVSrc src; src.k0 = QKV + 512 + h * 128 + map * 64; src.ldk0 = EVEN_IN; src.k1 = nullptr; src.ldk1 = 0; src.v = QKV + 1024 + h * 128; src.ldv = EVEN_IN;
        src.row_lat0 = b * 4096; src.n_lat = isctx ? 0 : 64; src.row_ctx0 = M_LAT + b * 256;
        bf16x8 qr[4]; load_q<64>(qr, QKV + (size_t)(qrow0 + r32) * EVEN_IN + h * 128 + map * 64, hi);
#pragma unroll
        for (int d = 0; d < 4; ++d) o[d] = (f32x16){};
        float m_reg = -1e30f, l_reg = 0.f;
        flash_loop<64, 128, 0>(lds, src, src.n_lat + 4, qr, 0.125f * LOG2E, o, m_reg, l_reg, nw);
        row_recips(l_reg, scr, r32, hi, rl);
        if (map == 0) {
#pragma unroll
            for (int d = 0; d < 4; ++d)
#pragma unroll
                for (int r = 0; r < 8; ++r) o1pk[d][r] = cvtpk(o[d][2 * r] * rl[2 * r], o[d][2 * r + 1] * rl[2 * r + 1]);
        }
    }
    const float* subln = P.in[I_SUBLN];
    float g[4];
#pragma unroll
    for (int d = 0; d < 4; ++d) g[d] = subln[d * 32 + r32] * 0.8f;
#pragma unroll
    for (int r = 0; r < 16; ++r) {
        float ss = 0.f;
#pragma unroll
        for (int d = 0; d < 4; ++d) { const unsigned w = o1pk[d][r >> 1]; const float o1 = (r & 1) ? bf_hi(w) : bf_lo(w); const float v = o1 - lam * (o[d][r] * rl[r]); o[d][r] = v; ss += v * v; }
#pragma unroll
        for (int x = 1; x < 32; x <<= 1) ss += __shfl_xor(ss, x);
        const float rs = rsqrtf(ss * (1.0f / 128.0f) + RMS_EPS);
        bf16_t* rp = ATT + (size_t)(qrow0 + crow(r, hi)) * 1024 + h * 128 + r32;
#pragma unroll
        for (int d = 0; d < 4; ++d) rp[d * 32] = (bf16_t)f2bf(o[d][r] * rs * g[d]);
    }
}
__device__ __forceinline__ void na_unit(const Params& P, LAS unsigned char* lds, int b, int h, int g4, bool isctx) {
    typedef Lay<64, 64> L;
    const int tid = opaque_tid(), wid = tid >> 6, lane = tid & 63, r32 = lane & 31, hi = lane >> 5;
    const bf16_t* QKV = (const bf16_t*)(P.ws + WS_BIG); bf16_t* ATT = (bf16_t*)(P.ws + WS_ATT);
    LAS float* tab = (LAS float*)(lds + L::TAB_OFF);
    LAS float* scr = (LAS float*)(lds + L::SCR_OFF) + wid * 64;
    KVSrc src; src.k0 = QKV + 2048 + h * 64; src.ldk0 = EVEN_IN; src.k1 = nullptr; src.ldk1 = 0; src.v = QKV + 2560 + h * 64; src.ldv = EVEN_IN;
    src.row_ctx0 = M_LAT + b * 256;
    NaWave nw{}; int qrow0;
    if (isctx) { src.row_lat0 = 0; src.n_lat = 0; qrow0 = M_LAT + b * 256 + wid * 32; }
    else {
        const int r0 = 4 * g4, rq = r0 + (wid >> 1), ch = wid & 1;
        const int kr_first = min(max(r0 - 4, 0), 56), kr_last = min(max(r0 + 3 - 4, 0), 56) + 7;
        const int rs_w = min(max(rq - 4, 0), 56);
        src.row_lat0 = b * 4096 + kr_first * 64; src.n_lat = kr_last - kr_first + 1;
        nw.active_lo = rs_w - kr_first; nw.active_hi = rs_w + 7 - kr_first; nw.dr0 = kr_first - rq + 7;
        nw.c = 32 * ch + r32; nw.cs = min(max(nw.c - 8, 0), 48);
        qrow0 = b * 4096 + rq * 64 + 32 * ch;
        const float* rpb = P.in[I_RPB] + (size_t)h * 15 * 31;
        for (int i = tid; i < 15 * 31; i += NTHREADS) tab[i] = rpb[i] * LOG2E;
    }
    bf16x8 qr[4]; load_q<64>(qr, QKV + (size_t)(qrow0 + r32) * EVEN_IN + 1536 + h * 64, hi);
    f32x16 o[2]; o[0] = (f32x16){}; o[1] = (f32x16){};
    float m_reg = -1e30f, l_reg = 0.f;
    if (isctx) flash_loop<64, 64, 0>(lds, src, 4, qr, 0.125f * LOG2E, o, m_reg, l_reg, nw);
    else flash_loop<64, 64, 1>(lds, src, src.n_lat + 4, qr, 0.125f * LOG2E, o, m_reg, l_reg, nw);
    float rl[16]; row_recips(l_reg, scr, r32, hi, rl);
    store_o<64>(o, rl, ATT, 1024, qrow0, 512 + h * 64, r32, hi);
}
__device__ __forceinline__ void mla_unit(const Params& P, LAS unsigned char* lds, int b, int h, int qb) {
    typedef Lay<96, 64> L;
    const int tid = opaque_tid(), wid = tid >> 6, lane = tid & 63, r32 = lane & 31, hi = lane >> 5;
    const bf16_t* QM = (const bf16_t*)(P.ws + WS_QM); const bf16_t* KVM = (const bf16_t*)(P.ws + WS_KVM); const bf16_t* KR = (const bf16_t*)(P.ws + WS_KR);
    bf16_t* ATT = (bf16_t*)(P.ws + WS_ATT);
    LAS float* scr = (LAS float*)(lds + L::SCR_OFF) + wid * 64;
    KVSrc src; src.k0 = KVM + h * 128; src.ldk0 = 1024; src.k1 = KR; src.ldk1 = 32; src.v = KVM + h * 128 + 64; src.ldv = 1024;
    src.row_lat0 = b * 4096; src.n_lat = 64; src.row_ctx0 = M_LAT + b * 256;
    const int qrow0 = b * 4096 + qb * 256 + wid * 32;
    NaWave nw{};
    bf16x8 qr[6]; load_q<96>(qr, QM + (size_t)(qrow0 + r32) * 768 + h * 96, hi);
    f32x16 o[2]; o[0] = (f32x16){}; o[1] = (f32x16){};
    float m_reg = -1e30f, l_reg = 0.f;
    flash_loop<96, 64, 0>(lds, src, 68, qr, 0.10206207261596575f * LOG2E, o, m_reg, l_reg, nw);
    float rl[16]; row_recips(l_reg, scr, r32, hi, rl);
    store_o<64>(o, rl, ATT, 1024, qrow0, h * 64, r32, hi);
}
}
namespace ret {
using att::tr_read; using att::v_st; using att::v_rd_base; using att::v_rd_off;
constexpr int PQ = 416, PK_ = 672, PV_ = 928, PG_ = 1440;
constexpr float KSCALE = 0.125f;
__device__ __forceinline__ size_t ret_off(int bh, int n, int dir) { return (((size_t)bh * 34 + n) * 2 + dir) * 8192; }
__device__ __forceinline__ int chunk_row0(int b, int n) { return (n < 32) ? b * 4096 + n * 128 : M_LAT + b * 256 + (n - 32) * 128; }

constexpr int R1_KF = 0, R1_KB = 16384, R1_V = 32768, R1_END = 65536;
__device__ __forceinline__ void r1_unit(const Params& P, LAS unsigned char* lds, int bh, int n) {
    const int tid = opaque_tid(), wid = tid >> 6, lane = tid & 63, r32 = lane & 31, hi = lane >> 5;
    const int b = bh >> 2, h = bh & 3;
    const bf16_t* PROJ = (const bf16_t*)(P.ws + WS_PROJ);
    const float* misc = (const float*)(P.ws + WS_MISC);
    const float lgf = misc[8 + h], lgb = misc[12 + h];
    const int row0 = chunk_row0(b, n);
#pragma unroll
    for (int i = 0; i < 2; ++i) {
        const int c = tid + 512 * i, j = c >> 3, part = c & 7;
        const u32x4 kv = *(const u32x4*)(PROJ + (size_t)(row0 + j) * ODD_IN + PK_ + h * 64 + part * 8);
        const float wf = KSCALE * __builtin_amdgcn_exp2f(lgf * (float)(127 - j)), wb = KSCALE * __builtin_amdgcn_exp2f(lgb * (float)j);
        u32x4 kf, kb;
        kf.x = cvtpk(bf_lo(kv.x) * wf, bf_hi(kv.x) * wf); kf.y = cvtpk(bf_lo(kv.y) * wf, bf_hi(kv.y) * wf); kf.z = cvtpk(bf_lo(kv.z) * wf, bf_hi(kv.z) * wf); kf.w = cvtpk(bf_lo(kv.w) * wf, bf_hi(kv.w) * wf);
        kb.x = cvtpk(bf_lo(kv.x) * wb, bf_hi(kv.x) * wb); kb.y = cvtpk(bf_lo(kv.y) * wb, bf_hi(kv.y) * wb); kb.z = cvtpk(bf_lo(kv.z) * wb, bf_hi(kv.z) * wb); kb.w = cvtpk(bf_lo(kv.w) * wb, bf_hi(kv.w) * wb);
        const int off = (j >> 6) * 8192 + v_st<64>(j & 63, part * 8);
        *(LAS u32x4*)(lds + R1_KF + off) = kf; *(LAS u32x4*)(lds + R1_KB + off) = kb;
    }
#pragma unroll
    for (int i = 0; i < 4; ++i) {
        const int c = tid + 512 * i, j = c >> 4, c8 = c & 15;
        const u32x4 vv = *(const u32x4*)(PROJ + (size_t)(row0 + j) * ODD_IN + PV_ + h * 128 + c8 * 8);
        *(LAS u32x4*)(lds + R1_V + (j >> 6) * 16384 + v_st<128>(j & 63, c8 * 8)) = vv;
    }
    __syncthreads();
    const int db = wid & 1, vb = wid >> 1;
    const unsigned base = (unsigned)(uintptr_t)lds + (unsigned)v_rd_base(lane);
    const unsigned kfa = base + R1_KF + db * 512, kba = base + R1_KB + db * 512, va = base + R1_V + vb * 512;
    f32x16 af = (f32x16){}, ab = (f32x16){};
#define R1_STEP(T, KS) do { \
        const s16x4 fl = tr_read<v_rd_off<64>(0, KS, 0) + T * 8192>(kfa), fh = tr_read<v_rd_off<64>(0, KS, 1) + T * 8192>(kfa); \
        const s16x4 bl = tr_read<v_rd_off<64>(0, KS, 0) + T * 8192>(kba), bh_ = tr_read<v_rd_off<64>(0, KS, 1) + T * 8192>(kba); \
        const s16x4 vl = tr_read<v_rd_off<128>(0, KS, 0) + T * 16384>(va), vh = tr_read<v_rd_off<128>(0, KS, 1) + T * 16384>(va); \
        asm volatile("s_waitcnt lgkmcnt(0)" ::: "memory"); SBAR(); \
        af = __builtin_amdgcn_mfma_f32_32x32x16_bf16(PK8(fl, fh), PK8(vl, vh), af, 0, 0, 0); \
        ab = __builtin_amdgcn_mfma_f32_32x32x16_bf16(PK8(bl, bh_), PK8(vl, vh), ab, 0, 0, 0); } while (0)
    R1_STEP(0, 0); R1_STEP(0, 1); R1_STEP(0, 2); R1_STEP(0, 3); R1_STEP(1, 0); R1_STEP(1, 1); R1_STEP(1, 2); R1_STEP(1, 3);
#undef R1_STEP
    float* U = (float*)(P.ws + WS_RET);
    float* uf = U + ret_off(bh, n, 0); float* ub = U + ret_off(bh, n, 1);
#pragma unroll
    for (int r = 0; r < 16; ++r) { const int d = 32 * db + crow(r, hi); uf[d * 128 + 32 * vb + r32] = af[r]; ub[d * 128 + 32 * vb + r32] = ab[r]; }
    __syncthreads();
}
__device__ __forceinline__ void r2_scan(const Params& P) {
    const float* misc = (const float*)(P.ws + WS_MISC);
    float* U = (float*)(P.ws + WS_RET);
    const int gt = blockIdx.x * NTHREADS + threadIdx.x, nth = gridDim.x * NTHREADS;
    for (int idx = gt; idx < 32 * 2 * 8192; idx += nth) {
        const int e = idx & 8191, dir = (idx >> 13) & 1, bh = idx >> 14, h = bh & 3;
        const float gC = __builtin_amdgcn_exp2f(128.0f * misc[8 + dir * 4 + h]);
        if (dir == 0) {
            float carry = gC * U[ret_off(bh, 32, 0) + e] + U[ret_off(bh, 33, 0) + e];
            for (int n = 0; n < 32; ++n) { float* p = U + ret_off(bh, n, 0) + e; const float u = *p; *p = carry; carry = gC * carry + u; }
        } else {
            float carry = U[ret_off(bh, 32, 1) + e] + gC * U[ret_off(bh, 33, 1) + e];
            for (int n = 31; n >= 0; --n) { float* p = U + ret_off(bh, n, 1) + e; const float u = *p; *p = carry; carry = gC * carry + u; }
        }
    }
}
constexpr int R3_K = 0, R3_KB = 64 * 144, R3_V = 2 * R3_KB  , R3_SF = R3_V + 32768, R3_SB = R3_SF + 16384, R3_RED = R3_SB + 16384, R3_END = R3_RED + 1024;
__device__ __forceinline__ void r3_unit(const Params& P, LAS unsigned char* lds, int bh, int n) {
    const int tid = opaque_tid(), wid = tid >> 6, lane = tid & 63, r32 = lane & 31, hi = lane >> 5;
    const int b = bh >> 2, h = bh & 3;
    const bf16_t* PROJ = (const bf16_t*)(P.ws + WS_PROJ); bf16_t* ATT = (bf16_t*)(P.ws + WS_ATT);
    const float* misc = (const float*)(P.ws + WS_MISC);
    const float lgf = misc[8 + h], lgb = misc[12 + h];
    const int row0 = b * 4096 + n * 128;
#pragma unroll
    for (int i = 0; i < 2; ++i) { const int c = tid + 512 * i, j = c >> 3, part = c & 7;
        *(LAS u32x4*)(lds + R3_K + (j >> 6) * R3_KB + (j & 63) * 144 + part * 16) = *(const u32x4*)(PROJ + (size_t)(row0 + j) * ODD_IN + PK_ + h * 64 + part * 8); }
#pragma unroll
    for (int i = 0; i < 4; ++i) { const int c = tid + 512 * i, j = c >> 4, c8 = c & 15;
        *(LAS u32x4*)(lds + R3_V + (j >> 6) * 16384 + v_st<128>(j & 63, c8 * 8)) = *(const u32x4*)(PROJ + (size_t)(row0 + j) * ODD_IN + PV_ + h * 128 + c8 * 8); }
    const float* S = (const float*)(P.ws + WS_RET);
#pragma unroll
    for (int dir = 0; dir < 2; ++dir) { const float* sp = S + ret_off(bh, n, dir);
#pragma unroll
        for (int i = 0; i < 2; ++i) { const int c = tid + 512 * i, d = c >> 4, c8 = c & 15;
            const f32x4 x0 = *(const f32x4*)(sp + d * 128 + c8 * 8), x1 = *(const f32x4*)(sp + d * 128 + c8 * 8 + 4);
            u32x4 w; w.x = cvtpk(x0[0], x0[1]); w.y = cvtpk(x0[2], x0[3]); w.z = cvtpk(x1[0], x1[1]); w.w = cvtpk(x1[2], x1[3]);
            *(LAS u32x4*)(lds + (dir ? R3_SB : R3_SF) + v_st<128>(d, c8 * 8)) = w; } }
    __syncthreads();
    const int qb = wid & 3, dvh = wid >> 2, ipos = 32 * qb + r32;
    bf16x8 qr[4]; att::load_q<64>(qr, PROJ + (size_t)(row0 + ipos) * ODD_IN + PQ + h * 64, hi);
    f32x16 o[2]; o[0] = (f32x16){}; o[1] = (f32x16){};
    const unsigned vbase = (unsigned)(uintptr_t)lds + (unsigned)v_rd_base(lane) + dvh * 1024;
#pragma unroll
    for (int T = 0; T < 2; ++T) {
        f32x16 p0, p1; att::qkt<64>(p0, p1, lds + R3_K + T * R3_KB, qr, r32, hi);
#pragma unroll
        for (int r = 0; r < 16; ++r) {
            const int j0 = 64 * T + crow(r, hi), j1 = j0 + 32;
            const float w0 = (j0 <= ipos) ? __builtin_amdgcn_exp2f(lgf * (float)(ipos - j0)) : __builtin_amdgcn_exp2f(lgb * (float)(j0 - ipos));
            const float w1 = (j1 <= ipos) ? __builtin_amdgcn_exp2f(lgf * (float)(ipos - j1)) : __builtin_amdgcn_exp2f(lgb * (float)(j1 - ipos));
            p0[r] *= KSCALE * w0; p1[r] *= KSCALE * w1;
        }
        bf16x8 pa0, pa1, pa2, pa3; att::pack_p(p0, p1, pa0, pa1, pa2, pa3);
        att::pv_one<128, 0>(o[0], vbase + R3_V + T * 16384, pa0, pa1, pa2, pa3); att::pv_one<128, 1>(o[1], vbase + R3_V + T * 16384, pa0, pa1, pa2, pa3);
    }
#pragma unroll
    for (int dir = 0; dir < 2; ++dir) {
        const float sc = dir ? __builtin_amdgcn_exp2f(lgb * (float)(128 - ipos)) : __builtin_amdgcn_exp2f(lgf * (float)(ipos + 1));
        bf16x8 pa[4];
#pragma unroll
        for (int s = 0; s < 4; ++s) { const u32x4 w = __builtin_bit_cast(u32x4, qr[s]); u32x4 x;
            x.x = cvtpk(bf_lo(w.x) * sc, bf_hi(w.x) * sc); x.y = cvtpk(bf_lo(w.y) * sc, bf_hi(w.y) * sc); x.z = cvtpk(bf_lo(w.z) * sc, bf_hi(w.z) * sc); x.w = cvtpk(bf_lo(w.w) * sc, bf_hi(w.w) * sc);
            pa[s] = __builtin_bit_cast(bf16x8, x); }
        const unsigned sb = vbase + (dir ? R3_SB : R3_SF);
        att::pv_one<128, 0>(o[0], sb, pa[0], pa[1], pa[2], pa[3]); att::pv_one<128, 1>(o[1], sb, pa[0], pa[1], pa[2], pa[3]);
    }
    LAS float* red = (LAS float*)(lds + R3_RED);
    float ss[16];
#pragma unroll
    for (int r = 0; r < 16; ++r) { float s = o[0][r] * o[0][r] + o[1][r] * o[1][r];
#pragma unroll
        for (int x = 1; x < 32; x <<= 1) s += __shfl_xor(s, x);
        ss[r] = s; }
    if (r32 == 0) {
#pragma unroll
        for (int r = 0; r < 16; ++r) red[(qb * 2 + dvh) * 32 + crow(r, hi)] = ss[r];
    }
    __syncthreads();
#pragma unroll
    for (int r = 0; r < 16; ++r) {
        const int q = crow(r, hi);
        const float tot = red[(qb * 2 + 0) * 32 + q] + red[(qb * 2 + 1) * 32 + q];
        const float rs = rsqrtf(tot * (1.0f / 128.0f) + RMS_EPS);
        const int row = row0 + 32 * qb + q;
#pragma unroll
        for (int d = 0; d < 2; ++d) {
            const int dv = 64 * dvh + 32 * d + r32;
            const float gt = bf2f(PROJ[(size_t)row * ODD_IN + PG_ + h * 128 + dv]);
            ATT[(size_t)row * 1024 + 512 + h * 128 + dv] = (bf16_t)f2bf(o[d][r] * rs * silu_f(gt));
        }
    }
    __syncthreads();
}
}
__device__ __forceinline__ void phase_prologue(const Params& P, LAS unsigned char* lds) {
    const int tid = opaque_tid();
    constexpr int N_MODS = 192, IT_TAB = N_MODS, IT_ZERO = N_MODS + 1, IT_SMALL = N_MODS + 2, IT_MOE = IT_SMALL + SMALL_TILES, IT_END = IT_MOE + MOE_TILES;
    for (int it = blockIdx.x; it < IT_END; it += gridDim.x) {
        if (it < N_MODS) mods_item(P, it, (LAS float*)lds, (LAS float*)(lds + 9 * 1024 * 4), tid);
        else if (it == IT_TAB) tables_item(P, tid);
        else if (it == IT_ZERO) { u32x4* z = (u32x4*)((bf16_t*)(P.ws + WS_W_OIN) + (size_t)1952 * 1024); for (int i = tid; i < 96 * 1024 / 8; i += NTHREADS) z[i] = (u32x4){0u, 0u, 0u, 0u}; }
        else if (it < IT_MOE) convert_small_item(P, it - IT_SMALL, (LAS float*)lds, tid);
        else convert_moe_item(P, 0, it - IT_MOE, (LAS float*)lds, tid);
    }
}
__device__ __forceinline__ void phase_attn_even(const Params& P, LAS unsigned char* lds) {
    constexpr int N_DIFF = 512, N_DIFFC = 32, N_NA = 1024, N_NAC = 64, N_ALL = N_DIFF + N_DIFFC + N_NA + N_NAC;
    for (int u = blockIdx.x; u < N_ALL; u += gridDim.x) {
        int r = u;
        if (r < N_DIFF) { att::diff_unit(P, lds, r >> 6, (r >> 4) & 3, r & 15, false); continue; } r -= N_DIFF;
        if (r < N_DIFFC) { att::diff_unit(P, lds, r >> 2, r & 3, 0, true); continue; } r -= N_DIFFC;
        if (r < N_NA) { att::na_unit(P, lds, r >> 7, (r >> 4) & 7, r & 15, false); continue; } r -= N_NA;
        att::na_unit(P, lds, r >> 3, r & 7, 0, true);
    }
}
enum { K_PRO = 0, K_NORM1, K_GEMM, K_ATTN_EVEN, K_NORM2, K_TOPK, K_R1, K_MLA, K_R3, K_FINAL };
enum { J_EVEN_IN = 0, J_OUT0, J_UP0, J_DOWN0, J_ODD_IN, J_UPQ, J_UPKV, J_OUT1, J_UP1, J_DOWN1 };
constexpr int NSTEPS = 22;
__device__ __forceinline__ void step_desc(int step, int& kind, int& arg, bool& sync) {
    sync = true;
    switch (step) {
        case 0: kind = K_PRO; arg = 0; break;
        case 1: kind = K_NORM1; arg = 0; break;
        case 2: kind = K_GEMM; arg = J_EVEN_IN; break;
        case 3: kind = K_ATTN_EVEN; arg = 0; break;
        case 4: kind = K_GEMM; arg = J_OUT0; break;
        case 5: kind = K_NORM2; arg = 0; break;
        case 6: kind = K_TOPK; arg = 0; break;
        case 7: kind = K_GEMM; arg = J_UP0; break;
        case 8: kind = K_GEMM; arg = J_DOWN0; break;
        case 9: kind = K_NORM1; arg = 1; break;
        case 10: kind = K_GEMM; arg = J_ODD_IN; break;
        case 11: kind = K_GEMM; arg = J_UPQ; sync = false; break;
        case 12: kind = K_GEMM; arg = J_UPKV; sync = false; break;
        case 13: kind = K_R1; arg = 0; break;
        case 14: kind = K_MLA; arg = 0; break;
        case 15: kind = K_R3; arg = 0; break;
        case 16: kind = K_GEMM; arg = J_OUT1; break;
        case 17: kind = K_NORM2; arg = 1; break;
        case 18: kind = K_TOPK; arg = 1; break;
        case 19: kind = K_GEMM; arg = J_UP1; break;
        case 20: kind = K_GEMM; arg = J_DOWN1; break;
        default: kind = K_FINAL; arg = 0; break;
    }
}
__device__ __forceinline__ void gemm_job(const Params& P, int job, pg8::Gemm& g, pg8::Sched& S, pg8::Epi& E) {
    unsigned char* ws = P.ws;
    g.lda = 1024; g.ldb = 1024; g.K = 1024; E.layer = 0; E.slots = 4352; E.nNe = 1;
    switch (job) {
        case J_EVEN_IN: g.A = (const bf16_t*)(ws + WS_H); g.Bt = (const bf16_t*)(ws + WS_W_EIN); S.init(1, M_ALL / 256, 12); E.mode = pg8::EPI_EVEN_IN; break;
        case J_OUT0: g.A = (const bf16_t*)(ws + WS_ATT); g.Bt = (const bf16_t*)(ws + WS_W_EOUT); S.init(1, M_ALL / 256, 4); E.mode = pg8::EPI_OUT; break;
        case J_UP0: g.A = (const bf16_t*)(ws + WS_XE); g.Bt = (const bf16_t*)(ws + WS_W13); S.init(16, 17, 8); E.mode = pg8::EPI_MOE_UP; E.nNe = 8; break;
        case J_DOWN0: g.A = (const bf16_t*)(ws + WS_HID); g.Bt = (const bf16_t*)(ws + WS_W2T); S.init(16, 17, 4); E.mode = pg8::EPI_MOE_DOWN; E.nNe = 4; break;
        case J_ODD_IN: g.A = (const bf16_t*)(ws + WS_H); g.Bt = (const bf16_t*)(ws + WS_W_OIN); S.init(1, M_ALL / 256, 8); E.mode = pg8::EPI_ODD_IN; E.layer = 1; break;
        case J_UPQ: g.A = (const bf16_t*)(ws + WS_PROJ); g.Bt = (const bf16_t*)(ws + WS_W_UQ); g.lda = ODD_IN; g.ldb = 256; g.K = 256; S.init(1, M_LAT / 256, 3); E.mode = pg8::EPI_UPQ; E.layer = 1; break;
        case J_UPKV: g.A = (const bf16_t*)(ws + WS_PROJ) + 256; g.Bt = (const bf16_t*)(ws + WS_W_UKV); g.lda = ODD_IN; g.ldb = 128; g.K = 128; S.init(1, M_ALL / 256, 4); E.mode = pg8::EPI_UPKV; E.layer = 1; break;
        case J_OUT1: g.A = (const bf16_t*)(ws + WS_ATT); g.Bt = (const bf16_t*)(ws + WS_W_OOUT); S.init(1, M_ALL / 256, 4); E.mode = pg8::EPI_OUT; E.layer = 1; break;
        case J_UP1: g.A = (const bf16_t*)(ws + WS_XE); g.Bt = (const bf16_t*)(ws + WS_W13); S.init(16, 16, 8); E.mode = pg8::EPI_MOE_UP; E.nNe = 8; E.layer = 1; E.slots = 4096; break;
        default: g.A = (const bf16_t*)(ws + WS_HID); g.Bt = (const bf16_t*)(ws + WS_W2T); S.init(16, 16, 4); E.mode = pg8::EPI_MOE_DOWN; E.nNe = 4; E.layer = 1; E.slots = 4096; break;
    }
}

__global__ void __launch_bounds__(NTHREADS, 2) mega(Params P0) {
    extern __shared__ __attribute__((aligned(16))) unsigned char smem_[];
    LAS unsigned char* lds = (LAS unsigned char*)smem_;
    cg::grid_group grid = cg::this_grid();
    volatile LAS unsigned* st = (volatile LAS unsigned*)(lds + LDS_CTL_OFF);
    if (threadIdx.x < 16) st[threadIdx.x] = 0u;
    __syncthreads();
    XcdBarrier xb = xcd_barrier_post((unsigned*)(P0.ws + WS_CTL), st);
    grid.sync();
#pragma unroll 1
    for (int step = 0; step < NSTEPS; ++step) {
        int kind, arg; bool sync; step_desc(step, kind, arg, sync);
        Params Q = P0;
        asm volatile("" : "+s"(Q.ws), "+s"(Q.out));
#pragma unroll
        for (int i = 0; i < 25; ++i) asm volatile("" : "+s"(Q.in[i]));
        const Params& P = Q;
        if (kind == K_GEMM) { pg8::Gemm g; pg8::Sched S; pg8::Epi E; gemm_job(P, arg, g, S, E); pg8::gemm_phase(lds, g, S, P, E); }
        else if (kind == K_PRO) phase_prologue(P, lds);
        else if (kind == K_NORM1) { phase_norm1(P, arg); if (arg == 1) { const int tid = opaque_tid(); for (int it = blockIdx.x; it < MOE_TILES; it += gridDim.x) convert_moe_item(P, 1, it, (LAS float*)lds, tid); } }
        else if (kind == K_ATTN_EVEN) phase_attn_even(P, lds);
        else if (kind == K_NORM2) phase_norm2(P, arg, lds);
        else if (kind == K_TOPK) { const int ng = arg ? 128 : 256, slots = arg ? 4096 : 4352; for (int gq = blockIdx.x; gq < ng; gq += gridDim.x) topk_item(P, gq, slots, lds); }
        else if (kind == K_R1) { for (int u = blockIdx.x; u < 32 * 34; u += gridDim.x) ret::r1_unit(P, lds, u / 34, u % 34); }
        else if (kind == K_MLA) { ret::r2_scan(P); for (int u = blockIdx.x; u < 1024; u += gridDim.x) att::mla_unit(P, lds, u >> 7, (u >> 4) & 7, u & 15); }
        else if (kind == K_R3) { for (int u = blockIdx.x; u < 1024; u += gridDim.x) ret::r3_unit(P, lds, u >> 5, u & 31); }
        else phase_final(P);
        if (sync) xcd_barrier(xb);
    }
}

extern "C" void kernel_launch(void* const* d_in, const int* in_sizes, int n_in, void* d_out, int out_size, void* d_ws, size_t ws_size, hipStream_t stream) {
    static int grid_blocks = 0;
    if (!grid_blocks) {
        int dev = 0, cus = 0, per_cu = 0;
        (void)hipGetDevice(&dev);
        (void)hipDeviceGetAttribute(&cus, hipDeviceAttributeMultiprocessorCount, dev);
        (void)hipFuncSetAttribute((const void*)mega, hipFuncAttributeMaxDynamicSharedMemorySize, LDS_BYTES);
        (void)hipOccupancyMaxActiveBlocksPerMultiprocessor(&per_cu, mega, NTHREADS, LDS_BYTES);
        if (per_cu < 1) { fprintf(stderr, "mega: occupancy query returned %d\n", per_cu); per_cu = 1; }
        grid_blocks = cus;
        if (ws_size < WS_END || n_in != 25) fprintf(stderr, "mega: ws_size %zu < %zu or n_in %d != 25\n", ws_size, (size_t)WS_END, n_in);
    }
    Params p{};
    for (int i = 0; i < 25; ++i) p.in[i] = (const float*)d_in[i];
    p.out = (float*)d_out; p.ws = (unsigned char*)d_ws; p.pad = 0;
    (void)hipMemsetAsync(d_ws, 0, 16384, stream);
    void* args[] = {&p};
    hipError_t e = hipLaunchCooperativeKernel((const void*)mega, dim3(grid_blocks), dim3(NTHREADS), args, LDS_BYTES, stream);
    if (e != hipSuccess) fprintf(stderr, "cooperative launch failed: %s (grid %d)\n", hipGetErrorString(e), grid_blocks);
}
```

```cpp
#include <hip/hip_runtime.h>
#include <hip/hip_cooperative_groups.h>
#include <cstdio>
#include <cstdint>
namespace cg = cooperative_groups;

#define LAS __attribute__((address_space(3)))
typedef unsigned short bf16_t;
typedef short bf16x8 __attribute__((ext_vector_type(8)));
typedef short s16x4 __attribute__((ext_vector_type(4)));
typedef float f32x4 __attribute__((ext_vector_type(4)));
typedef float f32x16 __attribute__((ext_vector_type(16)));
typedef unsigned u32x4 __attribute__((ext_vector_type(4)));
typedef unsigned u32x2 __attribute__((ext_vector_type(2)));

constexpr int NTHREADS = 512;
constexpr int LDS_BYTES = 147456;
constexpr int LDS_CTL_OFF = 147456 - 64;

constexpr int NB = 8, SEQ = 4096, LC = 256, DM = 1024;
constexpr int M_LAT = NB * SEQ, M_CTX = NB * LC, M_ALL = M_LAT + M_CTX;
constexpr int EVEN_IN = 3072, ODD_IN = 1952;
constexpr float RMS_EPS = 1e-6f;
constexpr float LOG2E = 1.4426950408889634f;

constexpr size_t MiB = 1u << 20;
constexpr size_t WS_CTL = 0;
constexpr size_t WS_MODS = 1 * MiB;
constexpr size_t WS_ROPE16 = 1 * MiB + 512 * 1024;
constexpr size_t WS_ROPE8 = WS_ROPE16 + 8192;
constexpr size_t WS_MISC = WS_ROPE8 + 4096;
constexpr size_t WS_PTRS = WS_MISC + 4096;
constexpr size_t WS_PARTQ = 2 * MiB;
constexpr size_t WS_PARTKV = 3 * MiB;
constexpr size_t WS_AFF_LAT = 4 * MiB;
constexpr size_t WS_AFF_CTX = 6 * MiB;
constexpr size_t WS_IDX = 7 * MiB;
constexpr size_t WS_GATE = 7 * MiB + 512 * 1024;
constexpr size_t WS_INV = 8 * MiB;
constexpr size_t WS_XC = 11 * MiB;
constexpr size_t WS_W_EIN = 20 * MiB;
constexpr size_t WS_W_EOUT = 26 * MiB;
constexpr size_t WS_W_OIN = 28 * MiB;
constexpr size_t WS_W_OOUT = 32 * MiB;
constexpr size_t WS_W_UQ = 34 * MiB;
constexpr size_t WS_W_UKV = 34 * MiB + 512 * 1024;
constexpr size_t WS_W13 = 36 * MiB;
constexpr size_t WS_W2T = 100 * MiB;
constexpr size_t WS_H = 132 * MiB;
constexpr size_t WS_BIG = 200 * MiB;
constexpr size_t WS_ATT = 404 * MiB;
constexpr size_t WS_RET = 472 * MiB;
constexpr size_t WS_END = 540 * MiB;
constexpr size_t WS_PROJ = WS_BIG;
constexpr size_t WS_KVM = WS_BIG + 130 * MiB;
constexpr size_t WS_KR = WS_BIG + 198 * MiB;
constexpr size_t WS_QM = WS_H;
constexpr size_t WS_XE = WS_BIG;
constexpr size_t WS_HID = WS_BIG + 136 * MiB;
constexpr size_t WS_Y = WS_XE;
constexpr size_t WS_YMIX = WS_BIG;
static_assert((size_t)M_ALL * 1952 * 2 <= 130 * MiB, "PROJ fits");
static_assert(WS_HID + (size_t)16 * 4352 * 1024 * 2 <= WS_RET, "HID fits");

enum { I_X = 0, I_C, I_CTX, I_CCTX, I_ADAW, I_ADAB, I_NMIX, I_NFFN, I_FNORM, I_EWIN, I_EWOUT, I_DLAM, I_SUBLN, I_RPB, I_OWIN, I_OWOUT,
       I_QNORM, I_WUQ, I_KVNORM, I_WUKV, I_DECAY, I_ROUTER, I_W1, I_W3, I_W2 };

struct KArgs {
    const float* in[25];
    float* out;
    unsigned char* ws;
    unsigned long long pad;
};
#if defined(__HIP_DEVICE_COMPILE__)
#define GAS __attribute__((address_space(1)))
#else
#define GAS
#endif
typedef GAS const float* gin_t;
struct Params {
    const gin_t GAS* in;
    GAS float* out;
    GAS unsigned char* ws;
};

constexpr unsigned WAVE_TAB_LDS = 143872;
__device__ __forceinline__ unsigned hw_wave_slot() { return (unsigned)__builtin_amdgcn_s_getreg((5 << 11) | 4) & 63u; }
__device__ __forceinline__ int opaque_tid() {
    const int lane = (int)__builtin_amdgcn_mbcnt_hi(~0u, __builtin_amdgcn_mbcnt_lo(~0u, 0u));
    int w = ((volatile LAS int*)(uintptr_t)WAVE_TAB_LDS)[hw_wave_slot()];
    w = __builtin_amdgcn_readfirstlane(w);
    int t = (w << 6) | lane; asm volatile("" : "+v"(t)); return t;
}
__device__ __forceinline__ unsigned f2bf(float f) { unsigned u = __builtin_bit_cast(unsigned, f); return (u + 0x7fffu + ((u >> 16) & 1u)) >> 16; }
__device__ __forceinline__ unsigned pk2(float lo, float hi) { return f2bf(lo) | (f2bf(hi) << 16); }
__device__ __forceinline__ unsigned cvtpk(float lo, float hi) { unsigned r; asm volatile("v_cvt_pk_bf16_f32 %0, %1, %2" : "=v"(r) : "v"(lo), "v"(hi)); return r; }
__device__ __forceinline__ float bf_lo(unsigned w) { return __uint_as_float(w << 16); }
__device__ __forceinline__ float bf_hi(unsigned w) { return __uint_as_float(w & 0xffff0000u); }
__device__ __forceinline__ float bf2f(bf16_t x) { return __uint_as_float(((unsigned)x) << 16); }
template <int M> __device__ __forceinline__ float xshfl(float v) {
    if constexpr (M == 32) { auto rr = __builtin_amdgcn_permlane32_swap(__float_as_uint(v), __float_as_uint(v), false, false); const int lane = (int)__builtin_amdgcn_mbcnt_hi(~0u, __builtin_amdgcn_mbcnt_lo(~0u, 0u)); return __uint_as_float(lane < 32 ? rr[1] : rr[0]); }
    else return __int_as_float(__builtin_amdgcn_ds_swizzle(__float_as_int(v), (M << 10) | 0x1F));
}
__device__ __forceinline__ float wave_sum(float v) {
    v += xshfl<1>(v); v += xshfl<2>(v); v += xshfl<4>(v); v += xshfl<8>(v); v += xshfl<16>(v);
    { auto rr = __builtin_amdgcn_permlane32_swap(__float_as_uint(v), __float_as_uint(v), false, false); v = __uint_as_float(rr[0]) + __uint_as_float(rr[1]); }
    return v;
}
__device__ __forceinline__ float silu_f(float v) { return v / (1.0f + __expf(-v)); }
__device__ __forceinline__ int crow(int r, int hi) { return (r & 3) + 8 * (r >> 2) + 4 * hi; }
__device__ __forceinline__ int sigma32(int p) { return (p < 8 || p >= 24) ? p : (p < 16 ? p + 8 : p - 8); }

#define XB_TMO      128
#define XB_XCNT(j)  (256  + 64 * (j))
#define XB_XSUB(j)  (1280 + 64 * (j))
#define XB_XGEN(j)  (2304 + 64 * (j))
#define XB_TOP      3328
#define XB_TOPGEN   3392
#define XCD_BAR_WORDS 3456
#define XB_SPIN_CAP (1u << 21)
__device__ __forceinline__ unsigned xb_ld(unsigned* p)              { return __hip_atomic_load(p, __ATOMIC_RELAXED, __HIP_MEMORY_SCOPE_AGENT); }
__device__ __forceinline__ unsigned xb_add(unsigned* p, unsigned v) { return __hip_atomic_fetch_add(p, v, __ATOMIC_RELAXED, __HIP_MEMORY_SCOPE_AGENT); }
__device__ __forceinline__ unsigned xb_xcc_id() { return (unsigned)__builtin_amdgcn_s_getreg((3 << 11) | 20) & 0xFu; }
#define XB_SPIN(cond, bar) do { unsigned _sp = 0; while (cond) { __builtin_amdgcn_s_sleep(1); \
    if ((++_sp & 255u) == 0u) { if (xb_ld(&(bar)[XB_TMO])) break; if (_sp > XB_SPIN_CAP) { atomicAdd(&(bar)[XB_TMO], 1u); break; } } } } while (0)
struct XcdBarrier { unsigned* bar; unsigned x; volatile LAS unsigned* st; };
__device__ __forceinline__ XcdBarrier xcd_barrier_post(unsigned* bar, volatile LAS unsigned* st) {
    XcdBarrier b; b.bar = bar; b.x = xb_xcc_id(); b.st = st;
    if (threadIdx.x == 0) (void)xb_add(&bar[XB_XCNT(b.x)], 1u);
    return b;
}
__device__ __forceinline__ void xcd_barrier_complete(unsigned* bar, unsigned x, unsigned& nloc, unsigned& nx) {
    const unsigned G = gridDim.x * gridDim.y * gridDim.z;
    unsigned sum, cnt, mine, sp = 0u;
    for (;;) {
        sum = 0u; cnt = 0u; mine = 0u;
#pragma unroll
        for (unsigned j = 0; j < 16; ++j) { const unsigned c = xb_ld(&bar[XB_XCNT(j)]); sum += c; cnt += (c > 0u) ? 1u : 0u; mine = (j == x) ? c : mine; }
        if (sum == G) break;
        __builtin_amdgcn_s_sleep(1);
        if ((++sp & 255u) == 0u) { if (xb_ld(&bar[XB_TMO])) break; if (sp > XB_SPIN_CAP) { atomicAdd(&bar[XB_TMO], 1u); break; } }
    }
    nloc = mine > 0u ? mine : 1u; nx = cnt > 0u ? cnt : 1u;
}
__device__ __forceinline__ void xcd_barrier(const XcdBarrier& b) {
    asm volatile("s_waitcnt vmcnt(0)" ::: "memory");
    __syncthreads();
    if (opaque_tid() == 0) {
        unsigned* bar = b.bar;
        __builtin_amdgcn_s_waitcnt(0);
        unsigned nloc = b.st[0], nx = b.st[1];
        if (nloc == 0u) { xcd_barrier_complete(bar, b.x, nloc, nx); b.st[0] = nloc; b.st[1] = nx; }
        const unsigned old = xb_add(&bar[XB_XSUB(b.x)], 1u);
        const unsigned gen = old / nloc;
        if (old + 1u == (gen + 1u) * nloc) {
            __builtin_amdgcn_fence(__ATOMIC_RELEASE, "agent");
            asm volatile("s_waitcnt vmcnt(0)" ::: "memory");
            const unsigned og = xb_add(&bar[XB_TOP], 1u);
            const unsigned tg = og / nx;
            if (og + 1u == (tg + 1u) * nx) xb_add(&bar[XB_TOPGEN], 1u);
            else XB_SPIN(xb_ld(&bar[XB_TOPGEN]) == tg, bar);
            __builtin_amdgcn_fence(__ATOMIC_ACQUIRE, "agent");
            xb_add(&bar[XB_XGEN(b.x)], 1u);
            asm volatile("s_waitcnt vmcnt(0)" ::: "memory");
        } else {
            XB_SPIN(xb_ld(&bar[XB_XGEN(b.x)]) == gen, bar);
            __builtin_amdgcn_fence(__ATOMIC_ACQUIRE, "agent");
            asm volatile("s_waitcnt vmcnt(0)" ::: "memory");
        }
    }
    __syncthreads();
}

__device__ __forceinline__ int pos16(int q) { const int n = q >> 4, r = q & 15; return 8 * (r >> 2) + 4 * n + (r & 3); }
__device__ __forceinline__ int pos8(int q) { const int blk = q >> 3, r = q & 7, n = blk & 1, fq = 2 * (blk >> 1) + (r >> 2); return 8 * fq + 4 * n + (r & 3); }
__device__ __forceinline__ int maprow(int n, int mode) {
    if (mode == 1) return (n >> 7) * 256 + (n & 127);
    if (mode == 2) return (n >> 7) * 256 + 128 + (n & 127);
    if (mode == 3) return (n >= 384 && n < 416) ? 384 + pos8(n - 384) : n;
    if (mode == 4) { const int h = n / 96, j = n - h * 96; return (j >= 64) ? h * 96 + 64 + pos8(j - 64) : n; }
    if (mode == 5) return (n < 1024) ? (n & ~31) + pos16(n & 31) : n;
    return n;
}
struct TDesc { const float* src; bf16_t* dst; const float* kscale; int ldsrc, Nvalid, k0, n0, lddst, mode; };
constexpr int TT_TILE_F = 64 * 65;
__device__ __forceinline__ void tt_load(const TDesc (&d)[4], int nvalid, f32x4 (&v)[4][2], int tid) {
#pragma unroll
    for (int t = 0; t < 4; ++t)
#pragma unroll
        for (int i = 0; i < 2; ++i) {
            const int k = (tid >> 4) + 32 * i, n4 = (tid & 15) * 4;
            v[t][i] = (f32x4){0.f, 0.f, 0.f, 0.f};
            if (t < nvalid && d[t].n0 + n4 < d[t].Nvalid) v[t][i] = *(const f32x4*)(d[t].src + (size_t)(d[t].k0 + k) * d[t].ldsrc + d[t].n0 + n4);
        }
}
__device__ __forceinline__ void tt_finish(const TDesc (&d)[4], int nvalid, const f32x4 (&v)[4][2], LAS float* tiles, int tid) {
#pragma unroll
    for (int t = 0; t < 4; ++t)
#pragma unroll
        for (int i = 0; i < 2; ++i) {
            const int k = (tid >> 4) + 32 * i, n4 = (tid & 15) * 4;
            f32x4 x = v[t][i];
            if (t < nvalid && d[t].kscale) { const float sc = d[t].kscale[d[t].k0 + k]; x = x * sc; }
            LAS float* tp = tiles + t * TT_TILE_F + k * 65 + n4;
            tp[0] = x[0]; tp[1] = x[1]; tp[2] = x[2]; tp[3] = x[3];
        }
    __syncthreads();
#pragma unroll
    for (int t = 0; t < 4; ++t) {
        const int n = tid >> 3, kc = (tid & 7) * 8;
        if (t < nvalid && d[t].n0 + n < d[t].Nvalid) {
            const LAS float* tp = tiles + t * TT_TILE_F + kc * 65 + n;
            u32x4 w;
            w.x = pk2(tp[0 * 65], tp[1 * 65]); w.y = pk2(tp[2 * 65], tp[3 * 65]); w.z = pk2(tp[4 * 65], tp[5 * 65]); w.w = pk2(tp[6 * 65], tp[7 * 65]);
            *(u32x4*)(d[t].dst + (size_t)maprow(d[t].n0 + n, d[t].mode) * d[t].lddst + d[t].k0 + kc) = w;
        }
    }
    __syncthreads();
}
constexpr int SMALL_TILES = 768 + 256 + 496 + 256 + 48 + 32;
__device__ __forceinline__ TDesc small_desc(const Params& P, int idx) {
    unsigned char* ws = P.ws; TDesc d; d.kscale = nullptr; d.mode = 0; d.lddst = 1024;
    if (idx < 768) { d.src = P.in[I_EWIN]; d.ldsrc = 3072; d.Nvalid = 3072; d.k0 = (idx / 48) * 64; d.n0 = (idx % 48) * 64; d.dst = (bf16_t*)(ws + WS_W_EIN); d.mode = 5; return d; } idx -= 768;
    if (idx < 256) { d.src = P.in[I_EWOUT]; d.ldsrc = 1024; d.Nvalid = 1024; d.k0 = (idx / 16) * 64; d.n0 = (idx % 16) * 64; d.dst = (bf16_t*)(ws + WS_W_EOUT); return d; } idx -= 256;
    if (idx < 496) { d.src = P.in[I_OWIN]; d.ldsrc = 1952; d.Nvalid = 1952; d.k0 = (idx / 31) * 64; d.n0 = (idx % 31) * 64; d.dst = (bf16_t*)(ws + WS_W_OIN); d.mode = 3; return d; } idx -= 496;
    if (idx < 256) { d.src = P.in[I_OWOUT]; d.ldsrc = 1024; d.Nvalid = 1024; d.k0 = (idx / 16) * 64; d.n0 = (idx % 16) * 64; d.dst = (bf16_t*)(ws + WS_W_OOUT); return d; } idx -= 256;
    if (idx < 48) { d.src = P.in[I_WUQ]; d.ldsrc = 768; d.Nvalid = 768; d.k0 = (idx / 12) * 64; d.n0 = (idx % 12) * 64; d.dst = (bf16_t*)(ws + WS_W_UQ); d.lddst = 256; d.mode = 4; d.kscale = P.in[I_QNORM]; return d; } idx -= 48;
    d.src = P.in[I_WUKV]; d.ldsrc = 1024; d.Nvalid = 1024; d.k0 = (idx / 16) * 64; d.n0 = (idx % 16) * 64; d.dst = (bf16_t*)(ws + WS_W_UKV); d.lddst = 128; d.kscale = P.in[I_KVNORM]; return d;
}
constexpr int MOE_TILES = 16 * 3 * 256;
__device__ __forceinline__ TDesc moe_desc(const Params& P, int layer, int idx) {
    const int e = idx / 768, r = idx - e * 768, which = r >> 8, t = r & 255;
    const size_t moff = ((size_t)layer * 16 + e) * 1024 * 1024;
    TDesc d; d.kscale = nullptr; d.ldsrc = 1024; d.Nvalid = 1024; d.k0 = (t >> 4) * 64; d.n0 = (t & 15) * 64; d.lddst = 1024;
    if (which == 0) { d.src = P.in[I_W1] + moff; d.dst = (bf16_t*)(P.ws + WS_W13) + (size_t)e * 2048 * 1024; d.mode = 1; }
    else if (which == 1) { d.src = P.in[I_W3] + moff; d.dst = (bf16_t*)(P.ws + WS_W13) + (size_t)e * 2048 * 1024; d.mode = 2; }
    else { d.src = P.in[I_W2] + moff; d.dst = (bf16_t*)(P.ws + WS_W2T) + (size_t)e * 1024 * 1024; d.mode = 0; }
    return d;
}
__device__ __forceinline__ void convert_weights(const Params& P, int layer, bool with_small, LAS float* tiles, int tid) {
    const int nsmall = with_small ? SMALL_TILES : 0, total = nsmall + MOE_TILES;
#define CW_DESCS(D, NV, BASE) do { NV = 0; _Pragma("unroll") for (int t = 0; t < 4; ++t) { const int idx_ = (BASE) + t; \
        if (idx_ < total) { D[t] = (idx_ < nsmall) ? small_desc(P, idx_) : moe_desc(P, layer, idx_ - nsmall); NV = t + 1; } else D[t] = D[0]; } } while (0)
    int base = blockIdx.x * 4;
    if (base >= total) return;
    TDesc d[4]; int nv; f32x4 v[4][2];
    CW_DESCS(d, nv, base); tt_load(d, nv, v, tid);
    for (;;) {
        const int nbase = base + gridDim.x * 4; const bool more = nbase < total;
        TDesc dn[4]; int nvn = 0; f32x4 vn[4][2];
        if (more) { CW_DESCS(dn, nvn, nbase); tt_load(dn, nvn, vn, tid); }
        tt_finish(d, nv, v, tiles, tid);
        if (!more) break;
#pragma unroll
        for (int t = 0; t < 4; ++t) { d[t] = dn[t]; v[t][0] = vn[t][0]; v[t][1] = vn[t][1]; }
        nv = nvn; base = nbase;
    }
#undef CW_DESCS
}
__device__ __forceinline__ void mods_item(const Params& P, int item, LAS float* S, LAS float* red, int tid) {
    const int l = item / 96, n0 = (item % 96) * 64;
    for (int i = tid; i < 9 * 1024; i += NTHREADS) { const int r = i >> 10, k = i & 1023; const float v = (r < 8) ? P.in[I_C][r * 1024 + k] : P.in[I_CCTX][k]; S[i] = v / (1.0f + __expf(-v)); }
    __syncthreads();
    const int kk = tid >> 6, col = tid & 63;
    float acc[9];
#pragma unroll
    for (int r = 0; r < 9; ++r) acc[r] = 0.f;
    const float* w = P.in[I_ADAW] + (size_t)l * 1024 * 6144 + n0 + col;
#pragma unroll 4
    for (int k = kk; k < 1024; k += 8) { const float wv = w[(size_t)k * 6144];
#pragma unroll
        for (int r = 0; r < 9; ++r) acc[r] += S[r * 1024 + k] * wv; }
#pragma unroll
    for (int r = 0; r < 9; ++r) red[(kk * 9 + r) * 64 + col] = acc[r];
    __syncthreads();
    float* mods = (float*)(P.ws + WS_MODS);
    for (int i = tid; i < 9 * 64; i += NTHREADS) { const int r = i >> 6, c = i & 63; float s = 0.f;
#pragma unroll
        for (int q = 0; q < 8; ++q) s += red[(q * 9 + r) * 64 + c];
        mods[(size_t)(l * 9 + r) * 6144 + n0 + c] = s + P.in[I_ADAB][l * 6144 + n0 + c]; }
    __syncthreads();
}
__device__ __forceinline__ void tables_item(const Params& P, int tid) {
    float* r16 = (float*)(P.ws + WS_ROPE16); float* r8 = (float*)(P.ws + WS_ROPE8); float* misc = (float*)(P.ws + WS_MISC);
    for (int i = tid; i < 64 * 16; i += NTHREADS) { const int pos = i >> 4, f = i & 15; const float fr = exp2f(-(float)f * (13.287712379549449f / 16.0f)); const float ang = (float)pos * fr;
        r16[2 * i] = cosf(ang); r16[2 * i + 1] = sinf(ang); }
    for (int i = tid; i < 64 * 8; i += NTHREADS) { const int pos = i >> 3, f = i & 7; const float fr = exp2f(-(float)f * (13.287712379549449f / 8.0f)); const float ang = (float)pos * fr;
        r8[2 * i] = cosf(ang); r8[2 * i + 1] = sinf(ang); }
    if (tid == 0) { const float* dl = P.in[I_DLAM]; float s1 = 0.f, s2 = 0.f;
        for (int i = 0; i < 64; ++i) { s1 += dl[i] * dl[64 + i]; s2 += dl[128 + i] * dl[192 + i]; }
        misc[0] = expf(s1) - expf(s2) + 0.2f; }
    if (tid >= 64 && tid < 72) { const float x = P.in[I_DECAY][tid - 64]; const float lg = -log1pf(expf(-x)); misc[8 + tid - 64] = lg * 1.4426950408889634f; }
}

struct Row16 { float v[16]; };
__device__ __forceinline__ Row16 ld_row_f32(const float* p, int lane) {
    Row16 r; const f32x4 a = *(const f32x4*)(p + lane * 8), b = *(const f32x4*)(p + lane * 8 + 4), c = *(const f32x4*)(p + 512 + lane * 8), d = *(const f32x4*)(p + 512 + lane * 8 + 4);
#pragma unroll
    for (int j = 0; j < 4; ++j) { r.v[j] = a[j]; r.v[4 + j] = b[j]; r.v[8 + j] = c[j]; r.v[12 + j] = d[j]; }
    return r;
}
__device__ __forceinline__ void st_row_f32(float* p, int lane, const Row16& r) {
    *(f32x4*)(p + lane * 8) = (f32x4){r.v[0], r.v[1], r.v[2], r.v[3]}; *(f32x4*)(p + lane * 8 + 4) = (f32x4){r.v[4], r.v[5], r.v[6], r.v[7]};
    *(f32x4*)(p + 512 + lane * 8) = (f32x4){r.v[8], r.v[9], r.v[10], r.v[11]}; *(f32x4*)(p + 512 + lane * 8 + 4) = (f32x4){r.v[12], r.v[13], r.v[14], r.v[15]};
}
__device__ __forceinline__ void st_row_bf16(bf16_t* p, int lane, const Row16& r) {
    u32x4 a, b; a.x = pk2(r.v[0], r.v[1]); a.y = pk2(r.v[2], r.v[3]); a.z = pk2(r.v[4], r.v[5]); a.w = pk2(r.v[6], r.v[7]);
    b.x = pk2(r.v[8], r.v[9]); b.y = pk2(r.v[10], r.v[11]); b.z = pk2(r.v[12], r.v[13]); b.w = pk2(r.v[14], r.v[15]);
    *(u32x4*)(p + lane * 8) = a; *(u32x4*)(p + 512 + lane * 8) = b;
}
__device__ __forceinline__ Row16 ld_row_bf16(const bf16_t* p, int lane) {
    const u32x4 a = *(const u32x4*)(p + lane * 8), b = *(const u32x4*)(p + 512 + lane * 8); Row16 r;
    r.v[0] = bf_lo(a.x); r.v[1] = bf_hi(a.x); r.v[2] = bf_lo(a.y); r.v[3] = bf_hi(a.y); r.v[4] = bf_lo(a.z); r.v[5] = bf_hi(a.z); r.v[6] = bf_lo(a.w); r.v[7] = bf_hi(a.w);
    r.v[8] = bf_lo(b.x); r.v[9] = bf_hi(b.x); r.v[10] = bf_lo(b.y); r.v[11] = bf_hi(b.y); r.v[12] = bf_lo(b.z); r.v[13] = bf_hi(b.z); r.v[14] = bf_lo(b.w); r.v[15] = bf_hi(b.w);
    return r;
}
__device__ __forceinline__ bf16_t* xres_row(const Params& P, int row) {
    return (row < M_LAT) ? (bf16_t*)P.out + (size_t)row * 2048 + 1024 : (bf16_t*)(P.ws + WS_XC) + (size_t)(row - M_LAT) * 1024;
}
__device__ __forceinline__ void add_row_bf16(Row16& r, const bf16_t* p, int lane, float s) {
    const u32x4 a = *(const u32x4*)(p + lane * 8), b = *(const u32x4*)(p + 512 + lane * 8);
    r.v[0] += s * bf_lo(a.x); r.v[1] += s * bf_hi(a.x); r.v[2] += s * bf_lo(a.y); r.v[3] += s * bf_hi(a.y);
    r.v[4] += s * bf_lo(a.z); r.v[5] += s * bf_hi(a.z); r.v[6] += s * bf_lo(a.w); r.v[7] += s * bf_hi(a.w);
    r.v[8] += s * bf_lo(b.x); r.v[9] += s * bf_hi(b.x); r.v[10] += s * bf_lo(b.y); r.v[11] += s * bf_hi(b.y);
    r.v[12] += s * bf_lo(b.z); r.v[13] += s * bf_hi(b.z); r.v[14] += s * bf_lo(b.w); r.v[15] += s * bf_hi(b.w);
}
__device__ __forceinline__ float row_rstd(const Row16& r) {
    float ss = 0.f;
#pragma unroll
    for (int j = 0; j < 16; ++j) ss += r.v[j] * r.v[j];
    ss = wave_sum(ss);
    return rsqrtf(ss * (1.0f / 1024.0f) + RMS_EPS);
}
__device__ __forceinline__ Row16 moe_combine(const Params& P, int row, int slots_per_e, int lane) {
    Row16 c;
#pragma unroll
    for (int j = 0; j < 16; ++j) c.v[j] = 0.f;
    const int* inv = (const int*)(P.ws + WS_INV) + (size_t)row * 16;
    const int mine = (lane < 16) ? inv[lane] : -1;
    const float gmine = (mine >= 0) ? ((const float*)(P.ws + WS_GATE))[lane * slots_per_e + mine] : 0.f;
    const bf16_t* Y = (const bf16_t*)(P.ws + WS_Y);
    unsigned mask = (unsigned)__ballot(mine >= 0) & 0xffffu;
    while (mask) {
        const int e0 = __builtin_ctz(mask); mask &= mask - 1;
        const int e1 = mask ? __builtin_ctz(mask) : -1; if (e1 >= 0) mask &= mask - 1;
        const int s0 = __builtin_amdgcn_readlane(mine, e0); const float g0 = __builtin_bit_cast(float, __builtin_amdgcn_readlane(__builtin_bit_cast(int, gmine), e0));
        float g1 = 0.f;
        const bf16_t* p0 = Y + ((size_t)e0 * slots_per_e + s0) * 1024;
        const u32x4 a0 = *(const u32x4*)(p0 + lane * 8), b0 = *(const u32x4*)(p0 + 512 + lane * 8);
        u32x4 a1 = {0u, 0u, 0u, 0u}, b1 = {0u, 0u, 0u, 0u};
        if (e1 >= 0) { const int s1 = __builtin_amdgcn_readlane(mine, e1); g1 = __builtin_bit_cast(float, __builtin_amdgcn_readlane(__builtin_bit_cast(int, gmine), e1)); const bf16_t* p1 = Y + ((size_t)e1 * slots_per_e + s1) * 1024; a1 = *(const u32x4*)(p1 + lane * 8); b1 = *(const u32x4*)(p1 + 512 + lane * 8); }
        const unsigned wa[8] = {a0.x, a0.y, a0.z, a0.w, b0.x, b0.y, b0.z, b0.w}, wb[8] = {a1.x, a1.y, a1.z, a1.w, b1.x, b1.y, b1.z, b1.w};
#pragma unroll
        for (int q = 0; q < 8; ++q) { c.v[2 * q] += g0 * bf_lo(wa[q]); c.v[2 * q + 1] += g0 * bf_hi(wa[q]); }
#pragma unroll
        for (int q = 0; q < 8; ++q) { c.v[2 * q] += g1 * bf_lo(wb[q]); c.v[2 * q + 1] += g1 * bf_hi(wb[q]); }
    }
    return c;
}
__device__ __forceinline__ void phase_norm1(const Params& P, int layer) {
    const int tid = opaque_tid(), wid = tid >> 6, lane = tid & 63;
    const int gw = blockIdx.x * 8 + wid, nw = gridDim.x * 8;
    const float* mods = (const float*)(P.ws + WS_MODS);
    bf16_t* H = (bf16_t*)(P.ws + WS_H);
    const Row16 gain = ld_row_f32(P.in[I_NMIX] + layer * 1024, lane);
    for (int row = gw; row < M_ALL; row += nw) {
        const bool lat = row < M_LAT; const int r9 = lat ? (row >> 12) : 8;
        Row16 x;
        if (layer == 0) x = ld_row_f32(lat ? P.in[I_X] + (size_t)row * 1024 : P.in[I_CTX] + (size_t)(row - M_LAT) * 1024, lane);
        else {
            bf16_t* xp = xres_row(P, row);
            x = ld_row_bf16(xp, lane);
            const Row16 cmb = moe_combine(P, row, 4352, lane);
            const Row16 g2 = ld_row_f32(mods + (size_t)(0 * 9 + r9) * 6144 + 5120, lane);
#pragma unroll
            for (int j = 0; j < 16; ++j) x.v[j] += g2.v[j] * cmb.v[j];
            st_row_bf16(xp, lane, x);
        }
        const float rs = row_rstd(x);
        const Row16 sh = ld_row_f32(mods + (size_t)(layer * 9 + r9) * 6144 + 0, lane), sc = ld_row_f32(mods + (size_t)(layer * 9 + r9) * 6144 + 1024, lane);
        Row16 h;
#pragma unroll
        for (int j = 0; j < 16; ++j) h.v[j] = x.v[j] * rs * gain.v[j] * (1.0f + sc.v[j]) + sh.v[j];
        st_row_bf16(H + (size_t)row * 1024, lane, h);
    }
}
__device__ __forceinline__ void phase_final(const Params& P) {
    const int tid = opaque_tid(), wid = tid >> 6, lane = tid & 63;
    const int gw = blockIdx.x * 8 + wid, nw = gridDim.x * 8;
    const float* mods = (const float*)(P.ws + WS_MODS);
    const Row16 gain = ld_row_f32(P.in[I_FNORM], lane);
    for (int row = gw; row < M_LAT; row += nw) {
        float* xp = P.out + (size_t)row * 1024;
        Row16 x = ld_row_bf16(xres_row(P, row), lane);
        const Row16 cmb = moe_combine(P, row, 4096, lane);
        const Row16 g2 = ld_row_f32(mods + (size_t)(1 * 9 + (row >> 12)) * 6144 + 5120, lane);
#pragma unroll
        for (int j = 0; j < 16; ++j) x.v[j] += g2.v[j] * cmb.v[j];
        const float rs = row_rstd(x);
#pragma unroll
        for (int j = 0; j < 16; ++j) x.v[j] = x.v[j] * rs * gain.v[j];
        st_row_f32(xp, lane, x);
    }
}
__device__ __forceinline__ int wr_off(int c) { return c * 16; }
__device__ __forceinline__ void phase_norm2(const Params& P, int layer, LAS unsigned char* lds) {
    const int tid = opaque_tid(), wid = tid >> 6, lane = tid & 63;
    const int gw = blockIdx.x * 8 + wid, nw = gridDim.x * 8;
    LAS float* wr = (LAS float*)lds;
    LAS float* hs = (LAS float*)(lds + 65536) + wid * 2048;
    const float* wsrc = P.in[I_ROUTER] + (size_t)layer * 1024 * 16;
    for (int i = tid; i < 1024 * 4; i += NTHREADS) { const int c = i >> 2, q = i & 3; const f32x4 v = *(const f32x4*)(wsrc + c * 16 + q * 4); *(LAS f32x4*)(wr + wr_off(c) + ((q ^ ((c >> 2) & 3)) * 4)) = v; }
    __syncthreads();
    const float* mods = (const float*)(P.ws + WS_MODS);
    bf16_t* H = (bf16_t*)(P.ws + WS_H);
    const Row16 gain = ld_row_f32(P.in[I_NFFN] + layer * 1024, lane);
    const int nrows = (layer == 0) ? M_ALL : M_LAT;
#define N2_ROW(ROW, HOFF) do { const int row_ = (ROW); \
        const bool lat = row_ < M_LAT; const int r9 = lat ? (row_ >> 12) : 8; \
        bf16_t* xo = xres_row(P, row_); \
        Row16 x; \
        if (layer == 0) x = ld_row_f32(lat ? P.in[I_X] + (size_t)row_ * 1024 : P.in[I_CTX] + (size_t)(row_ - M_LAT) * 1024, lane); else x = ld_row_bf16(xo, lane); \
        { const Row16 g1 = ld_row_f32(mods + (size_t)(layer * 9 + r9) * 6144 + 2048, lane); \
          Row16 y; _Pragma("unroll") for (int j = 0; j < 16; ++j) y.v[j] = 0.f; \
          add_row_bf16(y, (const bf16_t*)(P.ws + WS_YMIX) + (size_t)row_ * 1024, lane, 1.0f); \
          _Pragma("unroll") for (int j = 0; j < 16; ++j) x.v[j] += g1.v[j] * y.v[j]; } \
        st_row_bf16(xo, lane, x);           \
        const float rs = row_rstd(x); \
        const Row16 sh = ld_row_f32(mods + (size_t)(layer * 9 + r9) * 6144 + 3072, lane), sc = ld_row_f32(mods + (size_t)(layer * 9 + r9) * 6144 + 4096, lane); \
        Row16 h; \
        _Pragma("unroll") for (int j = 0; j < 16; ++j) h.v[j] = x.v[j] * rs * gain.v[j] * (1.0f + sc.v[j]) + sh.v[j]; \
        st_row_bf16(H + (size_t)row_ * 1024, lane, h); \
        LAS float* hsr = hs + (HOFF); \
        *(LAS f32x4*)(hsr + lane * 8) = (f32x4){h.v[0], h.v[1], h.v[2], h.v[3]}; *(LAS f32x4*)(hsr + lane * 8 + 4) = (f32x4){h.v[4], h.v[5], h.v[6], h.v[7]}; \
        *(LAS f32x4*)(hsr + 512 + lane * 8) = (f32x4){h.v[8], h.v[9], h.v[10], h.v[11]}; *(LAS f32x4*)(hsr + 512 + lane * 8 + 4) = (f32x4){h.v[12], h.v[13], h.v[14], h.v[15]}; } while (0)
#define N2_FINISH(ROW, LG) do { const int row_ = (ROW); const bool lat = row_ < M_LAT; \
        float h8[8], h4[4], h2[2], h1; \
        { const bool up = (lane & 32) != 0; \
          _Pragma("unroll") for (int q = 0; q < 8; ++q) { const float keep = up ? LG[8 + q] : LG[q], send = up ? LG[q] : LG[8 + q]; h8[q] = keep + xshfl<32>(send); } } \
        { const bool up = (lane & 16) != 0; \
          _Pragma("unroll") for (int q = 0; q < 4; ++q) { const float keep = up ? h8[4 + q] : h8[q], send = up ? h8[q] : h8[4 + q]; h4[q] = keep + xshfl<16>(send); } } \
        { const bool up = (lane & 8) != 0; \
          _Pragma("unroll") for (int q = 0; q < 2; ++q) { const float keep = up ? h4[2 + q] : h4[q], send = up ? h4[q] : h4[2 + q]; h2[q] = keep + xshfl<8>(send); } } \
        { const bool up = (lane & 4) != 0; const float keep = up ? h2[1] : h2[0], send = up ? h2[0] : h2[1]; h1 = keep + xshfl<4>(send); } \
        h1 += xshfl<1>(h1); h1 += xshfl<2>(h1); \
        float mx = h1; \
        mx = fmaxf(mx, xshfl<4>(mx)); mx = fmaxf(mx, xshfl<8>(mx)); mx = fmaxf(mx, xshfl<16>(mx)); mx = fmaxf(mx, xshfl<32>(mx)); \
        const float ex = __expf(h1 - mx); \
        float den = ex; \
        den += xshfl<4>(den); den += xshfl<8>(den); den += xshfl<16>(den); den += xshfl<32>(den); \
        const float mine = ex / den; \
        const int eid = ((lane >> 5) & 1) * 8 + ((lane >> 4) & 1) * 4 + ((lane >> 3) & 1) * 2 + ((lane >> 2) & 1); \
        if ((lane & 3) == 0) { \
            if (lat) ((float*)(P.ws + WS_AFF_LAT))[((size_t)((row_ >> 12) * 16 + eid)) * 4096 + (row_ & 4095)] = mine; \
            else { const int rc = row_ - M_LAT; ((float*)(P.ws + WS_AFF_CTX))[((size_t)((rc >> 8) * 16 + eid)) * 256 + (rc & 255)] = mine; } } } while (0)
#define N2_ROUTE2(ROWA, ROWB, TWO) do { \
        float lga[16], lgb[16]; \
        _Pragma("unroll") for (int e = 0; e < 16; ++e) { lga[e] = 0.f; lgb[e] = 0.f; } \
        _Pragma("unroll 4") for (int i = 0; i < 16; ++i) { \
            const int c = lane + 64 * i; const float ha = hs[c], hb = hs[1024 + c]; \
            const LAS f32x4* wp = (const LAS f32x4*)(wr + wr_off(c)); const int sx = (c >> 2) & 3; \
            const f32x4 w0 = wp[0 ^ sx], w1 = wp[1 ^ sx], w2 = wp[2 ^ sx], w3 = wp[3 ^ sx]; \
            _Pragma("unroll") for (int q = 0; q < 4; ++q) { lga[q] += ha * w0[q]; lga[4 + q] += ha * w1[q]; lga[8 + q] += ha * w2[q]; lga[12 + q] += ha * w3[q]; \
                                                            lgb[q] += hb * w0[q]; lgb[4 + q] += hb * w1[q]; lgb[8 + q] += hb * w2[q]; lgb[12 + q] += hb * w3[q]; } } \
        N2_FINISH(ROWA, lga); if (TWO) N2_FINISH(ROWB, lgb); } while (0)
    for (int row = gw; row < nrows; row += 2 * nw) {
        const bool two = row + nw < nrows;
        N2_ROW(row, 0);
        if (two) N2_ROW(row + nw, 1024);
        asm volatile("s_waitcnt lgkmcnt(0)" ::: "memory");
        N2_ROUTE2(row, row + nw, two);
        asm volatile("s_waitcnt lgkmcnt(0)" ::: "memory");
    }
#undef N2_ROW
#undef N2_FINISH
#undef N2_ROUTE2
}
__device__ __forceinline__ void topk_item(const Params& P, int group, int slots_per_e, LAS unsigned char* lds) {
    const int tid = opaque_tid(), wid = tid >> 6, lane = tid & 63;
    LAS unsigned* hist = (LAS unsigned*)lds;
    LAS unsigned* suf = hist + 256;
    LAS unsigned* ctl = suf + 256;
    LAS int* sel = (LAS int*)(ctl + 16);
    const bool isctx = group >= 128; const int g = group & 127, b = g >> 4, e = g & 15;
    const int T = isctx ? 256 : 4096, cap = T >> 3;
    const float* aff = isctx ? (const float*)(P.ws + WS_AFF_CTX) + (size_t)g * 256 : (const float*)(P.ws + WS_AFF_LAT) + (size_t)g * 4096;
    unsigned v[8];
#pragma unroll
    for (int i = 0; i < 8; ++i) { const int t = tid + NTHREADS * i; v[i] = (t < T) ? __float_as_uint(aff[t]) : 0u; }
    unsigned prefix = 0u, mask = 0u; int k = cap;
    for (int pass = 3; pass >= 0; --pass) {
        const int shift = pass * 8;
        if (tid < 256) hist[tid] = 0u;
        __syncthreads();
#pragma unroll
        for (int i = 0; i < 8; ++i) { const int t = tid + NTHREADS * i; if (t < T && (v[i] & mask) == prefix) atomicAdd((unsigned*)&hist[(v[i] >> shift) & 255u], 1u); }
        __syncthreads();
        if (tid < 256) suf[tid] = hist[tid];
        __syncthreads();
        for (int off = 1; off < 256; off <<= 1) {
            unsigned t2 = 0u;
            if (tid < 256 && tid + off < 256) t2 = suf[tid + off];
            __syncthreads();
            if (tid < 256) suf[tid] += t2;
            __syncthreads();
        }
        if (tid < 256) { const unsigned sj = suf[tid], sj1 = (tid < 255) ? suf[tid + 1] : 0u; if (sj >= (unsigned)k && sj1 < (unsigned)k) { ctl[0] = (unsigned)tid; ctl[1] = (unsigned)k - sj1; } }
        __syncthreads();
        prefix |= ctl[0] << shift; mask |= 255u << shift; k = (int)ctl[1];
        __syncthreads();
    }
    const unsigned thr = prefix; const int krem = k, ngt = cap - krem;
    int cgt = 0, ceq = 0;
#pragma unroll
    for (int i = 0; i < 8; ++i) { const int t = tid + NTHREADS * i; if (t < T) { cgt += (v[i] > thr) ? 1 : 0; ceq += (v[i] == thr) ? 1 : 0; } }
    int packed = cgt | (ceq << 16), incl = packed;
#pragma unroll
    for (int o = 1; o < 64; o <<= 1) { const int t2 = __builtin_amdgcn_ds_bpermute((lane - o) << 2, incl); if (lane >= o) incl += t2; }
    if (lane == 63) ctl[4 + wid] = (unsigned)incl;
    __syncthreads();
    int base = incl - packed;
    for (int w = 0; w < wid; ++w) base += (int)ctl[4 + w];
    int bgt = base & 0xffff, beq = base >> 16;
    int* IDX = (int*)(P.ws + WS_IDX); float* GATE = (float*)(P.ws + WS_GATE); int* INV = (int*)(P.ws + WS_INV);
    const int gslot0 = isctx ? 4096 + b * 32 : b * 512;
#pragma unroll
    for (int i = 0; i < 8; ++i) {
        const int t = tid + NTHREADS * i;
        if (t < T) {
            int slot = -1;
            if (v[i] > thr) slot = bgt++;
            else if (v[i] == thr) { const int r = beq++; if (r < krem) slot = ngt + r; }
            const int row = isctx ? M_LAT + b * 256 + t : b * 4096 + t;
            INV[(size_t)row * 16 + e] = (slot >= 0) ? gslot0 + slot : -1;
            if (slot >= 0) { IDX[e * slots_per_e + gslot0 + slot] = row; GATE[e * slots_per_e + gslot0 + slot] = __uint_as_float(v[i]); sel[slot] = row; }
        }
    }
    __syncthreads();
    __syncthreads();
}
namespace pg8 {
constexpr int BM = 256, BK = 64, HALF = 128, HTB = HALF * BK * 2, STAGE_BYTES = 8 * HTB;
__device__ __forceinline__ int lds_byte(int r, int c) { const int st = (r >> 4) * 2 + (c >> 5), rr = r & 15, cc = c & 31, ob = rr * 64 + cc * 2; return st * 1024 + (ob ^ (((ob >> 9) & 1) << 5)); }
__device__ __forceinline__ void stage_rc(int b, int& R, int& C) { const int st = b / 1024, sb = b % 1024, swz = sb ^ (((sb >> 9) & 1) << 5); R = (st >> 1) * 16 + swz / 64; C = (st & 1) * 32 + (swz % 64) / 2; }
__device__ __forceinline__ int perm32(int rho) { const int n = rho >> 4, i = rho & 15; return 8 * (i >> 2) + 4 * n + (i & 3); }
struct Unit { int pm, pn, hs, half; };
struct Gemm { const bf16_t* A; const bf16_t* Bt; int lda, ldb, K; };
struct Sched {
    int nUnits, tM, nN, G, c, nFull;
    __device__ __forceinline__ void init(int groups, int tM_, int nN_) { tM = tM_; nN = nN_; G = gridDim.x; c = (G % 8 == 0) ? (int)((blockIdx.x & 7) * (G / 8) + (blockIdx.x >> 3)) : (int)blockIdx.x;
        const int nTiles = groups * tM_ * nN_, R = nTiles % G;
        if (R > 0 && 2 * R <= G) { nFull = nTiles - R; nUnits = nFull + 2 * R; } else { nFull = nTiles; nUnits = nTiles; } }
    __device__ __forceinline__ bool next(int i, Unit& u) const {
        int L = i * G + c; if (L >= nUnits) return false;
        u.hs = 0; u.half = 0;
        if (L >= nFull) { const int h = L - nFull; L = nFull + (h >> 1); u.half = 1; u.hs = (h & 1) * 128; }
        const int per = tM * nN, e = L / per, r = L - e * per, pml = r / nN, pnl = r - pml * nN;
        u.pm = e * tM + pml; u.pn = e * nN + pnl; return true;
    }
};
enum { EPI_EVEN_IN = 0, EPI_OUT = 1, EPI_ODD_IN = 2, EPI_UPQ = 3, EPI_UPKV = 4, EPI_MOE_UP = 5, EPI_MOE_DOWN = 6 };
struct Epi { int mode; int layer; int nNe; int slots; };

__device__ __forceinline__ void epilogue(const Params& P, const Epi& E, const f32x4 (&acc)[2][2][4][2], const Unit& u) {
    const int tid_ = opaque_tid(), wid_ = __builtin_amdgcn_readfirstlane(tid_ >> 6), lane_ = tid_ & 63, wr = wid_ >> 2, wc = wid_ & 3, fr = lane_ & 15, fq = lane_ >> 4;
    unsigned char* ws = P.ws;
    if (E.mode == 99) return;
#define EPI_PACK8(W, A, B) do { W.x = cvtpk(A[0], A[1]); W.y = cvtpk(A[2], A[3]); W.z = cvtpk(B[0], B[1]); W.w = cvtpk(B[2], B[3]); } while (0)
#define EPI_ROT(A, B, CS, SN, RA, RB) do { _Pragma("unroll") for (int j = 0; j < 4; ++j) { RA[j] = A[j] * CS[j] - B[j] * SN[j]; RB[j] = B[j] * CS[j] + A[j] * SN[j]; } } while (0)
    if (E.mode == EPI_EVEN_IN) {
        bf16_t* O = (bf16_t*)(ws + WS_BIG); const float* rope = (const float*)(ws + WS_ROPE16);
        const int rowb = (u.pm * BM + u.hs) + wr * 64;
        bf16_t* rowp0 = O + (size_t)(rowb + fr) * EVEN_IN + u.pn * BM + wc * 32 + 8 * fq;
        const bool rot = ((u.pm * BM + u.hs) < M_LAT) && (u.pn < 4);
#define EPI_EVEN_STORE(CS, SN, AI, M_) do { _Pragma("unroll") for (int bj = 0; bj < 2; ++bj) { \
            const f32x4 a = acc[AI][bj][M_][0], b = acc[AI][bj][M_][1]; float ra[4], rb[4]; EPI_ROT(a, b, CS, SN, ra, rb); u32x4 w; EPI_PACK8(w, ra, rb); \
            *(u32x4*)(rowp0 + (size_t)((AI) * HALF + (M_) * 16) * EVEN_IN + bj * HALF) = w; } } while (0)
        if (!rot) {
#pragma unroll
            for (int ai = 0; ai < 2; ++ai) if (ai == 0 || !u.half)
#pragma unroll
                for (int m = 0; m < 4; ++m)
#pragma unroll
                    for (int bj = 0; bj < 2; ++bj) { const f32x4 a = acc[ai][bj][m][0], b = acc[ai][bj][m][1]; u32x4 w; EPI_PACK8(w, a, b);
                        *(u32x4*)(rowp0 + (size_t)(ai * HALF + m * 16) * EVEN_IN + bj * HALF) = w; }
        } else if (wc & 1) {
            f32x4 c01[4], c23[4];
#pragma unroll
            for (int m = 0; m < 4; ++m) { const f32x4* tp = (const f32x4*)(rope + (size_t)((m * 16 + fr) * 16 + 4 * fq) * 2); c01[m] = tp[0]; c23[m] = tp[1]; }
#pragma unroll
            for (int ai = 0; ai < 2; ++ai) if (ai == 0 || !u.half)
#pragma unroll
                for (int m = 0; m < 4; ++m) { const float cs[4] = {c01[m][0], c01[m][2], c23[m][0], c23[m][2]}, sn[4] = {c01[m][1], c01[m][3], c23[m][1], c23[m][3]}; EPI_EVEN_STORE(cs, sn, ai, m); }
        } else {
            f32x4 c01[2], c23[2];
#pragma unroll
            for (int ai = 0; ai < 2; ++ai) { const int pos = ((rowb + ai * HALF) & 4095) >> 6; const f32x4* tp = (const f32x4*)(rope + (size_t)(pos * 16 + 4 * fq) * 2); c01[ai] = tp[0]; c23[ai] = tp[1]; }
#pragma unroll
            for (int ai = 0; ai < 2; ++ai) if (ai == 0 || !u.half) { const float cs[4] = {c01[ai][0], c01[ai][2], c23[ai][0], c23[ai][2]}, sn[4] = {c01[ai][1], c01[ai][3], c23[ai][1], c23[ai][3]};
#pragma unroll
                for (int m = 0; m < 4; ++m) EPI_EVEN_STORE(cs, sn, ai, m); }
        }
#undef EPI_EVEN_STORE
    } else if (E.mode == EPI_OUT) {
        bf16_t* O = (bf16_t*)(ws + WS_YMIX);
#pragma unroll
        for (int ai = 0; ai < 2; ++ai) if (ai == 0 || !u.half)
#pragma unroll
            for (int m = 0; m < 4; ++m) {
                const int row = (u.pm * BM + u.hs) + ai * HALF + wr * 64 + m * 16 + fr;
                bf16_t* rowp = O + (size_t)row * 1024 + u.pn * BM + wc * 32 + 8 * fq;
#pragma unroll
                for (int bj = 0; bj < 2; ++bj) { const f32x4 a = acc[ai][bj][m][0], b = acc[ai][bj][m][1]; u32x4 w; EPI_PACK8(w, a, b); *(u32x4*)(rowp + bj * HALF) = w; }
            }
    } else if (E.mode == EPI_ODD_IN) {
        bf16_t* O = (bf16_t*)(ws + WS_PROJ); bf16_t* KR = (bf16_t*)(ws + WS_KR); const float* rope = (const float*)(ws + WS_ROPE8);
        float* partq = (float*)(ws + WS_PARTQ); float* partkv = (float*)(ws + WS_PARTKV);
#pragma unroll
        for (int ai = 0; ai < 2; ++ai) if (ai == 0 || !u.half)
#pragma unroll
            for (int m = 0; m < 4; ++m) {
                const int row = (u.pm * BM + u.hs) + ai * HALF + wr * 64 + m * 16 + fr;
                if (u.pn == 0) {
                    float s = 0.f;
#pragma unroll
                    for (int bj = 0; bj < 2; ++bj)
#pragma unroll
                        for (int n = 0; n < 2; ++n) { const f32x4 x = acc[ai][bj][m][n]; s += (x[0] * x[0] + x[1] * x[1]) + (x[2] * x[2] + x[3] * x[3]); }
                    s += xshfl<16>(s); s += xshfl<32>(s);
                    if (fq == 0) partq[(size_t)row * 4 + wc] = s;
                }
                if (u.pn == 1) {
                    float s = 0.f;
#pragma unroll
                    for (int n = 0; n < 2; ++n) { const f32x4 x = acc[ai][0][m][n]; s += (x[0] * x[0] + x[1] * x[1]) + (x[2] * x[2] + x[3] * x[3]); }
                    s += xshfl<16>(s); s += xshfl<32>(s);
                    if (fq == 0) partkv[(size_t)row * 4 + wc] = s;
                }
#pragma unroll
                for (int bj = 0; bj < 2; ++bj) {
                    const int colg = u.pn * BM + bj * HALF + wc * 32;
                    const f32x4 a = acc[ai][bj][m][0], b = acc[ai][bj][m][1];
                    if (colg == 384) {
                        const bool rot = row < M_LAT; const int t = row & 4095, pos = (fq >= 2) ? (t & 63) : (t >> 6);
                        f32x4 c01 = {1.f, 0.f, 1.f, 0.f}, c23 = {1.f, 0.f, 1.f, 0.f};
                        if (rot) { const f32x4* tp = (const f32x4*)(rope + (size_t)(pos * 8 + 4 * (fq & 1)) * 2); c01 = tp[0]; c23 = tp[1]; }
                        const float cs[4] = {c01[0], c01[2], c23[0], c23[2]}, sn[4] = {c01[1], c01[3], c23[1], c23[3]};
                        float ra[4], rb[4]; EPI_ROT(a, b, cs, sn, ra, rb);
                        u32x4 w; EPI_PACK8(w, ra, rb);
                        *(u32x4*)(KR + (size_t)row * 32 + 8 * fq) = w;
                    } else if (colg + 8 * fq < ODD_IN) { u32x4 w; EPI_PACK8(w, a, b); *(u32x4*)(O + (size_t)row * ODD_IN + colg + 8 * fq) = w; }
                }
            }
    } else if (E.mode == EPI_UPQ) {
        bf16_t* O = (bf16_t*)(ws + WS_QM); const float* rope = (const float*)(ws + WS_ROPE8); const float* partq = (const float*)(ws + WS_PARTQ);
        f32x4 pqa[8] = {};
#pragma unroll
        for (int g8 = 0; g8 < 8; ++g8) if (g8 < 4 || !u.half) pqa[g8] = *(const f32x4*)(partq + (size_t)((u.pm * BM + u.hs) + (g8 >> 2) * HALF + wr * 64 + (g8 & 3) * 16 + fr) * 4);
#pragma unroll
        for (int ai = 0; ai < 2; ++ai) if (ai == 0 || !u.half)
#pragma unroll
            for (int m = 0; m < 4; ++m) {
                const int row = (u.pm * BM + u.hs) + ai * HALF + wr * 64 + m * 16 + fr;
                const f32x4 pq = pqa[ai * 4 + m];
                const float rs = rsqrtf(((pq[0] + pq[1]) + (pq[2] + pq[3])) * (1.0f / 256.0f) + RMS_EPS);
                const int t = row & 4095, pos = (fq >= 2) ? (t & 63) : (t >> 6);
                const f32x4* tp = (const f32x4*)(rope + (size_t)(pos * 8 + 4 * (fq & 1)) * 2); f32x4 c01 = tp[0], c23 = tp[1];
                asm volatile("" : "+v"(c01), "+v"(c23));
                const float cs[4] = {c01[0], c01[2], c23[0], c23[2]}, sn[4] = {c01[1], c01[3], c23[1], c23[3]};
#pragma unroll
                for (int bj = 0; bj < 2; ++bj) {
                    const int colg = u.pn * BM + bj * HALF + wc * 32, grp = colg >> 5;
                    const f32x4 a = acc[ai][bj][m][0] * rs, b = acc[ai][bj][m][1] * rs;
                    u32x4 w;
                    if (grp % 3 == 2) { float ra[4], rb[4]; EPI_ROT(a, b, cs, sn, ra, rb); EPI_PACK8(w, ra, rb); }
                    else EPI_PACK8(w, a, b);
                    *(u32x4*)(O + (size_t)row * 768 + colg + 8 * fq) = w;
                }
            }
    } else if (E.mode == EPI_UPKV) {
        bf16_t* O = (bf16_t*)(ws + WS_KVM); const float* partkv = (const float*)(ws + WS_PARTKV);
        f32x4 pqa[8] = {};
#pragma unroll
        for (int g8 = 0; g8 < 8; ++g8) if (g8 < 4 || !u.half) pqa[g8] = *(const f32x4*)(partkv + (size_t)((u.pm * BM + u.hs) + (g8 >> 2) * HALF + wr * 64 + (g8 & 3) * 16 + fr) * 4);
#pragma unroll
        for (int ai = 0; ai < 2; ++ai) if (ai == 0 || !u.half)
#pragma unroll
            for (int m = 0; m < 4; ++m) {
                const int row = (u.pm * BM + u.hs) + ai * HALF + wr * 64 + m * 16 + fr;
                const f32x4 pq = pqa[ai * 4 + m];
                const float rs = rsqrtf(((pq[0] + pq[1]) + (pq[2] + pq[3])) * (1.0f / 128.0f) + RMS_EPS);
                bf16_t* rowp = O + (size_t)row * 1024 + u.pn * BM + wc * 32 + 8 * fq;
#pragma unroll
                for (int bj = 0; bj < 2; ++bj) { const f32x4 a = acc[ai][bj][m][0] * rs, b = acc[ai][bj][m][1] * rs; u32x4 w; EPI_PACK8(w, a, b); *(u32x4*)(rowp + bj * HALF) = w; }
            }
    } else if (E.mode == EPI_MOE_UP) {
        bf16_t* O = (bf16_t*)(ws + WS_HID); const int pnl = u.pn % E.nNe;
#pragma unroll
        for (int ai = 0; ai < 2; ++ai) if (ai == 0 || !u.half)
#pragma unroll
            for (int m = 0; m < 4; ++m) {
                const int row = (u.pm * BM + u.hs) + ai * HALF + wr * 64 + m * 16 + fr;
                float hv[8];
#pragma unroll
                for (int n = 0; n < 2; ++n)
#pragma unroll
                    for (int j = 0; j < 4; ++j) { const float a = acc[ai][0][m][n][j], b = acc[ai][1][m][n][j]; hv[n * 4 + j] = a * __builtin_amdgcn_rcpf(1.0f + __builtin_amdgcn_exp2f(-a * LOG2E)) * b; }
                u32x4 w; w.x = cvtpk(hv[0], hv[1]); w.y = cvtpk(hv[2], hv[3]); w.z = cvtpk(hv[4], hv[5]); w.w = cvtpk(hv[6], hv[7]);
                *(u32x4*)(O + (size_t)row * 1024 + pnl * 128 + wc * 32 + 8 * fq) = w;
            }
    } else {
        bf16_t* O = (bf16_t*)(ws + WS_Y); const int pnl = u.pn % E.nNe;
#pragma unroll
        for (int ai = 0; ai < 2; ++ai) if (ai == 0 || !u.half)
#pragma unroll
            for (int m = 0; m < 4; ++m) {
                const int row = (u.pm * BM + u.hs) + ai * HALF + wr * 64 + m * 16 + fr;
#pragma unroll
                for (int bj = 0; bj < 2; ++bj) { const f32x4 x0 = acc[ai][bj][m][0], x1 = acc[ai][bj][m][1];
                    u32x4 w; EPI_PACK8(w, x0, x1);
                    *(u32x4*)(O + (size_t)row * 1024 + pnl * BM + bj * HALF + wc * 32 + 8 * fq) = w; }
            }
    }
#undef EPI_PACK8
#undef EPI_ROT
}

__device__ __forceinline__ void gemm_phase(LAS unsigned char* lds, const Gemm g, const Sched& S, const Params& P, const Epi& E) {
    const int tid = opaque_tid(), wid = __builtin_amdgcn_readfirstlane(tid >> 6), lane = tid & 63, wr = wid >> 2, wc = wid & 3, fr = lane & 15, fq = lane >> 4;
    const int K = g.K, nt = K / BK;
    const bool perm = true;
    const bool gather = (E.mode == EPI_MOE_UP);
    const int* IDXp = (const int*)(P.ws + WS_IDX);
    unsigned voffB[2]; int Rl[2], Cl[2];
#pragma unroll
    for (int i = 0; i < 2; ++i) { int R, C; stage_rc(tid * 16 + i * 8192, R, C); const int Rb = perm ? ((R & ~31) + perm32(R & 31)) : R; Rl[i] = R; Cl[i] = C;
        voffB[i] = (unsigned)(Rb * g.ldb + C) * 2u; }
    const size_t kstep = (size_t)(BK * 2);
    const size_t hstepA = (size_t)HALF * g.lda * 2, hstepB = (size_t)HALF * g.ldb * 2;
    const size_t tstepA = gather ? 0 : 2 * hstepA, tstepB = 2 * hstepB;
    unsigned voffA_lo[2], voffA_hi[2], voffN_lo[2], voffN_hi[2];
#define PG8_ROWS_NOW(U, R0, R1) do { _Pragma("unroll") for (int i_ = 0; i_ < 2; ++i_) { const int rl_ = (U).hs + Rl[i_], rh_ = ((U).hs ^ HALF) + Rl[i_]; \
        if (gather) { R0[i_] = IDXp[(U).pm * BM + rl_]; R1[i_] = IDXp[(U).pm * BM + rh_]; } else { R0[i_] = rl_; R1[i_] = rh_; } } } while (0)
#define PG8_ROWS_ASYNC(U, R0, R1) do { _Pragma("unroll") for (int i_ = 0; i_ < 2; ++i_) { const int rl_ = (U).hs + Rl[i_], rh_ = ((U).hs ^ HALF) + Rl[i_]; \
        if (gather) { asm volatile("global_load_dword %0, %1, off" : "=v"(R0[i_]) : "v"(IDXp + (U).pm * BM + rl_) : "memory"); \
                      asm volatile("global_load_dword %0, %1, off" : "=v"(R1[i_]) : "v"(IDXp + (U).pm * BM + rh_) : "memory"); } else { R0[i_] = rl_; R1[i_] = rh_; } } } while (0)
#define PG8_VOFF(R0, R1, LO, HI) do { _Pragma("unroll") for (int i_ = 0; i_ < 2; ++i_) { LO[i_] = (unsigned)(R0[i_] * g.lda + Cl[i_]) * 2u; HI[i_] = (unsigned)(R1[i_] * g.lda + Cl[i_]) * 2u; } } while (0)
    const unsigned ldsw = (unsigned)wid * 1024u;
    const int aoff = lds_byte(wr * 64 + fr, fq * 8), boff = lds_byte(wc * 32 + fr, fq * 8);
#define PG8_SA(b, h) (((b) * 2 + (h)) * HTB)
#define PG8_SB(b, h) ((4 + (b) * 2 + (h)) * HTB)
#define PG8_STAGE(bufoff, gbase, voff) do { _Pragma("unroll") for (int _i = 0; _i < 2; ++_i) \
        __builtin_amdgcn_global_load_lds((const unsigned*)((const char*)(gbase) + (voff)[_i]), (LAS unsigned*)(lds + (bufoff) + ldsw + _i * 8192), 16, 0, 0); } while (0)
#define PG8_LDA(dst, b, h) do { _Pragma("unroll") for (int m = 0; m < 4; ++m) _Pragma("unroll") for (int k = 0; k < 2; ++k) dst[m][k] = *(const LAS bf16x8*)(lds + PG8_SA(b, h) + aoff + m * 2048 + k * 1024); } while (0)
#define PG8_LDB(dst, b, h) do { _Pragma("unroll") for (int n = 0; n < 2; ++n) _Pragma("unroll") for (int k = 0; k < 2; ++k) dst[n][k] = *(const LAS bf16x8*)(lds + PG8_SB(b, h) + boff + n * 2048 + k * 1024); } while (0)
#define PG8_MMA(ai, bj, At, Bt) do { __builtin_amdgcn_s_setprio(1); _Pragma("unroll") for (int m = 0; m < 4; ++m) _Pragma("unroll") for (int n = 0; n < 2; ++n) _Pragma("unroll") for (int k = 0; k < 2; ++k) \
        acc[ai][bj][m][n] = __builtin_amdgcn_mfma_f32_16x16x32_bf16(Bt[n][k], At[m][k], acc[ai][bj][m][n], 0, 0, 0); __builtin_amdgcn_s_setprio(0); } while (0)
#define PG8_WAIT_V(n) asm volatile("s_waitcnt vmcnt(" #n ")" ::: "memory")
#define PG8_WAIT_L(n) __builtin_amdgcn_s_waitcnt(0xC07F)
#define PG8_BAR __builtin_amdgcn_s_barrier()
#define PG8_SCHED __builtin_amdgcn_sched_barrier(0)
    Unit cur, nxt; int ui = 0;
    if (!S.next(0, cur)) return;
    float z0_ = 0.f; asm volatile("" : "+v"(z0_));
    const f32x4 zero4 = {z0_, z0_, z0_, z0_};
    f32x4 acc[2][2][4][2];
#pragma unroll
    for (int a = 0; a < 2; ++a)
#pragma unroll
        for (int b = 0; b < 2; ++b)
#pragma unroll
            for (int m = 0; m < 4; ++m)
#pragma unroll
                for (int n = 0; n < 2; ++n) acc[a][b][m][n] = zero4;
    bf16x8 At[4][2], B0[2][2], B1[2][2];
    const char* cA = (const char*)g.A + (size_t)cur.pm * tstepA; const char* cB = (const char*)g.Bt + (size_t)cur.pn * tstepB;
    int crow0[2], crow1[2], nrow0[2], nrow1[2];
    PG8_ROWS_NOW(cur, crow0, crow1); PG8_VOFF(crow0, crow1, voffA_lo, voffA_hi);
    PG8_STAGE(PG8_SB(0, 0), cB, voffB); PG8_STAGE(PG8_SB(0, 1), cB + hstepB, voffB); PG8_STAGE(PG8_SA(0, 0), cA, voffA_lo); PG8_STAGE(PG8_SA(0, 1), cA, voffA_hi);
    if (wr == 1) PG8_BAR;
    PG8_WAIT_V(2); PG8_BAR;
    PG8_STAGE(PG8_SB(1, 0), cB + kstep, voffB); PG8_STAGE(PG8_SA(1, 0), cA + kstep, voffA_lo); PG8_STAGE(PG8_SB(1, 1), cB + hstepB + kstep, voffB);
    PG8_WAIT_V(6); PG8_BAR;
    for (;;) {
        const bool has_next = S.next(ui + 1, nxt);
        const char* nA = has_next ? (const char*)g.A + (size_t)nxt.pm * tstepA : cA; const char* nB = has_next ? (const char*)g.Bt + (size_t)nxt.pn * tstepB : cB;
        if (has_next) PG8_ROWS_ASYNC(nxt, nrow0, nrow1); else { nrow0[0] = crow0[0]; nrow0[1] = crow0[1]; nrow1[0] = crow1[0]; nrow1[1] = crow1[1]; }
#define PG8_KLOOP(FULL) do { for (int t = 0; t < nt; t += 2) { \
            const bool last = (t == nt - 2); \
            asm volatile("" : "+v"(nrow0[0]), "+v"(nrow0[1]), "+v"(nrow1[0]), "+v"(nrow1[1])); PG8_VOFF(nrow0, nrow1, voffN_lo, voffN_hi);     \
            const char* a1 = cA + (size_t)(t + 1) * kstep; \
            const char* a2 = last ? nA : cA + (size_t)(t + 2) * kstep; const char* b2 = last ? nB : cB + (size_t)(t + 2) * kstep; \
            const char* a3 = a2 + kstep; const char* b3 = b2 + kstep; \
            unsigned v2lo[2], v2hi[2]; v2lo[0] = last ? voffN_lo[0] : voffA_lo[0]; v2lo[1] = last ? voffN_lo[1] : voffA_lo[1]; v2hi[0] = last ? voffN_hi[0] : voffA_hi[0]; v2hi[1] = last ? voffN_hi[1] : voffA_hi[1]; \
              \
            PG8_LDB(B0, 0, 0); PG8_LDB(B1, 0, 1); PG8_SCHED; PG8_LDA(At, 0, 0); PG8_STAGE(PG8_SA(1, 1), a1, voffA_hi); \
            PG8_WAIT_V(8); PG8_WAIT_L(0); PG8_BAR; PG8_MMA(0, 0, At, B0); PG8_MMA(0, 1, At, B1); PG8_BAR; PG8_SCHED; \
            if (FULL) PG8_LDA(At, 0, 1); PG8_STAGE(PG8_SB(0, 0), b2, voffB); PG8_STAGE(PG8_SB(0, 1), b2 + hstepB, voffB); PG8_STAGE(PG8_SA(0, 0), a2, v2lo); \
            PG8_WAIT_V(8); PG8_WAIT_L(0); PG8_BAR; if (FULL) { PG8_MMA(1, 0, At, B0); PG8_MMA(1, 1, At, B1); } PG8_BAR; PG8_SCHED; \
              \
            PG8_LDB(B0, 1, 0); PG8_LDB(B1, 1, 1); PG8_SCHED; PG8_LDA(At, 1, 0); PG8_STAGE(PG8_SA(0, 1), a2, v2hi); \
            PG8_WAIT_V(8); PG8_WAIT_L(0); PG8_BAR; PG8_MMA(0, 0, At, B0); PG8_MMA(0, 1, At, B1); PG8_BAR; PG8_SCHED; \
            if (FULL) PG8_LDA(At, 1, 1); PG8_STAGE(PG8_SB(1, 0), b3, voffB); PG8_STAGE(PG8_SB(1, 1), b3 + hstepB, voffB); PG8_STAGE(PG8_SA(1, 0), a3, v2lo); \
            PG8_WAIT_V(8); PG8_WAIT_L(0); PG8_BAR; if (FULL) { PG8_MMA(1, 0, At, B0); PG8_MMA(1, 1, At, B1); } PG8_BAR; PG8_SCHED; \
        } } while (0)
        { const bool full = (cur.half == 0); PG8_KLOOP(full); }
#undef PG8_KLOOP
        if (wr == 0) PG8_BAR;
        epilogue(P, E, acc, cur);
        if (!has_next) break;
#pragma unroll
        for (int a = 0; a < 2; ++a)
#pragma unroll
            for (int b = 0; b < 2; ++b)
#pragma unroll
                for (int m = 0; m < 4; ++m)
#pragma unroll
                    for (int n = 0; n < 2; ++n) acc[a][b][m][n] = zero4;
        cur = nxt; cA = nA; cB = nB; ++ui;
        voffA_lo[0] = voffN_lo[0]; voffA_lo[1] = voffN_lo[1]; voffA_hi[0] = voffN_hi[0]; voffA_hi[1] = voffN_hi[1];
        crow0[0] = nrow0[0]; crow0[1] = nrow0[1]; crow1[0] = nrow1[0]; crow1[1] = nrow1[1];
        if (wr == 1) PG8_BAR;
    }
    PG8_WAIT_V(0);
    PG8_BAR;
#undef PG8_ROWS_NOW
#undef PG8_ROWS_ASYNC
#undef PG8_VOFF
#undef PG8_SA
#undef PG8_SB
#undef PG8_STAGE
#undef PG8_LDA
#undef PG8_LDB
#undef PG8_MMA
#undef PG8_WAIT_V
#undef PG8_WAIT_L
#undef PG8_BAR
#undef PG8_SCHED
}
}
namespace att {
#define SBAR() __builtin_amdgcn_sched_barrier(0)
#ifndef PROF_SEG
#define PROF_SEG -1
#endif
constexpr int PROF_LDS_OFF = 143360;
#if PROF_SEG >= 0
__device__ __forceinline__ unsigned long long prof_stamp() { unsigned long long t; SBAR(); asm volatile("s_memtime %0\n\ts_waitcnt lgkmcnt(0)" : "=s"(t) :: "memory"); SBAR(); return t; }
#define PROF_DECL() unsigned prof_acc[8] = {0u, 0u, 0u, 0u, 0u, 0u, 0u, 0u}; unsigned long long prof_last = prof_stamp()
#define PROF_MARK(seg) do { const unsigned long long t_now_ = prof_stamp(); prof_acc[seg] += (unsigned)(t_now_ - prof_last); prof_last = t_now_; } while (0)
#define PROF_FLUSH(lds, wid, lane) do { if (lane == 0) { LAS unsigned* pp_ = (LAS unsigned*)((lds) + PROF_LDS_OFF) + (wid) * 8; _Pragma("unroll") for (int q_ = 0; q_ < 8; ++q_) pp_[q_] += prof_acc[q_]; } } while (0)
#else
#define PROF_DECL() do {} while (0)
#define PROF_MARK(seg) do {} while (0)
#define PROF_FLUSH(lds, wid, lane) do {} while (0)
#endif
template <int OFF> __device__ __forceinline__ s16x4 tr_read(unsigned vb) {
    s16x4 r; asm volatile("ds_read_b64_tr_b16 %0, %1 offset:%2" : "=&v"(r) : "v"(vb), "i"(OFF) : "memory"); return r;
}
template <int DV> __device__ __forceinline__ int v_st(int k, int c) {
    const int kk = (k & ~0xC) | ((k & 4) << 1) | ((k & 8) >> 1);
    return ((kk >> 3) * (DV / 32) + (c >> 5)) * 512 + ((kk & 7) * 32 + (c & 31)) * 2;
}
__device__ __forceinline__ int v_rd_base(int lane) { return ((lane & 3) << 3) | (((lane >> 2) & 3) << 6) | (((lane >> 4) & 1) << 5) | (((lane >> 5) & 1) << 8); }
template <int DV> constexpr int v_rd_off(int d0, int ks, int half) { return d0 * 512 + ks * (DV / 32) * 1024 + half * (DV / 32) * 512; }
#define PK8(L, H) (bf16x8){L[0], L[1], L[2], L[3], H[0], H[1], H[2], H[3]}
template <int DV, int D0> __device__ __forceinline__ void pv_one(f32x16& od, unsigned vb, bf16x8 pa0, bf16x8 pa1, bf16x8 pa2, bf16x8 pa3) {
    const s16x4 l0 = tr_read<v_rd_off<DV>(D0, 0, 0)>(vb), h0 = tr_read<v_rd_off<DV>(D0, 0, 1)>(vb), l1 = tr_read<v_rd_off<DV>(D0, 1, 0)>(vb), h1 = tr_read<v_rd_off<DV>(D0, 1, 1)>(vb);
    const s16x4 l2 = tr_read<v_rd_off<DV>(D0, 2, 0)>(vb), h2 = tr_read<v_rd_off<DV>(D0, 2, 1)>(vb), l3 = tr_read<v_rd_off<DV>(D0, 3, 0)>(vb), h3 = tr_read<v_rd_off<DV>(D0, 3, 1)>(vb);
    asm volatile("s_waitcnt lgkmcnt(0)" ::: "memory"); SBAR();
    od = __builtin_amdgcn_mfma_f32_32x32x16_bf16(pa0, PK8(l0, h0), od, 0, 0, 0);
    od = __builtin_amdgcn_mfma_f32_32x32x16_bf16(pa1, PK8(l1, h1), od, 0, 0, 0);
    od = __builtin_amdgcn_mfma_f32_32x32x16_bf16(pa2, PK8(l2, h2), od, 0, 0, 0);
    od = __builtin_amdgcn_mfma_f32_32x32x16_bf16(pa3, PK8(l3, h3), od, 0, 0, 0);
}
#define PK4(P, BASE, OUT) do { unsigned a0 = cvtpk(P[BASE + 0], P[BASE + 1]), a1 = cvtpk(P[BASE + 2], P[BASE + 3]);   \
    unsigned b0 = cvtpk(P[BASE + 4], P[BASE + 5]), b1 = cvtpk(P[BASE + 6], P[BASE + 7]);                              \
    auto r0 = __builtin_amdgcn_permlane32_swap(a0, b0, false, false); auto r1 = __builtin_amdgcn_permlane32_swap(a1, b1, false, false); \
    u32x4 w = {r0[0], r1[0], r0[1], r1[1]}; OUT = __builtin_bit_cast(bf16x8, w); } while (0)
__device__ __forceinline__ void pack_p(const f32x16& p0, const f32x16& p1, bf16x8& pa0, bf16x8& pa1, bf16x8& pa2, bf16x8& pa3) {
    PK4(p0, 0, pa0); PK4(p0, 8, pa1); PK4(p1, 0, pa2); PK4(p1, 8, pa3);
}
__device__ __forceinline__ float half_swap_max(float x) { auto rr = __builtin_amdgcn_permlane32_swap(__float_as_uint(x), __float_as_uint(x), false, false); return fmaxf(__uint_as_float(rr[0]), __uint_as_float(rr[1])); }
__device__ __forceinline__ float half_swap_add(float x) { auto rr = __builtin_amdgcn_permlane32_swap(__float_as_uint(x), __float_as_uint(x), false, false); return __uint_as_float(rr[0]) + __uint_as_float(rr[1]); }

template <int DQK> constexpr int KROW = DQK * 2 + 16;
template <int DQK, int DV> struct Lay {
    static constexpr int KB = 64 * KROW<DQK>, VB = 64 * DV * 2;
    static constexpr int K_OFF = 0, V_OFF = 2 * KB, SCR_OFF = 2 * KB + 2 * VB;
    static constexpr int TAB_OFF = SCR_OFF + 8 * 256, END = TAB_OFF + 2048;
};
struct KVSrc {
    const bf16_t* k0; int ldk0;
    const bf16_t* k1; int ldk1;
    const bf16_t* v; int ldv;
    int row_lat0, n_lat, row_ctx0;
};
__device__ __forceinline__ int tile_row0(const KVSrc& s, int j) { return (j < s.n_lat) ? s.row_lat0 + 64 * j : s.row_ctx0 + 64 * (j - s.n_lat); }

template <int DQK, int DV> struct Stage {
    static constexpr int KC = DQK / 8, VC = DV / 8;
    static constexpr int NK = (64 * KC + 511) / 512, NV = (64 * VC + 511) / 512;
    u32x4 kr[NK], vr[NV];
    __device__ __forceinline__ void load(const KVSrc& s, int j, int tid) {
        const int row0 = tile_row0(s, j);
#pragma unroll
        for (int i = 0; i < NK; ++i) { const int c = tid + 512 * i;
            if (c < 64 * KC) { const int key = c / KC, part = c - key * KC;
                const bf16_t* p = (DQK == 96 && part >= 8) ? s.k1 + (size_t)(row0 + key) * s.ldk1 + (part - 8) * 8 : s.k0 + (size_t)(row0 + key) * s.ldk0 + part * 8;
                kr[i] = *(const u32x4*)p; } }
#pragma unroll
        for (int i = 0; i < NV; ++i) { const int c = tid + 512 * i; const int key = c / VC, c8 = c - key * VC;
            vr[i] = *(const u32x4*)(s.v + (size_t)(row0 + key) * s.ldv + c8 * 8); }
    }
    __device__ __forceinline__ void write(LAS unsigned char* kbuf, LAS unsigned char* vbuf, int tid) const {
#pragma unroll
        for (int i = 0; i < NK; ++i) { const int c = tid + 512 * i;
            if (c < 64 * KC) { const int key = c / KC, part = c - key * KC; *(LAS u32x4*)(kbuf + key * KROW<DQK> + part * 16) = kr[i]; } }
#pragma unroll
        for (int i = 0; i < NV; ++i) { const int c = tid + 512 * i; const int key = c / VC, c8 = c - key * VC; *(LAS u32x4*)(vbuf + v_st<DV>(key, c8 * 8)) = vr[i]; }
    }
};
template <int DQK> __device__ __forceinline__ void qkt(f32x16& p0, f32x16& p1, const LAS unsigned char* kbuf, const bf16x8 (&qr)[DQK / 16], int r32, int hi) {
    p0 = (f32x16){}; p1 = (f32x16){};
    bf16x8 kf[DQK / 8];
    const LAS unsigned char* kp = kbuf + r32 * KROW<DQK> + hi * 16;
#pragma unroll
    for (int d0 = 0; d0 < DQK / 16; ++d0) { kf[2 * d0] = *(const LAS bf16x8*)(kp + d0 * 32); kf[2 * d0 + 1] = *(const LAS bf16x8*)(kp + 32 * KROW<DQK> + d0 * 32); }
    asm volatile("s_waitcnt lgkmcnt(0)" ::: "memory"); SBAR();
    __builtin_amdgcn_s_setprio(1);
#pragma unroll
    for (int d0 = 0; d0 < DQK / 16; ++d0) {
        p0 = __builtin_amdgcn_mfma_f32_32x32x16_bf16(kf[2 * d0], qr[d0], p0, 0, 0, 0);
        p1 = __builtin_amdgcn_mfma_f32_32x32x16_bf16(kf[2 * d0 + 1], qr[d0], p1, 0, 0, 0);
    }
    __builtin_amdgcn_s_setprio(0);
}
struct VFrag { s16x4 l0, h0, l1, h1, l2, h2, l3, h3; };
template <int DV, int D0> __device__ __forceinline__ void v_issue(VFrag& f, unsigned vb) {
    f.l0 = tr_read<v_rd_off<DV>(D0, 0, 0)>(vb); f.h0 = tr_read<v_rd_off<DV>(D0, 0, 1)>(vb); f.l1 = tr_read<v_rd_off<DV>(D0, 1, 0)>(vb); f.h1 = tr_read<v_rd_off<DV>(D0, 1, 1)>(vb);
    f.l2 = tr_read<v_rd_off<DV>(D0, 2, 0)>(vb); f.h2 = tr_read<v_rd_off<DV>(D0, 2, 1)>(vb); f.l3 = tr_read<v_rd_off<DV>(D0, 3, 0)>(vb); f.h3 = tr_read<v_rd_off<DV>(D0, 3, 1)>(vb);
}
__device__ __forceinline__ void v_mma(f32x16& od, const VFrag& f, bf16x8 pa0, bf16x8 pa1, bf16x8 pa2, bf16x8 pa3) {
    __builtin_amdgcn_s_setprio(1);
    od = __builtin_amdgcn_mfma_f32_32x32x16_bf16(pa0, PK8(f.l0, f.h0), od, 0, 0, 0);
    od = __builtin_amdgcn_mfma_f32_32x32x16_bf16(pa1, PK8(f.l1, f.h1), od, 0, 0, 0);
    od = __builtin_amdgcn_mfma_f32_32x32x16_bf16(pa2, PK8(f.l2, f.h2), od, 0, 0, 0);
    od = __builtin_amdgcn_mfma_f32_32x32x16_bf16(pa3, PK8(f.l3, f.h3), od, 0, 0, 0);
    __builtin_amdgcn_s_setprio(0);
}
#define LGKM_WAIT(n) do { asm volatile("s_waitcnt lgkmcnt(" #n ")" ::: "memory"); SBAR(); } while (0)
template <int DV> __device__ __forceinline__ void pv_pipe(f32x16 (&o)[DV / 32], VFrag& f0, unsigned vb, bf16x8 pa0, bf16x8 pa1, bf16x8 pa2, bf16x8 pa3) {
    VFrag f1; v_issue<DV, 1>(f1, vb);
    LGKM_WAIT(8); v_mma(o[0], f0, pa0, pa1, pa2, pa3);
    if constexpr (DV == 128) {
        v_issue<DV, 2>(f0, vb);
        LGKM_WAIT(8); v_mma(o[1], f1, pa0, pa1, pa2, pa3);
        v_issue<DV, 3>(f1, vb);
        LGKM_WAIT(8); v_mma(o[2], f0, pa0, pa1, pa2, pa3);
        LGKM_WAIT(0); v_mma(o[3], f1, pa0, pa1, pa2, pa3);
    } else {
        LGKM_WAIT(0); v_mma(o[1], f1, pa0, pa1, pa2, pa3);
    }
}
template <int DV> __device__ __forceinline__ void pv_all(f32x16 (&o)[DV / 32], unsigned vb, bf16x8 pa0, bf16x8 pa1, bf16x8 pa2, bf16x8 pa3) {
    pv_one<DV, 0>(o[0], vb, pa0, pa1, pa2, pa3); pv_one<DV, 1>(o[1], vb, pa0, pa1, pa2, pa3);
    if constexpr (DV == 128) { pv_one<DV, 2>(o[2], vb, pa0, pa1, pa2, pa3); pv_one<DV, 3>(o[3], vb, pa0, pa1, pa2, pa3); }
}
constexpr float THR2 = 10.0f;
template <int DV, bool RAW> __device__ __forceinline__ void softmax_step(f32x16& p0, f32x16& p1, float C, float& m_reg, float& l_reg, f32x16 (&o)[DV / 32], LAS float* al_l, int r32, int hi,
                                                               bf16x8& pa0, bf16x8& pa1, bf16x8& pa2, bf16x8& pa3) {
    float pmax = p0[0];
#pragma unroll
    for (int r = 1; r < 16; ++r) pmax = fmaxf(pmax, p0[r]);
#pragma unroll
    for (int r = 0; r < 16; ++r) pmax = fmaxf(pmax, p1[r]);
    pmax = half_swap_max(pmax);
    if (RAW) pmax *= C;
    if (!__all(pmax - m_reg <= THR2)) {
        const float mn = fmaxf(m_reg, pmax), alpha = __builtin_amdgcn_exp2f(m_reg - mn);
        m_reg = mn; l_reg *= alpha;
        if (hi == 0) al_l[r32] = alpha;
        asm volatile("s_waitcnt lgkmcnt(0)" ::: "memory");
#pragma unroll
        for (int r = 0; r < 16; ++r) { const float a = al_l[crow(r, hi)];
#pragma unroll
            for (int d = 0; d < DV / 32; ++d) o[d][r] *= a; }
        asm volatile("s_waitcnt lgkmcnt(0)" ::: "memory");
    }
    float ps = 0.f; const float nm = -m_reg;
#pragma unroll
    for (int r = 0; r < 16; ++r) { p0[r] = __builtin_amdgcn_exp2f(RAW ? fmaf(p0[r], C, nm) : p0[r] + nm); ps += p0[r]; }
#pragma unroll
    for (int r = 0; r < 16; ++r) { p1[r] = __builtin_amdgcn_exp2f(RAW ? fmaf(p1[r], C, nm) : p1[r] + nm); ps += p1[r]; }
    l_reg += half_swap_add(ps);
    pack_p(p0, p1, pa0, pa1, pa2, pa3);
}
struct NaWave { int active_lo, active_hi;
                int dr0;
                int c, cs; };
template <int DQK, int DV> struct LayD {
    static constexpr int KRB = (DQK == 96) ? 4096 : 0, VB = 64 * DV * 2;
    static constexpr int KR_OFF = 8192, V_OFF = 8192 + KRB;
    static constexpr int NI = (8192 + KRB + VB + 8191) / 8192;
    static constexpr int TILE = NI * 8192, NB = 4;
    static constexpr int SCR_OFF = NB * TILE, TAB_OFF = SCR_OFF + 2048, END = TAB_OFF + 2048;
};
template <int DQK, int DV> struct Dma {
    typedef LayD<DQK, DV> L;
    unsigned voff[L::NI];
    const char* base[L::NI];
    unsigned rowb[L::NI];
    int row_lat0, n_lat, row_ctx0;
    __device__ __forceinline__ void setup(const KVSrc& s, int wid, int lane) {
        row_lat0 = s.row_lat0; n_lat = s.n_lat; row_ctx0 = s.row_ctx0;
#pragma unroll
        for (int i = 0; i < L::NI; ++i) {
            const int Pw = (wid + 8 * i) * 1024;
            if (Pw < 8192) { base[i] = (const char*)s.k0; rowb[i] = (unsigned)s.ldk0 * 2u; }
            else if (Pw < 8192 + L::KRB) { base[i] = (const char*)s.k1; rowb[i] = (unsigned)s.ldk1 * 2u; }
            else { base[i] = (const char*)s.v; rowb[i] = (unsigned)s.ldv * 2u; }
            const int P = Pw + lane * 16;
            if (P < 8192) { const int key = P >> 7, slot = (P >> 4) & 7, c = slot ^ (key & 7); voff[i] = (unsigned)(key * s.ldk0 + c * 8) * 2u; }
            else if (P < 8192 + L::KRB) { const int Pp = P - 8192, key = Pp >> 6, slot = (Pp >> 4) & 3, c = slot ^ ((key >> 2) & 3); voff[i] = (unsigned)(key * s.ldk1 + c * 8) * 2u; }
            else { int Pp = P - L::V_OFF; if (Pp >= L::VB) Pp -= 4096;
                const int sub = Pp >> 9, within = Pp & 511, kkh = sub / (DV / 32), cb = sub % (DV / 32), kkl = within >> 6, cl = (within & 63) >> 1;
                const int kk = kkh * 8 + kkl, key = (kk & ~0xC) | ((kk & 4) << 1) | ((kk & 8) >> 1), c = cb * 32 + cl;
                voff[i] = (unsigned)(key * s.ldv + c) * 2u; }
        }
    }
    __device__ __forceinline__ void issue(const KVSrc&, int j, LAS unsigned char* buf, int wid) const {
        const unsigned row0 = (unsigned)((j < n_lat) ? row_lat0 + 64 * j : row_ctx0 + 64 * (j - n_lat));
#pragma unroll
        for (int i = 0; i < L::NI; ++i)
            __builtin_amdgcn_global_load_lds((const unsigned*)(base[i] + (size_t)row0 * rowb[i] + voff[i]), (LAS unsigned*)(buf + (wid + 8 * i) * 1024), 16, 0, 0);
    }
};
template <int DQK> __device__ __forceinline__ void qkt_sw(f32x16& p0, f32x16& p1, const LAS unsigned char* img, const bf16x8 (&qr)[DQK / 16], int r32, int hi) {
    p0 = (f32x16){}; p1 = (f32x16){};
    bf16x8 kf[DQK / 8];
    const LAS unsigned char* kp = img + r32 * 128;
    const int sw = r32 & 7;
#pragma unroll
    for (int d0 = 0; d0 < 4; ++d0) { const int off = ((d0 * 2 + hi) ^ sw) << 4; kf[2 * d0] = *(const LAS bf16x8*)(kp + off); kf[2 * d0 + 1] = *(const LAS bf16x8*)(kp + 4096 + off); }
    if constexpr (DQK == 96) {
        const LAS unsigned char* rp = img + 8192 + r32 * 64; const int sr = (r32 >> 2) & 3;
#pragma unroll
        for (int d0 = 4; d0 < 6; ++d0) { const int off = (((d0 - 4) * 2 + hi) ^ sr) << 4; kf[2 * d0] = *(const LAS bf16x8*)(rp + off); kf[2 * d0 + 1] = *(const LAS bf16x8*)(rp + 2048 + off); }
    }
    asm volatile("s_waitcnt lgkmcnt(0)" ::: "memory"); SBAR();
    __builtin_amdgcn_s_setprio(1);
#pragma unroll
    for (int d0 = 0; d0 < DQK / 16; ++d0) {
        p0 = __builtin_amdgcn_mfma_f32_32x32x16_bf16(kf[2 * d0], qr[d0], p0, 0, 0, 0);
        p1 = __builtin_amdgcn_mfma_f32_32x32x16_bf16(kf[2 * d0 + 1], qr[d0], p1, 0, 0, 0);
    }
    __builtin_amdgcn_s_setprio(0);
}
template <int DQK, int DV, int MODE>
__device__ __forceinline__ void flash_loop(LAS unsigned char* lds, const KVSrc& src, int nt, const bf16x8 (&qr)[DQK / 16], float C,
                                           f32x16 (&o)[DV / 32], float& m_reg, float& l_reg, const NaWave& nw) {
    typedef LayD<DQK, DV> L;
    const int tid = opaque_tid(), wid = __builtin_amdgcn_readfirstlane(tid >> 6), lane = tid & 63, r32 = lane & 31, hi = lane >> 5;
    const bool skew = wid >= 4;
    LAS float* al_l = (LAS float*)(lds + L::SCR_OFF) + wid * 64;
    const LAS float* tab = (const LAS float*)(lds + L::TAB_OFF);
    const unsigned vlane = (unsigned)(uintptr_t)lds + (unsigned)L::V_OFF + (unsigned)v_rd_base(lane);
    Dma<DQK, DV> dma; dma.setup(src, wid, lane);
#pragma unroll
    for (int t = 0; t < 2; ++t) dma.issue(src, min(t, nt - 1), lds + t * L::TILE, wid);
    bf16x8 pa0, pa1, pa2, pa3; bool pend = false;
    PROF_DECL();
#pragma unroll 1
    for (int j = 0; j <= nt; ++j) {
        PROF_MARK(7);
        if constexpr (L::NI == 3) asm volatile("s_waitcnt vmcnt(3) lgkmcnt(0)" ::: "memory"); else asm volatile("s_waitcnt vmcnt(2) lgkmcnt(0)" ::: "memory");
        __builtin_amdgcn_s_barrier();
        PROF_MARK(0);
        dma.issue(src, min(j + 2, nt - 1), lds + ((j + 2) & 3) * L::TILE, wid);
        PROF_MARK(1);
        if (skew && pend) {
            const unsigned vb = vlane + ((j - 1) & 3) * L::TILE;
            VFrag vf0; v_issue<DV, 0>(vf0, vb);
            pv_pipe<DV>(o, vf0, vb, pa0, pa1, pa2, pa3);
            pend = false;
        }
        PROF_MARK(2);
        const int cur = j & 3;
        bool act = j < nt;
        if (MODE == 1) act = act && ((j >= src.n_lat) || (j >= nw.active_lo && j <= nw.active_hi));
        if (act) {
            f32x16 p0, p1;
            qkt_sw<DQK>(p0, p1, lds + cur * L::TILE, qr, r32, hi);
            PROF_MARK(3);
            VFrag vf0;
            if (!skew) v_issue<DV, 0>(vf0, vlane + cur * L::TILE);
            if (MODE == 1 && j < src.n_lat) {
                const LAS float* brow = tab + (nw.dr0 + j) * 31 + 15 - nw.c;
#pragma unroll
                for (int r = 0; r < 16; ++r) { const int kj = crow(r, hi);
                    p0[r] = (kj >= nw.cs && kj < nw.cs + 16) ? fmaf(p0[r], C, brow[kj]) : -1e30f;
                    const int kj1 = 32 + kj;
                    p1[r] = (kj1 >= nw.cs && kj1 < nw.cs + 16) ? fmaf(p1[r], C, brow[kj1]) : -1e30f; }
                softmax_step<DV, false>(p0, p1, C, m_reg, l_reg, o, al_l, r32, hi, pa0, pa1, pa2, pa3);
            } else {
                softmax_step<DV, true>(p0, p1, C, m_reg, l_reg, o, al_l, r32, hi, pa0, pa1, pa2, pa3);
            }
            PROF_MARK(4);
            if (!skew) pv_pipe<DV>(o, vf0, vlane + cur * L::TILE, pa0, pa1, pa2, pa3);
            else pend = true;
            PROF_MARK(5);
        }
    }
    asm volatile("s_waitcnt vmcnt(0) lgkmcnt(0)" ::: "memory");
    __builtin_amdgcn_s_barrier();
    PROF_FLUSH(lds, wid, lane);
}
typedef __bf16 bf16x2_t __attribute__((ext_vector_type(2)));
typedef float f32x2_t __attribute__((ext_vector_type(2)));
__device__ __forceinline__ unsigned cvtpk_s(float lo, float hi) { f32x2_t v = {lo, hi}; bf16x2_t b = __builtin_convertvector(v, bf16x2_t); return __builtin_bit_cast(unsigned, b); }
#define PK4S(P, BASE, OUT) do { unsigned a0 = cvtpk_s(P[BASE + 0], P[BASE + 1]), a1 = cvtpk_s(P[BASE + 2], P[BASE + 3]);   \
    unsigned b0 = cvtpk_s(P[BASE + 4], P[BASE + 5]), b1 = cvtpk_s(P[BASE + 6], P[BASE + 7]);                              \
    auto r0 = __builtin_amdgcn_permlane32_swap(a0, b0, false, false); auto r1 = __builtin_amdgcn_permlane32_swap(a1, b1, false, false); \
    u32x4 w = {r0[0], r1[0], r0[1], r1[1]}; OUT = __builtin_bit_cast(bf16x8, w); } while (0)
#define SGB(mask, n) __builtin_amdgcn_sched_group_barrier(mask, n, 0)
struct SmState { float m, l; };
__device__ __forceinline__ float sm_decide(const f32x16& p0, const f32x16& p1, float C, float& m_reg) {
    float pmax = p0[0];
#pragma unroll
    for (int r = 1; r < 16; ++r) pmax = fmaxf(pmax, p0[r]);
#pragma unroll
    for (int r = 0; r < 16; ++r) pmax = fmaxf(pmax, p1[r]);
    pmax = half_swap_max(pmax) * C;
    const bool keep = __all(pmax - m_reg <= THR2);
    const float mn = keep ? m_reg : fmaxf(m_reg, pmax);
    const float alpha = __builtin_amdgcn_exp2f(m_reg - mn);
    m_reg = mn;
    return alpha;
}
template <int DQK, int DV, int ABL = 0, bool SKEW = true>
__device__ __forceinline__ void flash_loop2(LAS unsigned char* lds, const KVSrc& src, int nt, const bf16x8 (&qr)[DQK / 16], float C,
                                            f32x16 (&o)[DV / 32], float& l_out) {
    typedef LayD<DQK, DV> L;
    const int tid = opaque_tid(), wid = __builtin_amdgcn_readfirstlane(tid >> 6), lane = tid & 63, r32 = lane & 31, hi = lane >> 5;
    LAS float* al_l = (LAS float*)(lds + L::SCR_OFF) + wid * 64;
    const unsigned vlane = (unsigned)(uintptr_t)lds + (unsigned)L::V_OFF + (unsigned)v_rd_base(lane);
    Dma<DQK, DV> dma; dma.setup(src, wid, lane);
#pragma unroll
    for (int t = 0; t < 2; ++t) dma.issue(src, min(t, nt - 1), lds + t * L::TILE, wid);
    float m_reg = -1e30f, l_reg = 0.f;
    f32x16 pA0, pA1, pB0, pB1; float alA, alB; bf16x8 pa0, pa1, pa2, pa3;
#define WAITBAR_ISSUE(J) do { if constexpr (L::NI == 3) asm volatile("s_waitcnt vmcnt(3) lgkmcnt(0)" ::: "memory"); else asm volatile("s_waitcnt vmcnt(2) lgkmcnt(0)" ::: "memory"); \
        if constexpr (!(ABL & 16)) __builtin_amdgcn_s_barrier(); if constexpr (!(ABL & 8)) dma.issue(src, min((J) + 2, nt - 1), lds + (((J) + 2) & 3) * L::TILE, wid); } while (0)
#define KISSUE(KF, IMG, H) do { \
        if ((H) < 2) { const LAS unsigned char* kp_ = (IMG) + r32 * 128; const int sw_ = r32 & 7; \
            _Pragma("unroll") for (int dd = 0; dd < 2; ++dd) { const int off_ = ((((H) * 2 + dd) * 2 + hi) ^ sw_) << 4; KF[2 * dd] = *(const LAS bf16x8*)(kp_ + off_); KF[2 * dd + 1] = *(const LAS bf16x8*)(kp_ + 4096 + off_); } } \
        else { const LAS unsigned char* rp_ = (IMG) + 8192 + r32 * 64; const int sr_ = (r32 >> 2) & 3; \
            _Pragma("unroll") for (int dd = 0; dd < 2; ++dd) { const int off_ = ((dd * 2 + hi) ^ sr_) << 4; KF[2 * dd] = *(const LAS bf16x8*)(rp_ + off_); KF[2 * dd + 1] = *(const LAS bf16x8*)(rp_ + 2048 + off_); } } } while (0)
#define QK_MMA_H(KF, P0, P1, H) do { \
        _Pragma("unroll") for (int dd = 0; dd < 2; ++dd) { P0 = __builtin_amdgcn_mfma_f32_32x32x16_bf16(KF[2 * dd], qr[(H) * 2 + dd], P0, 0, 0, 0); P1 = __builtin_amdgcn_mfma_f32_32x32x16_bf16(KF[2 * dd + 1], qr[(H) * 2 + dd], P1, 0, 0, 0); } } while (0)
#define FIN1(P0, P1) do { _Pragma("unroll") for (int r = 0; r < 16; ++r) { P1[r] = __builtin_amdgcn_exp2f(P1[r]); } } while (0)
#define FIN2(P0, P1, AL) do { float ps_ = 0.f; \
        _Pragma("unroll") for (int r = 0; r < 16; ++r) { ps_ += P0[r]; } \
        _Pragma("unroll") for (int r = 0; r < 16; ++r) { ps_ += P1[r]; } \
        l_reg = l_reg * (AL) + half_swap_add(ps_); } while (0)
#define FIN3(P0, P1) do { PK4S(P0, 0, pa0); PK4S(P0, 8, pa1); PK4S(P1, 0, pa2); PK4S(P1, 8, pa3); } while (0)
#define FINISH_SM(P0, P1, AL) do { FIN1(P0, P1); FIN2(P0, P1, AL); FIN3(P0, P1); } while (0)
#define SGB4(k) do { SGB(0x8, 1); SGB(0x2, k); SGB(0x8, 1); SGB(0x2, k); SGB(0x8, 1); SGB(0x2, k); SGB(0x8, 1); SGB(0x2, k); } while (0)
#define AF1(O0, O1) do { if constexpr (!(ABL & 1)) FIN1(O0, O1); } while (0)
#define AF2(O0, O1, OAL) do { if constexpr (!(ABL & 1)) FIN2(O0, O1, OAL); } while (0)
#define SEG_QK(IMG, N0, N1) do { if constexpr (!(ABL & 4)) { bf16x8 kfA[4], kfB[4]; N0 = (f32x16){}; N1 = (f32x16){}; \
        KISSUE(kfA, IMG, 0); KISSUE(kfB, IMG, 1); LGKM_WAIT(4); __builtin_amdgcn_s_setprio(1); QK_MMA_H(kfA, N0, N1, 0); \
        if constexpr (DQK == 96) { KISSUE(kfA, IMG, 2); LGKM_WAIT(4); QK_MMA_H(kfB, N0, N1, 1); LGKM_WAIT(0); QK_MMA_H(kfA, N0, N1, 2); } \
        else { LGKM_WAIT(0); QK_MMA_H(kfB, N0, N1, 1); } __builtin_amdgcn_s_setprio(0); SBAR(); } } while (0)
#define SEG_QK_LEAN(IMG, N0, N1) do { if constexpr (!(ABL & 4)) { bf16x8 kfA[4]; N0 = (f32x16){}; N1 = (f32x16){}; \
        KISSUE(kfA, IMG, 0); LGKM_WAIT(0); __builtin_amdgcn_s_setprio(1); QK_MMA_H(kfA, N0, N1, 0); SBAR(); \
        KISSUE(kfA, IMG, 1); LGKM_WAIT(0); QK_MMA_H(kfA, N0, N1, 1); __builtin_amdgcn_s_setprio(0); SBAR(); } } while (0)
#define SEG_FIN(VB, O0, O1, OAL) do { if constexpr (!(ABL & 2) && DV == 64) v_issue<DV, 0>(vf0, VB); \
        if constexpr (!(ABL & 1)) { FIN1(O0, O1); FIN2(O0, O1, OAL); } \
        if constexpr (!(ABL & 2) && DV == 128) { SBAR(); v_issue<DV, 0>(vf0, VB); }     \
        FIN3(O0, O1); SBAR(); } while (0)
#define SEG_PV(VB) do { if constexpr (!(ABL & 2)) { const unsigned vb_ = (VB); LGKM_WAIT(0); v_issue<DV, 1>(vf1, vb_); v_mma(o[0], vf0, pa0, pa1, pa2, pa3); LGKM_WAIT(0); \
        if constexpr (DV == 128) { v_issue<DV, 2>(vf0, vb_); v_mma(o[1], vf1, pa0, pa1, pa2, pa3); LGKM_WAIT(0); v_issue<DV, 3>(vf1, vb_); v_mma(o[2], vf0, pa0, pa1, pa2, pa3); LGKM_WAIT(0); v_mma(o[3], vf1, pa0, pa1, pa2, pa3); } \
        else { v_mma(o[1], vf1, pa0, pa1, pa2, pa3); } SBAR(); } } while (0)
#define SEG_PART(X0, X1, XAL) do { XAL = 1.f; if constexpr (!(ABL & 1)) { XAL = sm_decide(X0, X1, C, m_reg); const float nm_ = -m_reg; \
        _Pragma("unroll") for (int r = 0; r < 16; ++r) { X0[r] = __builtin_amdgcn_exp2f(fmaf(X0[r], C, nm_)); X1[r] = fmaf(X1[r], C, nm_); } \
        RESC(XAL); } SBAR(); } while (0)
#define RESC(AL) do { if (__any((AL) < 1.f)) { if (hi == 0) al_l[r32] = (AL); asm volatile("s_waitcnt lgkmcnt(0)" ::: "memory"); \
        _Pragma("unroll") for (int r = 0; r < 16; ++r) { const float a_ = al_l[crow(r, hi)]; _Pragma("unroll") for (int d = 0; d < DV / 32; ++d) o[d][r] *= a_; } \
        asm volatile("s_waitcnt lgkmcnt(0)" ::: "memory"); } } while (0)
#define STEP(J, N0, N1, NAL, O0, O1, OAL) do { \
        if (!skew) WAITBAR_ISSUE(J); \
        { const unsigned vbp_ = vlane + (((J) - 1) & 3) * L::TILE; \
          SEG_QK(lds + ((J) & 3) * L::TILE, N0, N1); \
          SEG_FIN(vbp_, O0, O1, OAL); SEG_PV(vbp_); } \
        if (skew) WAITBAR_ISSUE((J) + 1); \
        SEG_PART(N0, N1, NAL); } while (0)
    VFrag vf0, vf1;
    const bool skew = SKEW && (wid >= 4);
    WAITBAR_ISSUE(0);
    SEG_QK(lds, pA0, pA1);
    if (skew) WAITBAR_ISSUE(1);
    SEG_PART(pA0, pA1, alA);
#pragma unroll 1
    for (int j = 1; j + 1 < nt; j += 2) {
        STEP(j, pB0, pB1, alB, pA0, pA1, alA);
        STEP(j + 1, pA0, pA1, alA, pB0, pB1, alB);
    }
    STEP(nt - 1, pB0, pB1, alB, pA0, pA1, alA);
    if (!skew) WAITBAR_ISSUE(nt);
    { const unsigned vbl_ = vlane + ((nt - 1) & 3) * L::TILE; SEG_FIN(vbl_, pB0, pB1, alB); SEG_PV(vbl_); }
    asm volatile("s_waitcnt vmcnt(0) lgkmcnt(0)" ::: "memory");
    __builtin_amdgcn_s_barrier();
    l_out = l_reg;
#undef WAITBAR_ISSUE
#undef KISSUE
#undef QK_MMA_H
#undef FIN1
#undef FIN2
#undef FIN3
#undef FINISH_SM
#undef SGB4
#undef AF1
#undef AF2
#undef SEG_QK
#undef SEG_QK_LEAN
#undef SEG_FIN
#undef SEG_PV
#undef SEG_PART
#undef RESC
#undef STEP
}
__device__ __forceinline__ void row_recips(float l_reg, LAS float* li_l, int r32, int hi, float (&rl)[16]) {
    if (hi == 0) li_l[r32] = l_reg;
    asm volatile("s_waitcnt lgkmcnt(0)" ::: "memory");
#pragma unroll
    for (int r = 0; r < 16; ++r) rl[r] = __builtin_amdgcn_rcpf(li_l[crow(r, hi)]);
    asm volatile("s_waitcnt lgkmcnt(0)" ::: "memory");
}
template <int DQK> __device__ __forceinline__ void load_q(bf16x8 (&qr)[DQK / 16], const bf16_t* qrow, int hi) {
#pragma unroll
    for (int d0 = 0; d0 < DQK / 16; ++d0) qr[d0] = *(const bf16x8*)(qrow + d0 * 16 + hi * 8);
}
template <int DV> constexpr int OROW = DV * 2 + 16;
template <int DV> __device__ __forceinline__ void stage_o(LAS unsigned char* wst, const f32x16 (&o)[DV / 32], const float (&sc)[16], int r32, int hi) {
#pragma unroll
    for (int r = 0; r < 16; ++r) { LAS unsigned char* rp = wst + crow(r, hi) * OROW<DV> + r32 * 2;
#pragma unroll
        for (int d = 0; d < DV / 32; ++d) *(LAS bf16_t*)(rp + d * 64) = (bf16_t)f2bf(o[d][r] * sc[r]); }
    asm volatile("s_waitcnt lgkmcnt(0)" ::: "memory");
}
template <int DV> __device__ __forceinline__ void store_rows(const LAS unsigned char* wst, bf16_t* O, int ldo, int row0, int col0, int lane) {
    constexpr int CPR = DV / 8;
#pragma unroll
    for (int i = 0; i < 32 * CPR / 64; ++i) { const int idx = i * 64 + lane, row = idx / CPR, ch = idx % CPR;
        const u32x4 v = *(const LAS u32x4*)(wst + row * OROW<DV> + ch * 16);
        *(u32x4*)(O + (size_t)(row0 + row) * ldo + col0 + ch * 8) = v; }
}

}
namespace att {
typedef short v4i16_t __attribute__((ext_vector_type(4)));
__device__ __forceinline__ s16x4 vtr(const LAS unsigned char* p) { return __builtin_bit_cast(s16x4, __builtin_amdgcn_ds_read_tr16_b64_v4i16((LAS v4i16_t*)p)); }
#define PIN(x) asm volatile("" : "+v"(x))
#define MFMA32(a, b, c) __builtin_amdgcn_mfma_f32_32x32x16_bf16(a, b, c, 0, 0, 0)
#define MX3(a, b, c) __builtin_fmaxf(__builtin_fmaxf((a), (b)), (c))
#define F3_THR 8.0f
__device__ __forceinline__ float rowmax3(const f32x16& p0, const f32x16& p1) {
    float a = MX3(p0[0], p0[1], p1[0]), b = MX3(p0[2], p0[3], p1[1]); a = MX3(a, p1[2], p1[3]);
#pragma unroll
    for (int r = 4; r < 16; r += 4) { a = MX3(a, p0[r], p0[r + 1]); b = MX3(b, p0[r + 2], p0[r + 3]); a = MX3(a, p1[r], p1[r + 1]); b = MX3(b, p1[r + 2], p1[r + 3]); }
    return half_swap_max(__builtin_fmaxf(a, b));
}
template <int DQK, int DV> struct LayE {
    static constexpr int KBYTES = 64 * DQK * 2, VB = 64 * DV * 2, V_OFF = KBYTES;
    static constexpr int NI = (KBYTES + VB + 8191) / 8192;
    static constexpr int TILE = NI * 8192, NB = 5;
    static constexpr int SCR_OFF = NB * TILE, TAB_OFF = SCR_OFF + 2048, END = TAB_OFF + 2048;
};
template <int DQK, int DV> struct Dma3 {
    typedef LayE<DQK, DV> L;
    unsigned voff[L::NI]; const char* base[L::NI]; unsigned rowb[L::NI];
    int row_lat0, n_lat, row_ctx0;
    __device__ __forceinline__ void setup(const KVSrc& s, int wid, int lane) {
        row_lat0 = s.row_lat0; n_lat = s.n_lat; row_ctx0 = s.row_ctx0;
#pragma unroll
        for (int i = 0; i < L::NI; ++i) {
            const int q = wid + 8 * i, Pw = q * 1024;
            if (Pw < L::KBYTES) {
                if (q < 8) { base[i] = (const char*)s.k0; rowb[i] = (unsigned)s.ldk0 * 2u; voff[i] = (unsigned)(lane * s.ldk0 + q * 8) * 2u; }
                else { base[i] = (const char*)s.k1; rowb[i] = (unsigned)s.ldk1 * 2u; voff[i] = (unsigned)(lane * s.ldk1 + (q - 8) * 8) * 2u; }
            } else {
                base[i] = (const char*)s.v; rowb[i] = (unsigned)s.ldv * 2u;
                int Pp = Pw + lane * 16 - L::V_OFF; if (Pp >= L::VB) Pp -= 4096;
                const int sub = Pp >> 9, within = Pp & 511, kkh = sub / (DV / 32), cb = sub % (DV / 32), kkl = within >> 6, cl = (within & 63) >> 1;
                const int key = kkh * 8 + kkl, c = cb * 32 + cl;
                voff[i] = (unsigned)(key * s.ldv + c) * 2u;
            }
        }
    }
    __device__ __forceinline__ void issue(int j, LAS unsigned char* buf, int wid) const {
        const unsigned row0 = (unsigned)((j < n_lat) ? row_lat0 + 64 * j : row_ctx0 + 64 * (j - n_lat));
#pragma unroll
        for (int i = 0; i < L::NI; ++i)
            __builtin_amdgcn_global_load_lds((const unsigned*)(base[i] + (size_t)row0 * rowb[i] + voff[i]), (LAS unsigned*)(buf + (wid + 8 * i) * 1024), 16, 0, 0);
    }
};
__device__ __forceinline__ void flash3_diff(LAS unsigned char* lds, const KVSrc& src, int nt, const bf16x8 (&qr)[4], float C, f32x16 (&o)[4], float& l_out) {
    typedef LayE<64, 128> L;
    const int tid = opaque_tid(), wid = __builtin_amdgcn_readfirstlane(tid >> 6), lane = tid & 63, r32 = lane & 31, hi = lane >> 5;
    Dma3<64, 128> dma; dma.setup(src, wid, lane);
    const LAS unsigned char* kb0 = lds + hi * 1024 + r32 * 16;
    const LAS unsigned char* vb0 = lds + L::V_OFF + v_rd_base(lane);
    dma.issue(0, lds, wid); dma.issue(min(1, nt - 1), lds + L::TILE, wid); dma.issue(min(2, nt - 1), lds + 2 * L::TILE, wid);
    float mhat = 0.f, l_reg = 0.f; bool resc = false; f32x16 negm;
    f32x16 c0, c1; bf16x8 kf[8]; u32x4 pa0, pa1, pa2, pa3, pb0, pb1, pb2, pb3; s16x4 vR0l, vR0h, vR1l, vR1h, vR2l, vR2h, vR3l, vR3h, vR4l, vR4h, vR5l, vR5h;
#define F3_WAITB2() do { if constexpr (L::NI == 3) asm volatile("s_waitcnt vmcnt(6) lgkmcnt(0)\n\ts_barrier" ::: "memory"); else asm volatile("s_waitcnt vmcnt(4) lgkmcnt(0)\n\ts_barrier" ::: "memory"); } while (0)
#define F3_WAITB1() do { if constexpr (L::NI == 3) asm volatile("s_waitcnt vmcnt(3) lgkmcnt(0)\n\ts_barrier" ::: "memory"); else asm volatile("s_waitcnt vmcnt(2) lgkmcnt(0)\n\ts_barrier" ::: "memory"); } while (0)
#define F3_KLOADR(KP, d0, sl) do { kf[2 * (sl)] = *(const LAS bf16x8*)((KP) + (d0) * 2048); kf[2 * (sl) + 1] = *(const LAS bf16x8*)((KP) + (d0) * 2048 + 512); } while (0)
#define F3_EX(v) __builtin_amdgcn_exp2f(v)
#define F3_BF(w) __builtin_bit_cast(bf16x8, w)
#define F3_VF(l, h) (bf16x8){l[0], l[1], l[2], l[3], h[0], h[1], h[2], h[3]}
#define F3_RESC() do { if (resc) { const int t2_ = opaque_tid(); const LAS float* ws2_ = (const LAS float*)(lds + L::SCR_OFF) + (t2_ >> 6) * 64; const int h2_ = (t2_ & 63) >> 5; _Pragma("unroll") for (int r = 0; r < 16; ++r) { const float a_ = ws2_[crow(r, h2_)]; _Pragma("unroll") for (int d = 0; d < 4; ++d) o[d][r] *= a_; } } } while (0)
    F3_WAITB2();
    { bf16x8 k0f[8];
      _Pragma("unroll") for (int d0 = 0; d0 < 4; ++d0) { k0f[2 * d0] = *(const LAS bf16x8*)(kb0 + d0 * 2048); k0f[2 * d0 + 1] = *(const LAS bf16x8*)(kb0 + d0 * 2048 + 512); }
      c0 = MFMA32(k0f[0], qr[0], (f32x16){}); c1 = MFMA32(k0f[1], qr[0], (f32x16){});
      c0 = MFMA32(k0f[2], qr[1], c0); c1 = MFMA32(k0f[3], qr[1], c1);
      c0 = MFMA32(k0f[4], qr[2], c0); c1 = MFMA32(k0f[5], qr[2], c1);
      c0 = MFMA32(k0f[6], qr[3], c0); c1 = MFMA32(k0f[7], qr[3], c1);
    }
    { const float rm = rowmax3(c0, c1); mhat = rm; const float nmh = -mhat; float sacc = 0.f;
      _Pragma("unroll") for (int r = 0; r < 16; ++r) { c0[r] = F3_EX(c0[r] + nmh); c1[r] = F3_EX(c1[r] + nmh); sacc += c0[r]; sacc += c1[r]; negm[r] = nmh; } PIN(negm);
      l_reg = sacc;
      pa0 = (u32x4){cvtpk_s(c0[0], c0[1]), cvtpk_s(c0[2], c0[3]), cvtpk_s(c0[4], c0[5]), cvtpk_s(c0[6], c0[7])}; pa1 = (u32x4){cvtpk_s(c0[8], c0[9]), cvtpk_s(c0[10], c0[11]), cvtpk_s(c0[12], c0[13]), cvtpk_s(c0[14], c0[15])};
      pa2 = (u32x4){cvtpk_s(c1[0], c1[1]), cvtpk_s(c1[2], c1[3]), cvtpk_s(c1[4], c1[5]), cvtpk_s(c1[6], c1[7])}; pa3 = (u32x4){cvtpk_s(c1[8], c1[9]), cvtpk_s(c1[10], c1[11]), cvtpk_s(c1[12], c1[13]), cvtpk_s(c1[14], c1[15])}; }
    dma.issue(min(3, nt - 1), lds + 3 * L::TILE, wid);
    F3_WAITB1();
    F3_KLOADR(kb0 + L::TILE, 0, 0); F3_KLOADR(kb0 + L::TILE, 1, 1); F3_KLOADR(kb0 + L::TILE, 2, 2); F3_KLOADR(kb0 + L::TILE, 3, 3);
#define F3_STEP(PO0, PO1, PO2, PO3, PN0, PN1, PN2, PN3, T) do { SBAR(); \
    const int sp_ = (((T) + 4) % 5) * L::TILE, sn_ = (((T) + 1) % 5) * L::TILE; \
    unsigned vpa_ = (unsigned)(uintptr_t)(vb0 + sp_), kna_ = (unsigned)(uintptr_t)(kb0 + sn_), kca_ = (unsigned)(uintptr_t)(kb0 + ((T) % 5) * L::TILE); asm volatile("" : "+v"(vpa_), "+v"(kna_), "+v"(kca_));     \
    const LAS unsigned char* vp_ = (const LAS unsigned char*)(uintptr_t)vpa_; const LAS unsigned char* kn_ = (const LAS unsigned char*)(uintptr_t)kna_; const LAS unsigned char* kc_ = (const LAS unsigned char*)(uintptr_t)kca_; \
    c0 = MFMA32(kf[0], qr[0], negm); SBAR(); \
    c1 = MFMA32(kf[1], qr[0], negm); SBAR(); \
    vR0l = vtr(vp_ + 0); vR0h = vtr(vp_ + 2048); c0 = MFMA32(kf[2], qr[1], c0); SBAR(); \
    vR1l = vtr(vp_ + 512); vR1h = vtr(vp_ + 2560); c1 = MFMA32(kf[3], qr[1], c1); SBAR(); \
    vR2l = vtr(vp_ + 1024); vR2h = vtr(vp_ + 3072); c0 = MFMA32(kf[4], qr[2], c0); SBAR(); \
    vR3l = vtr(vp_ + 1536); vR3h = vtr(vp_ + 3584); c1 = MFMA32(kf[5], qr[2], c1); SBAR(); \
    vR4l = vtr(vp_ + 4096); vR4h = vtr(vp_ + 6144); c0 = MFMA32(kf[6], qr[3], c0); SBAR(); \
    vR5l = vtr(vp_ + 4608); vR5h = vtr(vp_ + 6656); c1 = MFMA32(kf[7], qr[3], c1); SBAR(); \
    dma.issue(min((T) + 3, nt - 1), lds + (((T) + 3) % 5) * L::TILE, wid); \
    { const float rm = rowmax3(c0, c1); resc = false; \
      if (__builtin_expect(__any(rm > F3_THR), 0)) { const float dl = __builtin_fmaxf(rm, 0.f); mhat += dl; const float f_ = __builtin_amdgcn_exp2f(-dl); l_reg *= f_; { const int t2_ = opaque_tid(); if ((t2_ & 63) < 32) ((LAS float*)(lds + L::SCR_OFF))[(t2_ >> 6) * 64 + (t2_ & 63)] = f_; } resc = true; \
        _Pragma("unroll") for (int r = 0; r < 16; ++r) { c0[r] -= dl; c1[r] -= dl; negm[r] = -mhat; } PIN(negm); } } \
    float sacc = 0.f; SBAR(); \
    o[0] = MFMA32(F3_BF(PO0), F3_VF(vR0l, vR0h), o[0]); vR0l = vtr(vp_ + 5120); vR0h = vtr(vp_ + 7168); c0[0] = F3_EX(c0[0]); sacc += c0[0]; c0[1] = F3_EX(c0[1]); sacc += c0[1]; PN0[0] = cvtpk_s(c0[0], c0[1]); PIN(PN0); PIN(sacc); SBAR(); \
    F3_KLOADR(kn_, 0, 0); o[1] = MFMA32(F3_BF(PO0), F3_VF(vR1l, vR1h), o[1]); vR1l = vtr(vp_ + 5632); vR1h = vtr(vp_ + 7680); c0[2] = F3_EX(c0[2]); sacc += c0[2]; c0[3] = F3_EX(c0[3]); sacc += c0[3]; PN0[1] = cvtpk_s(c0[2], c0[3]); PIN(PN0); PIN(sacc); SBAR(); \
    o[2] = MFMA32(F3_BF(PO0), F3_VF(vR2l, vR2h), o[2]); vR2l = vtr(vp_ + 8192); vR2h = vtr(vp_ + 10240); c0[4] = F3_EX(c0[4]); sacc += c0[4]; c0[5] = F3_EX(c0[5]); sacc += c0[5]; PN0[2] = cvtpk_s(c0[4], c0[5]); PIN(PN0); PIN(sacc); SBAR(); \
    o[3] = MFMA32(F3_BF(PO0), F3_VF(vR3l, vR3h), o[3]); vR3l = vtr(vp_ + 8704); vR3h = vtr(vp_ + 10752); c0[6] = F3_EX(c0[6]); sacc += c0[6]; c0[7] = F3_EX(c0[7]); sacc += c0[7]; PN0[3] = cvtpk_s(c0[6], c0[7]); PIN(PN0); PIN(sacc); SBAR(); \
    o[0] = MFMA32(F3_BF(PO1), F3_VF(vR4l, vR4h), o[0]); vR4l = vtr(vp_ + 9216); vR4h = vtr(vp_ + 11264); c0[8] = F3_EX(c0[8]); sacc += c0[8]; c0[9] = F3_EX(c0[9]); sacc += c0[9]; PN1[0] = cvtpk_s(c0[8], c0[9]); PIN(PN1); PIN(sacc); SBAR(); \
    F3_KLOADR(kn_, 1, 1); o[1] = MFMA32(F3_BF(PO1), F3_VF(vR5l, vR5h), o[1]); vR5l = vtr(vp_ + 9728); vR5h = vtr(vp_ + 11776); c0[10] = F3_EX(c0[10]); sacc += c0[10]; c0[11] = F3_EX(c0[11]); sacc += c0[11]; PN1[1] = cvtpk_s(c0[10], c0[11]); PIN(PN1); PIN(sacc); SBAR(); \
    o[2] = MFMA32(F3_BF(PO1), F3_VF(vR0l, vR0h), o[2]); vR0l = vtr(vp_ + 12288); vR0h = vtr(vp_ + 14336); c0[12] = F3_EX(c0[12]); sacc += c0[12]; c0[13] = F3_EX(c0[13]); sacc += c0[13]; PN1[2] = cvtpk_s(c0[12], c0[13]); PIN(PN1); PIN(sacc); SBAR(); \
    o[3] = MFMA32(F3_BF(PO1), F3_VF(vR1l, vR1h), o[3]); vR1l = vtr(vp_ + 12800); vR1h = vtr(vp_ + 14848); c0[14] = F3_EX(c0[14]); sacc += c0[14]; c0[15] = F3_EX(c0[15]); sacc += c0[15]; PN1[3] = cvtpk_s(c0[14], c0[15]); PIN(PN1); PIN(sacc); SBAR(); \
    o[0] = MFMA32(F3_BF(PO2), F3_VF(vR2l, vR2h), o[0]); vR2l = vtr(vp_ + 13312); vR2h = vtr(vp_ + 15360); c1[0] = F3_EX(c1[0]); sacc += c1[0]; c1[1] = F3_EX(c1[1]); sacc += c1[1]; PN2[0] = cvtpk_s(c1[0], c1[1]); PIN(PN2); PIN(sacc); SBAR(); \
    F3_KLOADR(kn_, 2, 2); o[1] = MFMA32(F3_BF(PO2), F3_VF(vR3l, vR3h), o[1]); vR3l = vtr(vp_ + 13824); vR3h = vtr(vp_ + 15872); c1[2] = F3_EX(c1[2]); sacc += c1[2]; c1[3] = F3_EX(c1[3]); sacc += c1[3]; PN2[1] = cvtpk_s(c1[2], c1[3]); PIN(PN2); PIN(sacc); SBAR(); \
    o[2] = MFMA32(F3_BF(PO2), F3_VF(vR4l, vR4h), o[2]); c1[4] = F3_EX(c1[4]); sacc += c1[4]; c1[5] = F3_EX(c1[5]); sacc += c1[5]; PN2[2] = cvtpk_s(c1[4], c1[5]); PIN(PN2); PIN(sacc); SBAR(); \
    o[3] = MFMA32(F3_BF(PO2), F3_VF(vR5l, vR5h), o[3]); c1[6] = F3_EX(c1[6]); sacc += c1[6]; c1[7] = F3_EX(c1[7]); sacc += c1[7]; PN2[3] = cvtpk_s(c1[6], c1[7]); PIN(PN2); PIN(sacc); SBAR(); \
    o[0] = MFMA32(F3_BF(PO3), F3_VF(vR0l, vR0h), o[0]); c1[8] = F3_EX(c1[8]); sacc += c1[8]; c1[9] = F3_EX(c1[9]); sacc += c1[9]; PN3[0] = cvtpk_s(c1[8], c1[9]); PIN(PN3); PIN(sacc); SBAR(); \
    F3_KLOADR(kn_, 3, 3); o[1] = MFMA32(F3_BF(PO3), F3_VF(vR1l, vR1h), o[1]); c1[10] = F3_EX(c1[10]); sacc += c1[10]; c1[11] = F3_EX(c1[11]); sacc += c1[11]; PN3[1] = cvtpk_s(c1[10], c1[11]); PIN(PN3); PIN(sacc); SBAR(); \
    o[2] = MFMA32(F3_BF(PO3), F3_VF(vR2l, vR2h), o[2]); c1[12] = F3_EX(c1[12]); sacc += c1[12]; c1[13] = F3_EX(c1[13]); sacc += c1[13]; PN3[2] = cvtpk_s(c1[12], c1[13]); PIN(PN3); PIN(sacc); SBAR(); \
    o[3] = MFMA32(F3_BF(PO3), F3_VF(vR3l, vR3h), o[3]); c1[14] = F3_EX(c1[14]); sacc += c1[14]; c1[15] = F3_EX(c1[15]); sacc += c1[15]; PN3[3] = cvtpk_s(c1[14], c1[15]); PIN(PN3); PIN(sacc); SBAR(); \
    l_reg += sacc; \
    } while (0)
#pragma unroll 1
    for (int t = 1; t + 1 < nt; t += 2) {
        F3_STEP(pa0, pa1, pa2, pa3, pb0, pb1, pb2, pb3, t); F3_WAITB1(); F3_RESC();
        F3_STEP(pb0, pb1, pb2, pb3, pa0, pa1, pa2, pa3, t + 1); F3_WAITB1(); F3_RESC();
    }
    F3_STEP(pa0, pa1, pa2, pa3, pb0, pb1, pb2, pb3, nt - 1); F3_WAITB1(); F3_RESC();
    { const LAS unsigned char* vp_ = vb0 + ((nt - 1) % 5) * L::TILE;
      { const s16x4 l_ = vtr(vp_ + 0), h_ = vtr(vp_ + 2048); const bf16x8 vf_ = {l_[0], l_[1], l_[2], l_[3], h_[0], h_[1], h_[2], h_[3]}; o[0] = MFMA32(F3_BF(pb0), vf_, o[0]); }
      { const s16x4 l_ = vtr(vp_ + 512), h_ = vtr(vp_ + 2560); const bf16x8 vf_ = {l_[0], l_[1], l_[2], l_[3], h_[0], h_[1], h_[2], h_[3]}; o[1] = MFMA32(F3_BF(pb0), vf_, o[1]); }
      { const s16x4 l_ = vtr(vp_ + 1024), h_ = vtr(vp_ + 3072); const bf16x8 vf_ = {l_[0], l_[1], l_[2], l_[3], h_[0], h_[1], h_[2], h_[3]}; o[2] = MFMA32(F3_BF(pb0), vf_, o[2]); }
      { const s16x4 l_ = vtr(vp_ + 1536), h_ = vtr(vp_ + 3584); const bf16x8 vf_ = {l_[0], l_[1], l_[2], l_[3], h_[0], h_[1], h_[2], h_[3]}; o[3] = MFMA32(F3_BF(pb0), vf_, o[3]); }
      { const s16x4 l_ = vtr(vp_ + 4096), h_ = vtr(vp_ + 6144); const bf16x8 vf_ = {l_[0], l_[1], l_[2], l_[3], h_[0], h_[1], h_[2], h_[3]}; o[0] = MFMA32(F3_BF(pb1), vf_, o[0]); }
      { const s16x4 l_ = vtr(vp_ + 4608), h_ = vtr(vp_ + 6656); const bf16x8 vf_ = {l_[0], l_[1], l_[2], l_[3], h_[0], h_[1], h_[2], h_[3]}; o[1] = MFMA32(F3_BF(pb1), vf_, o[1]); }
      { const s16x4 l_ = vtr(vp_ + 5120), h_ = vtr(vp_ + 7168); const bf16x8 vf_ = {l_[0], l_[1], l_[2], l_[3], h_[0], h_[1], h_[2], h_[3]}; o[2] = MFMA32(F3_BF(pb1), vf_, o[2]); }
      { const s16x4 l_ = vtr(vp_ + 5632), h_ = vtr(vp_ + 7680); const bf16x8 vf_ = {l_[0], l_[1], l_[2], l_[3], h_[0], h_[1], h_[2], h_[3]}; o[3] = MFMA32(F3_BF(pb1), vf_, o[3]); }
      { const s16x4 l_ = vtr(vp_ + 8192), h_ = vtr(vp_ + 10240); const bf16x8 vf_ = {l_[0], l_[1], l_[2], l_[3], h_[0], h_[1], h_[2], h_[3]}; o[0] = MFMA32(F3_BF(pb2), vf_, o[0]); }
      { const s16x4 l_ = vtr(vp_ + 8704), h_ = vtr(vp_ + 10752); const bf16x8 vf_ = {l_[0], l_[1], l_[2], l_[3], h_[0], h_[1], h_[2], h_[3]}; o[1] = MFMA32(F3_BF(pb2), vf_, o[1]); }
      { const s16x4 l_ = vtr(vp_ + 9216), h_ = vtr(vp_ + 11264); const bf16x8 vf_ = {l_[0], l_[1], l_[2], l_[3], h_[0], h_[1], h_[2], h_[3]}; o[2] = MFMA32(F3_BF(pb2), vf_, o[2]); }
      { const s16x4 l_ = vtr(vp_ + 9728), h_ = vtr(vp_ + 11776); const bf16x8 vf_ = {l_[0], l_[1], l_[2], l_[3], h_[0], h_[1], h_[2], h_[3]}; o[3] = MFMA32(F3_BF(pb2), vf_, o[3]); }
      { const s16x4 l_ = vtr(vp_ + 12288), h_ = vtr(vp_ + 14336); const bf16x8 vf_ = {l_[0], l_[1], l_[2], l_[3], h_[0], h_[1], h_[2], h_[3]}; o[0] = MFMA32(F3_BF(pb3), vf_, o[0]); }
      { const s16x4 l_ = vtr(vp_ + 12800), h_ = vtr(vp_ + 14848); const bf16x8 vf_ = {l_[0], l_[1], l_[2], l_[3], h_[0], h_[1], h_[2], h_[3]}; o[1] = MFMA32(F3_BF(pb3), vf_, o[1]); }
      { const s16x4 l_ = vtr(vp_ + 13312), h_ = vtr(vp_ + 15360); const bf16x8 vf_ = {l_[0], l_[1], l_[2], l_[3], h_[0], h_[1], h_[2], h_[3]}; o[2] = MFMA32(F3_BF(pb3), vf_, o[2]); }
      { const s16x4 l_ = vtr(vp_ + 13824), h_ = vtr(vp_ + 15872); const bf16x8 vf_ = {l_[0], l_[1], l_[2], l_[3], h_[0], h_[1], h_[2], h_[3]}; o[3] = MFMA32(F3_BF(pb3), vf_, o[3]); }
    }
    l_reg = half_swap_add(l_reg);
    asm volatile("s_waitcnt vmcnt(0) lgkmcnt(0)\n\ts_barrier" ::: "memory");
    l_out = l_reg;
#undef F3_WAITB2
#undef F3_WAITB1
#undef F3_KLOADR
#undef F3_EX
#undef F3_BF
#undef F3_VF
#undef F3_RESC
#undef F3_STEP
}
__device__ __forceinline__ void flash3_mla(LAS unsigned char* lds, const KVSrc& src, int nt, const bf16x8 (&qr)[6], float C, f32x16 (&o)[2], float& l_out) {
    typedef LayE<96, 64> L;
    const int tid = opaque_tid(), wid = __builtin_amdgcn_readfirstlane(tid >> 6), lane = tid & 63, r32 = lane & 31, hi = lane >> 5;
    Dma3<96, 64> dma; dma.setup(src, wid, lane);
    const LAS unsigned char* kb0 = lds + hi * 1024 + r32 * 16;
    const LAS unsigned char* vb0 = lds + L::V_OFF + v_rd_base(lane);
    dma.issue(0, lds, wid); dma.issue(min(1, nt - 1), lds + L::TILE, wid); dma.issue(min(2, nt - 1), lds + 2 * L::TILE, wid);
    float mhat = 0.f, l_reg = 0.f; bool resc = false; f32x16 negm;
    f32x16 pA0, pA1, pB0, pB1; bf16x8 kf[12]; u32x4 pw0, pw1, pw2, pw3; s16x4 vlo[8], vhi[8];
#define F3_WAITB2() do { if constexpr (L::NI == 3) asm volatile("s_waitcnt vmcnt(6) lgkmcnt(0)\n\ts_barrier" ::: "memory"); else asm volatile("s_waitcnt vmcnt(4) lgkmcnt(0)\n\ts_barrier" ::: "memory"); } while (0)
#define F3_WAITB1() do { if constexpr (L::NI == 3) asm volatile("s_waitcnt vmcnt(3) lgkmcnt(0)\n\ts_barrier" ::: "memory"); else asm volatile("s_waitcnt vmcnt(2) lgkmcnt(0)\n\ts_barrier" ::: "memory"); } while (0)
#define F3_KLOAD2(KP, d0) do { kf[2 * (d0)] = *(const LAS bf16x8*)((KP) + (d0) * 2048); kf[2 * (d0) + 1] = *(const LAS bf16x8*)((KP) + (d0) * 2048 + 512); } while (0)
#define F3_EX(v) __builtin_amdgcn_exp2f(v)
#define F3_PK(P, i) cvtpk_s(P[i], P[i + 1])
#define F3_PAF(k) __builtin_bit_cast(bf16x8, pw##k)
#define F3_VF(i) (bf16x8){vlo[i][0], vlo[i][1], vlo[i][2], vlo[i][3], vhi[i][0], vhi[i][1], vhi[i][2], vhi[i][3]}
#define F3_RESC() do { if (resc) { const int t2_ = opaque_tid(); const LAS float* ws2_ = (const LAS float*)(lds + L::SCR_OFF) + (t2_ >> 6) * 64; const int h2_ = (t2_ & 63) >> 5; _Pragma("unroll") for (int r = 0; r < 16; ++r) { const float a_ = ws2_[crow(r, h2_)]; _Pragma("unroll") for (int d = 0; d < 2; ++d) o[d][r] *= a_; } } } while (0)
    F3_WAITB2();
    _Pragma("unroll") for (int d0 = 0; d0 < 6; ++d0) F3_KLOAD2(kb0, d0);
    pA0 = MFMA32(kf[0], qr[0], (f32x16){}); pA1 = MFMA32(kf[1], qr[0], (f32x16){});
    pA0 = MFMA32(kf[2], qr[1], pA0); pA1 = MFMA32(kf[3], qr[1], pA1);
    pA0 = MFMA32(kf[4], qr[2], pA0); pA1 = MFMA32(kf[5], qr[2], pA1);
    pA0 = MFMA32(kf[6], qr[3], pA0); pA1 = MFMA32(kf[7], qr[3], pA1);
    pA0 = MFMA32(kf[8], qr[4], pA0); pA1 = MFMA32(kf[9], qr[4], pA1);
    pA0 = MFMA32(kf[10], qr[5], pA0); pA1 = MFMA32(kf[11], qr[5], pA1);
    { const float rm = rowmax3(pA0, pA1); mhat = rm; const float nmh = -mhat;
      _Pragma("unroll") for (int r = 0; r < 16; ++r) { pA0[r] = F3_EX(pA0[r] + nmh); pA1[r] = F3_EX(pA1[r] + nmh); negm[r] = nmh; } PIN(negm); }
    dma.issue(min(3, nt - 1), lds + 3 * L::TILE, wid);
    F3_WAITB1();
    _Pragma("unroll") for (int d0 = 0; d0 < 6; ++d0) F3_KLOAD2(kb0 + L::TILE, d0);
#define F3_STEP(C0, C1, P0, P1, T) do { SBAR(); \
    const int sp_ = (((T) + 4) % 5) * L::TILE, sn_ = (((T) + 1) % 5) * L::TILE; \
    const LAS unsigned char* vp_ = vb0 + sp_; const LAS unsigned char* kn_ = kb0 + sn_; \
    float sacc = P0[0] + P0[1]; \
    vlo[0] = vtr(vp_ + 0); vhi[0] = vtr(vp_ + 1024); SBAR(); C0 = MFMA32(kf[0], qr[0], negm); sacc += P0[2]; sacc += P0[3]; sacc += P0[4]; sacc += P0[5]; pw0[0] = F3_PK(P0, 0); pw0[1] = F3_PK(P0, 2); PIN(pw0); PIN(sacc); SBAR(); \
    vlo[4] = vtr(vp_ + 512); vhi[4] = vtr(vp_ + 1536); SBAR(); C1 = MFMA32(kf[1], qr[0], negm); sacc += P0[6]; sacc += P0[7]; sacc += P0[8]; sacc += P0[9]; pw0[2] = F3_PK(P0, 4); pw0[3] = F3_PK(P0, 6); PIN(pw0); PIN(sacc); SBAR(); \
    vlo[1] = vtr(vp_ + 2048); vhi[1] = vtr(vp_ + 3072); SBAR(); C0 = MFMA32(kf[2], qr[1], C0); sacc += P0[10]; sacc += P0[11]; sacc += P0[12]; sacc += P0[13]; pw1[0] = F3_PK(P0, 8); pw1[1] = F3_PK(P0, 10); PIN(pw1); PIN(sacc); SBAR(); \
    vlo[5] = vtr(vp_ + 2560); vhi[5] = vtr(vp_ + 3584); SBAR(); C1 = MFMA32(kf[3], qr[1], C1); sacc += P0[14]; sacc += P0[15]; sacc += P1[0]; sacc += P1[1]; pw1[2] = F3_PK(P0, 12); pw1[3] = F3_PK(P0, 14); PIN(pw1); PIN(sacc); SBAR(); \
    vlo[2] = vtr(vp_ + 4096); vhi[2] = vtr(vp_ + 5120); SBAR(); C0 = MFMA32(kf[4], qr[2], C0); sacc += P1[2]; sacc += P1[3]; sacc += P1[4]; sacc += P1[5]; pw2[0] = F3_PK(P1, 0); pw2[1] = F3_PK(P1, 2); PIN(pw2); PIN(sacc); SBAR(); \
    vlo[6] = vtr(vp_ + 4608); vhi[6] = vtr(vp_ + 5632); SBAR(); C1 = MFMA32(kf[5], qr[2], C1); sacc += P1[6]; sacc += P1[7]; sacc += P1[8]; sacc += P1[9]; pw2[2] = F3_PK(P1, 4); pw2[3] = F3_PK(P1, 6); PIN(pw2); PIN(sacc); SBAR(); \
    vlo[3] = vtr(vp_ + 6144); vhi[3] = vtr(vp_ + 7168); SBAR(); C0 = MFMA32(kf[6], qr[3], C0); sacc += P1[10]; sacc += P1[11]; sacc += P1[12]; sacc += P1[13]; pw3[0] = F3_PK(P1, 8); pw3[1] = F3_PK(P1, 10); PIN(pw3); PIN(sacc); SBAR(); \
    vlo[7] = vtr(vp_ + 6656); vhi[7] = vtr(vp_ + 7680); SBAR(); C1 = MFMA32(kf[7], qr[3], C1); sacc += P1[14]; sacc += P1[15]; pw3[2] = F3_PK(P1, 12); pw3[3] = F3_PK(P1, 14); PIN(pw3); PIN(sacc); SBAR(); \
    C0 = MFMA32(kf[8], qr[4], C0); SBAR(); \
    C1 = MFMA32(kf[9], qr[4], C1); SBAR(); \
    C0 = MFMA32(kf[10], qr[5], C0); SBAR(); \
    C1 = MFMA32(kf[11], qr[5], C1); SBAR(); \
    l_reg += sacc; \
    dma.issue(min((T) + 3, nt - 1), lds + (((T) + 3) % 5) * L::TILE, wid); \
    { const float rm = rowmax3(C0, C1); resc = false; \
      if (__builtin_expect(__any(rm > F3_THR), 0)) { const float dl = __builtin_fmaxf(rm, 0.f); mhat += dl; const float f_ = __builtin_amdgcn_exp2f(-dl); l_reg *= f_; { const int t2_ = opaque_tid(); if ((t2_ & 63) < 32) ((LAS float*)(lds + L::SCR_OFF))[(t2_ >> 6) * 64 + (t2_ & 63)] = f_; } resc = true; \
        _Pragma("unroll") for (int r = 0; r < 16; ++r) { C0[r] -= dl; C1[r] -= dl; negm[r] = -mhat; } PIN(negm); } } \
    SBAR(); \
    o[0] = MFMA32(F3_PAF(0), F3_VF(0), o[0]); C0[0] = F3_EX(C0[0]); C0[1] = F3_EX(C0[1]); C0[2] = F3_EX(C0[2]); C0[3] = F3_EX(C0[3]); PIN(C0); SBAR(); \
    F3_KLOAD2(kn_, 0); SBAR(); o[1] = MFMA32(F3_PAF(0), F3_VF(4), o[1]); C0[4] = F3_EX(C0[4]); C0[5] = F3_EX(C0[5]); C0[6] = F3_EX(C0[6]); C0[7] = F3_EX(C0[7]); PIN(C0); SBAR(); \
    F3_KLOAD2(kn_, 1); SBAR(); o[0] = MFMA32(F3_PAF(1), F3_VF(1), o[0]); C0[8] = F3_EX(C0[8]); C0[9] = F3_EX(C0[9]); C0[10] = F3_EX(C0[10]); C0[11] = F3_EX(C0[11]); PIN(C0); SBAR(); \
    F3_KLOAD2(kn_, 2); SBAR(); o[1] = MFMA32(F3_PAF(1), F3_VF(5), o[1]); C0[12] = F3_EX(C0[12]); C0[13] = F3_EX(C0[13]); C0[14] = F3_EX(C0[14]); C0[15] = F3_EX(C0[15]); PIN(C0); SBAR(); \
    F3_KLOAD2(kn_, 3); SBAR(); o[0] = MFMA32(F3_PAF(2), F3_VF(2), o[0]); C1[0] = F3_EX(C1[0]); C1[1] = F3_EX(C1[1]); C1[2] = F3_EX(C1[2]); C1[3] = F3_EX(C1[3]); PIN(C1); SBAR(); \
    F3_KLOAD2(kn_, 4); SBAR(); o[1] = MFMA32(F3_PAF(2), F3_VF(6), o[1]); C1[4] = F3_EX(C1[4]); C1[5] = F3_EX(C1[5]); C1[6] = F3_EX(C1[6]); C1[7] = F3_EX(C1[7]); PIN(C1); SBAR(); \
    F3_KLOAD2(kn_, 5); SBAR(); o[0] = MFMA32(F3_PAF(3), F3_VF(3), o[0]); C1[8] = F3_EX(C1[8]); C1[9] = F3_EX(C1[9]); C1[10] = F3_EX(C1[10]); C1[11] = F3_EX(C1[11]); PIN(C1); SBAR(); \
    o[1] = MFMA32(F3_PAF(3), F3_VF(7), o[1]); C1[12] = F3_EX(C1[12]); C1[13] = F3_EX(C1[13]); C1[14] = F3_EX(C1[14]); C1[15] = F3_EX(C1[15]); PIN(C1); SBAR(); \
    } while (0)
#pragma unroll 1
    for (int t = 1; t + 1 < nt; t += 2) {
        F3_STEP(pB0, pB1, pA0, pA1, t); F3_WAITB1(); F3_RESC();
        F3_STEP(pA0, pA1, pB0, pB1, t + 1); F3_WAITB1(); F3_RESC();
    }
    F3_STEP(pB0, pB1, pA0, pA1, nt - 1); F3_WAITB1(); F3_RESC();
    { float sacc = pB0[0] + pB0[1];
      _Pragma("unroll") for (int r = 2; r < 16; ++r) sacc += pB0[r];
      _Pragma("unroll") for (int r = 0; r < 16; ++r) sacc += pB1[r];
      l_reg += sacc;
      pw0 = (u32x4){F3_PK(pB0, 0), F3_PK(pB0, 2), F3_PK(pB0, 4), F3_PK(pB0, 6)}; pw1 = (u32x4){F3_PK(pB0, 8), F3_PK(pB0, 10), F3_PK(pB0, 12), F3_PK(pB0, 14)};
      pw2 = (u32x4){F3_PK(pB1, 0), F3_PK(pB1, 2), F3_PK(pB1, 4), F3_PK(pB1, 6)}; pw3 = (u32x4){F3_PK(pB1, 8), F3_PK(pB1, 10), F3_PK(pB1, 12), F3_PK(pB1, 14)};
      const LAS unsigned char* vp_ = vb0 + ((nt - 1) % 5) * L::TILE;
      { const s16x4 l_ = vtr(vp_ + 0), h_ = vtr(vp_ + 1024); const bf16x8 vf_ = {l_[0], l_[1], l_[2], l_[3], h_[0], h_[1], h_[2], h_[3]}; o[0] = MFMA32(F3_PAF(0), vf_, o[0]); }
      { const s16x4 l_ = vtr(vp_ + 2048), h_ = vtr(vp_ + 3072); const bf16x8 vf_ = {l_[0], l_[1], l_[2], l_[3], h_[0], h_[1], h_[2], h_[3]}; o[0] = MFMA32(F3_PAF(1), vf_, o[0]); }
      { const s16x4 l_ = vtr(vp_ + 4096), h_ = vtr(vp_ + 5120); const bf16x8 vf_ = {l_[0], l_[1], l_[2], l_[3], h_[0], h_[1], h_[2], h_[3]}; o[0] = MFMA32(F3_PAF(2), vf_, o[0]); }
      { const s16x4 l_ = vtr(vp_ + 6144), h_ = vtr(vp_ + 7168); const bf16x8 vf_ = {l_[0], l_[1], l_[2], l_[3], h_[0], h_[1], h_[2], h_[3]}; o[0] = MFMA32(F3_PAF(3), vf_, o[0]); }
      { const s16x4 l_ = vtr(vp_ + 512), h_ = vtr(vp_ + 1536); const bf16x8 vf_ = {l_[0], l_[1], l_[2], l_[3], h_[0], h_[1], h_[2], h_[3]}; o[1] = MFMA32(F3_PAF(0), vf_, o[1]); }
      { const s16x4 l_ = vtr(vp_ + 2560), h_ = vtr(vp_ + 3584); const bf16x8 vf_ = {l_[0], l_[1], l_[2], l_[3], h_[0], h_[1], h_[2], h_[3]}; o[1] = MFMA32(F3_PAF(1), vf_, o[1]); }
      { const s16x4 l_ = vtr(vp_ + 4608), h_ = vtr(vp_ + 5632); const bf16x8 vf_ = {l_[0], l_[1], l_[2], l_[3], h_[0], h_[1], h_[2], h_[3]}; o[1] = MFMA32(F3_PAF(2), vf_, o[1]); }
      { const s16x4 l_ = vtr(vp_ + 6656), h_ = vtr(vp_ + 7680); const bf16x8 vf_ = {l_[0], l_[1], l_[2], l_[3], h_[0], h_[1], h_[2], h_[3]}; o[1] = MFMA32(F3_PAF(3), vf_, o[1]); }
    }
    l_reg = half_swap_add(l_reg);
    asm volatile("s_waitcnt vmcnt(0) lgkmcnt(0)\n\ts_barrier" ::: "memory");
    l_out = l_reg;
#undef F3_WAITB2
#undef F3_WAITB1
#undef F3_KLOAD2
#undef F3_EX
#undef F3_PK
#undef F3_PAF
#undef F3_VF
#undef F3_RESC
#undef F3_STEP
}
#undef PIN
#undef MFMA32
#undef MX3
}
namespace att {
__device__ __forceinline__ void scale_q(bf16x8& q, float c) {
    const u32x4 w = __builtin_bit_cast(u32x4, q); u32x4 x;
    x.x = cvtpk(bf_lo(w.x) * c, bf_hi(w.x) * c); x.y = cvtpk(bf_lo(w.y) * c, bf_hi(w.y) * c); x.z = cvtpk(bf_lo(w.z) * c, bf_hi(w.z) * c); x.w = cvtpk(bf_lo(w.w) * c, bf_hi(w.w) * c);
    q = __builtin_bit_cast(bf16x8, x);
}
template <int ABL = 0>
__device__ __forceinline__ void diff_unit(const Params& P, LAS unsigned char* lds, int b, int h, int qb, bool isctx) {
    typedef LayE<64, 128> L;
    const bf16_t* QKV0 = (const bf16_t*)(P.ws + WS_BIG); bf16_t* ATT = (bf16_t*)(P.ws + WS_ATT);
    f32x16 o[4]; float rl[16];
#pragma unroll 1
    for (int map = 0; map < 2; ++map) {
        float l_reg = 0.f;
        {   const int tid = opaque_tid(), wid = tid >> 6, lane = tid & 63, r32 = lane & 31, hi = lane >> 5;
            const int qrow0 = isctx ? M_LAT + b * 256 + wid * 32 : b * 4096 + qb * 256 + wid * 32;
            GAS const bf16_t* QKV = (GAS const bf16_t*)QKV0; asm volatile("" : "+s"(QKV));
            KVSrc src; src.k0 = QKV + 512 + h * 128 + map * 64; src.ldk0 = EVEN_IN; src.k1 = nullptr; src.ldk1 = 0; src.v = QKV + 1024 + h * 128; src.ldv = EVEN_IN;
            src.row_lat0 = b * 4096; src.n_lat = isctx ? 0 : 64; src.row_ctx0 = M_LAT + b * 256;
            bf16x8 qr[4]; load_q<64>(qr, QKV + (size_t)(qrow0 + r32) * EVEN_IN + h * 128 + map * 64, hi);
#pragma unroll
            for (int i_ = 0; i_ < 4; ++i_) scale_q(qr[i_], 0.125f * LOG2E);
#pragma unroll
            for (int d = 0; d < 4; ++d) o[d] = (f32x16){};
            flash3_diff(lds, src, src.n_lat + 4, qr, 0.125f * LOG2E, o, l_reg); }
        {   const int tid = opaque_tid(), wid = tid >> 6, lane = tid & 63, r32 = lane & 31, hi = lane >> 5;
            LAS float* scr = (LAS float*)(lds + L::SCR_OFF) + wid * 64;
            row_recips(l_reg, scr, r32, hi, rl);
            if (map == 0) {
                unsigned* stash = (unsigned*)(P.ws + WS_RET) + ((size_t)blockIdx.x * 8 + wid) * 2048 + lane;
#pragma unroll
                for (int d = 0; d < 4; ++d)
#pragma unroll
                    for (int r = 0; r < 8; ++r) stash[(d * 8 + r) * 64] = cvtpk(o[d][2 * r] * rl[2 * r], o[d][2 * r + 1] * rl[2 * r + 1]);
            } }
    }
    const int tid = opaque_tid(), wid = tid >> 6, lane = tid & 63, r32 = lane & 31, hi = lane >> 5;
    const float lam = ((const float*)(P.ws + WS_MISC))[0];
    const int qrow0 = isctx ? M_LAT + b * 256 + wid * 32 : b * 4096 + qb * 256 + wid * 32;
    const unsigned* stash_r = (const unsigned*)(P.ws + WS_RET) + ((size_t)blockIdx.x * 8 + wid) * 2048 + lane;
    bf16_t* att_e = ATT + (size_t)qrow0 * 1024 + h * 128;
    LAS unsigned char* wst = lds + wid * (32 * OROW<128>);
#pragma unroll
    for (int r = 0; r < 16; ++r) {
#pragma unroll
        for (int d = 0; d < 4; ++d) { const unsigned w = stash_r[(d * 8 + (r >> 1)) * 64]; const float o1 = (r & 1) ? bf_hi(w) : bf_lo(w); o[d][r] = o1 - lam * (o[d][r] * rl[r]); }
    }
    { float one[16];
#pragma unroll
      for (int r = 0; r < 16; ++r) one[r] = 1.0f;
      stage_o<128>(wst, o, one, r32, hi); }
    { const float* subln = P.in[I_SUBLN];
      const int ch = lane & 15;
      const f32x4 g0 = *(const f32x4*)(subln + ch * 8), g1 = *(const f32x4*)(subln + ch * 8 + 4);
#pragma unroll
      for (int i = 0; i < 8; ++i) {
          const int row = i * 4 + (lane >> 4);
          const u32x4 v = *(const LAS u32x4*)(wst + row * OROW<128> + ch * 16);
          float x[8] = {bf_lo(v.x), bf_hi(v.x), bf_lo(v.y), bf_hi(v.y), bf_lo(v.z), bf_hi(v.z), bf_lo(v.w), bf_hi(v.w)};
          float ss = 0.f;
#pragma unroll
          for (int j = 0; j < 8; ++j) ss += x[j] * x[j];
          ss += xshfl<1>(ss); ss += xshfl<2>(ss); ss += xshfl<4>(ss); ss += xshfl<8>(ss);
          const float rs = rsqrtf(ss * (1.0f / 128.0f) + RMS_EPS) * 0.8f;
          u32x4 w; w.x = cvtpk(x[0] * rs * g0[0], x[1] * rs * g0[1]); w.y = cvtpk(x[2] * rs * g0[2], x[3] * rs * g0[3]);
          w.z = cvtpk(x[4] * rs * g1[0], x[5] * rs * g1[1]); w.w = cvtpk(x[6] * rs * g1[2], x[7] * rs * g1[3]);
          *(u32x4*)(att_e + (size_t)row * 1024 + ch * 8) = w;
      } }
    __syncthreads();
}
__device__ __forceinline__ void na_unit(const Params& P, LAS unsigned char* lds, int b, int h, int g4, bool isctx) {
    typedef LayD<64, 64> L;
    const int tid = opaque_tid(), wid = tid >> 6, lane = tid & 63, r32 = lane & 31, hi = lane >> 5;
    const bf16_t* QKV = (const bf16_t*)(P.ws + WS_BIG); bf16_t* ATT = (bf16_t*)(P.ws + WS_ATT);
    LAS float* tab = (LAS float*)(lds + L::TAB_OFF);
    LAS float* scr = (LAS float*)(lds + L::SCR_OFF) + wid * 64;
    KVSrc src; src.k0 = QKV + 2048 + h * 64; src.ldk0 = EVEN_IN; src.k1 = nullptr; src.ldk1 = 0; src.v = QKV + 2560 + h * 64; src.ldv = EVEN_IN;
    src.row_ctx0 = M_LAT + b * 256;
    NaWave nw{}; int qrow0;
    if (isctx) { src.row_lat0 = 0; src.n_lat = 0; qrow0 = M_LAT + b * 256 + wid * 32; }
    else {
        const int r0 = 4 * g4, rq = r0 + (wid >> 1), ch = wid & 1;
        const int kr_first = min(max(r0 - 4, 0), 56), kr_last = min(max(r0 + 3 - 4, 0), 56) + 7;
        const int rs_w = min(max(rq - 4, 0), 56);
        src.row_lat0 = b * 4096 + kr_first * 64; src.n_lat = kr_last - kr_first + 1;
        nw.active_lo = rs_w - kr_first; nw.active_hi = rs_w + 7 - kr_first; nw.dr0 = kr_first - rq + 7;
        nw.c = 32 * ch + r32; nw.cs = min(max(nw.c - 8, 0), 48);
        qrow0 = b * 4096 + rq * 64 + 32 * ch;
        const float* rpb = P.in[I_RPB] + (size_t)h * 15 * 31;
        for (int i = tid; i < 15 * 31; i += NTHREADS) tab[i] = rpb[i] * LOG2E;
    }
    bf16x8 qr[4]; load_q<64>(qr, QKV + (size_t)(qrow0 + r32) * EVEN_IN + 1536 + h * 64, hi);
    f32x16 o[2]; o[0] = (f32x16){}; o[1] = (f32x16){};
    float m_reg = -1e30f, l_reg = 0.f;
    if (isctx) flash_loop<64, 64, 0>(lds, src, 4, qr, 0.125f * LOG2E, o, m_reg, l_reg, nw);
    else flash_loop<64, 64, 1>(lds, src, src.n_lat + 4, qr, 0.125f * LOG2E, o, m_reg, l_reg, nw);
    float rl[16]; row_recips(l_reg, scr, r32, hi, rl);
    LAS unsigned char* wst = lds + wid * (32 * OROW<64>);
    stage_o<64>(wst, o, rl, r32, hi);
    store_rows<64>(wst, ATT, 1024, qrow0, 512 + h * 64, lane);
    __syncthreads();
}
template <int ABL = 0>
__device__ __forceinline__ void mla_unit(const Params& P, LAS unsigned char* lds, int b, int h, int qb) {
    typedef LayE<96, 64> L;
    const int tid = opaque_tid(), wid = tid >> 6, lane = tid & 63, r32 = lane & 31, hi = lane >> 5;
    const bf16_t* QM = (const bf16_t*)(P.ws + WS_QM); const bf16_t* KVM = (const bf16_t*)(P.ws + WS_KVM); const bf16_t* KR = (const bf16_t*)(P.ws + WS_KR);
    bf16_t* ATT = (bf16_t*)(P.ws + WS_ATT);
    LAS float* scr = (LAS float*)(lds + L::SCR_OFF) + wid * 64;
    KVSrc src; src.k0 = KVM + h * 128; src.ldk0 = 1024; src.k1 = KR; src.ldk1 = 32; src.v = KVM + h * 128 + 64; src.ldv = 1024;
    src.row_lat0 = b * 4096; src.n_lat = 64; src.row_ctx0 = M_LAT + b * 256;
    const int qrow0 = b * 4096 + qb * 256 + wid * 32;
    NaWave nw{};
    bf16x8 qr[6]; load_q<96>(qr, QM + (size_t)(qrow0 + r32) * 768 + h * 96, hi);
#pragma unroll
    for (int i_ = 0; i_ < 6; ++i_) scale_q(qr[i_], 0.10206207261596575f * LOG2E);
    f32x16 o[2]; o[0] = (f32x16){}; o[1] = (f32x16){};
    float m_reg = -1e30f, l_reg = 0.f;
    flash3_mla(lds, src, 68, qr, 0.10206207261596575f * LOG2E, o, l_reg);
    float rl[16]; row_recips(l_reg, scr, r32, hi, rl);
    LAS unsigned char* wst = lds + wid * (32 * OROW<64>);
    stage_o<64>(wst, o, rl, r32, hi);
    store_rows<64>(wst, ATT, 1024, qrow0, h * 64, lane);
    __syncthreads();
}
}
namespace ret {
using att::tr_read; using att::v_st; using att::v_rd_base; using att::v_rd_off;
constexpr int PQ = 416, PK_ = 672, PV_ = 928, PG_ = 1440;
constexpr float KSCALE = 0.125f;
__device__ __forceinline__ size_t ret_off(int bh, int n, int dir) { return (((size_t)bh * 34 + n) * 2 + dir) * 8192; }
__device__ __forceinline__ int chunk_row0(int b, int n) { return (n < 32) ? b * 4096 + n * 128 : M_LAT + b * 256 + (n - 32) * 128; }

constexpr int R1_KF = 0, R1_KB = 16384, R1_V = 32768, R1_END = 65536;
__device__ __forceinline__ void r1_unit(const Params& P, LAS unsigned char* lds, int bh, int n) {
    const int tid = opaque_tid(), wid = tid >> 6, lane = tid & 63, r32 = lane & 31, hi = lane >> 5;
    const int b = bh >> 2, h = bh & 3;
    const bf16_t* PROJ = (const bf16_t*)(P.ws + WS_PROJ);
    const float* misc = (const float*)(P.ws + WS_MISC);
    const float lgf = misc[8 + h], lgb = misc[12 + h];
    const int row0 = chunk_row0(b, n);
#pragma unroll
    for (int i = 0; i < 2; ++i) {
        const int c = tid + 512 * i, j = c >> 3, part = c & 7;
        const u32x4 kv = *(const u32x4*)(PROJ + (size_t)(row0 + j) * ODD_IN + PK_ + h * 64 + part * 8);
        const float wf = KSCALE * __builtin_amdgcn_exp2f(lgf * (float)(127 - j)), wb = KSCALE * __builtin_amdgcn_exp2f(lgb * (float)j);
        u32x4 kf, kb;
        kf.x = cvtpk(bf_lo(kv.x) * wf, bf_hi(kv.x) * wf); kf.y = cvtpk(bf_lo(kv.y) * wf, bf_hi(kv.y) * wf); kf.z = cvtpk(bf_lo(kv.z) * wf, bf_hi(kv.z) * wf); kf.w = cvtpk(bf_lo(kv.w) * wf, bf_hi(kv.w) * wf);
        kb.x = cvtpk(bf_lo(kv.x) * wb, bf_hi(kv.x) * wb); kb.y = cvtpk(bf_lo(kv.y) * wb, bf_hi(kv.y) * wb); kb.z = cvtpk(bf_lo(kv.z) * wb, bf_hi(kv.z) * wb); kb.w = cvtpk(bf_lo(kv.w) * wb, bf_hi(kv.w) * wb);
        const int off = (j >> 6) * 8192 + v_st<64>(j & 63, part * 8);
        *(LAS u32x4*)(lds + R1_KF + off) = kf; *(LAS u32x4*)(lds + R1_KB + off) = kb;
    }
#pragma unroll
    for (int i = 0; i < 4; ++i) {
        const int c = tid + 512 * i, j = c >> 4, c8 = c & 15;
        const u32x4 vv = *(const u32x4*)(PROJ + (size_t)(row0 + j) * ODD_IN + PV_ + h * 128 + c8 * 8);
        *(LAS u32x4*)(lds + R1_V + (j >> 6) * 16384 + v_st<128>(j & 63, c8 * 8)) = vv;
    }
    __syncthreads();
    const int db = wid & 1, vb = wid >> 1;
    const unsigned base = (unsigned)(uintptr_t)lds + (unsigned)v_rd_base(lane);
    const unsigned kfa = base + R1_KF + db * 512, kba = base + R1_KB + db * 512, va = base + R1_V + vb * 512;
    f32x16 af = (f32x16){}, ab = (f32x16){};
#define R1_STEP(T, KS) do { \
        const s16x4 fl = tr_read<v_rd_off<64>(0, KS, 0) + T * 8192>(kfa), fh = tr_read<v_rd_off<64>(0, KS, 1) + T * 8192>(kfa); \
        const s16x4 bl = tr_read<v_rd_off<64>(0, KS, 0) + T * 8192>(kba), bh_ = tr_read<v_rd_off<64>(0, KS, 1) + T * 8192>(kba); \
        const s16x4 vl = tr_read<v_rd_off<128>(0, KS, 0) + T * 16384>(va), vh = tr_read<v_rd_off<128>(0, KS, 1) + T * 16384>(va); \
        asm volatile("s_waitcnt lgkmcnt(0)" ::: "memory"); SBAR(); \
        af = __builtin_amdgcn_mfma_f32_32x32x16_bf16(PK8(fl, fh), PK8(vl, vh), af, 0, 0, 0); \
        ab = __builtin_amdgcn_mfma_f32_32x32x16_bf16(PK8(bl, bh_), PK8(vl, vh), ab, 0, 0, 0); } while (0)
    R1_STEP(0, 0); R1_STEP(0, 1); R1_STEP(0, 2); R1_STEP(0, 3); R1_STEP(1, 0); R1_STEP(1, 1); R1_STEP(1, 2); R1_STEP(1, 3);
#undef R1_STEP
    float* U = (float*)(P.ws + WS_RET);
    float* uf = U + ret_off(bh, n, 0); float* ub = U + ret_off(bh, n, 1);
#pragma unroll
    for (int r = 0; r < 16; ++r) { const int d = 32 * db + crow(r, hi); uf[d * 128 + 32 * vb + r32] = af[r]; ub[d * 128 + 32 * vb + r32] = ab[r]; }
    __syncthreads();
}
__device__ __forceinline__ void r2_scan(const Params& P) {
    const float* misc = (const float*)(P.ws + WS_MISC);
    float* U = (float*)(P.ws + WS_RET);
    const int gt = blockIdx.x * NTHREADS + opaque_tid(), nth = gridDim.x * NTHREADS;
    for (int idx = gt; idx < 32 * 2 * 8192; idx += nth) {
        const int e = idx & 8191, dir = (idx >> 13) & 1, bh = idx >> 14, h = bh & 3;
        const float gC = __builtin_amdgcn_exp2f(128.0f * misc[8 + dir * 4 + h]);
        float* base = U + ret_off(bh, 0, dir) + e;
        float u[34];
#pragma unroll
        for (int n = 0; n < 34; ++n) u[n] = base[(size_t)n * 16384];
        if (dir == 0) {
            float carry = gC * u[32] + u[33];
#pragma unroll
            for (int n = 0; n < 32; ++n) { base[(size_t)n * 16384] = carry; carry = gC * carry + u[n]; }
        } else {
            float carry = u[32] + gC * u[33];
#pragma unroll
            for (int n = 31; n >= 0; --n) { base[(size_t)n * 16384] = carry; carry = gC * carry + u[n]; }
        }
    }
}
constexpr int R3_K = 0, R3_KB = 64 * 144, R3_V = 2 * R3_KB  , R3_SF = R3_V + 32768, R3_SB = R3_SF + 16384, R3_RED = R3_SB + 16384, R3_END = R3_RED + 1024;
__device__ __forceinline__ void r3_unit(const Params& P, LAS unsigned char* lds, int bh, int n) {
    const int tid = opaque_tid(), wid = tid >> 6, lane = tid & 63, r32 = lane & 31, hi = lane >> 5;
    const int b = bh >> 2, h = bh & 3;
    const bf16_t* PROJ = (const bf16_t*)(P.ws + WS_PROJ); bf16_t* ATT = (bf16_t*)(P.ws + WS_ATT);
    const float* misc = (const float*)(P.ws + WS_MISC);
    const float lgf = misc[8 + h], lgb = misc[12 + h];
    const int row0 = b * 4096 + n * 128;
#pragma unroll
    for (int i = 0; i < 2; ++i) { const int c = tid + 512 * i, j = c >> 3, part = c & 7;
        *(LAS u32x4*)(lds + R3_K + (j >> 6) * R3_KB + (j & 63) * 144 + part * 16) = *(const u32x4*)(PROJ + (size_t)(row0 + j) * ODD_IN + PK_ + h * 64 + part * 8); }
#pragma unroll
    for (int i = 0; i < 4; ++i) { const int c = tid + 512 * i, j = c >> 4, c8 = c & 15;
        *(LAS u32x4*)(lds + R3_V + (j >> 6) * 16384 + v_st<128>(j & 63, c8 * 8)) = *(const u32x4*)(PROJ + (size_t)(row0 + j) * ODD_IN + PV_ + h * 128 + c8 * 8); }
    const float* S = (const float*)(P.ws + WS_RET);
#pragma unroll
    for (int dir = 0; dir < 2; ++dir) { const float* sp = S + ret_off(bh, n, dir);
#pragma unroll
        for (int i = 0; i < 2; ++i) { const int c = tid + 512 * i, d = c >> 4, c8 = c & 15;
            const f32x4 x0 = *(const f32x4*)(sp + d * 128 + c8 * 8), x1 = *(const f32x4*)(sp + d * 128 + c8 * 8 + 4);
            u32x4 w; w.x = cvtpk(x0[0], x0[1]); w.y = cvtpk(x0[2], x0[3]); w.z = cvtpk(x1[0], x1[1]); w.w = cvtpk(x1[2], x1[3]);
            *(LAS u32x4*)(lds + (dir ? R3_SB : R3_SF) + v_st<128>(d, c8 * 8)) = w; } }
    __syncthreads();
    const int qb = wid & 3, dvh = wid >> 2, ipos = 32 * qb + r32;
    bf16x8 qr[4]; att::load_q<64>(qr, PROJ + (size_t)(row0 + ipos) * ODD_IN + PQ + h * 64, hi);
    f32x16 o[2]; o[0] = (f32x16){}; o[1] = (f32x16){};
    const unsigned vbase = (unsigned)(uintptr_t)lds + (unsigned)v_rd_base(lane) + dvh * 1024;
#pragma unroll
    for (int T = 0; T < 2; ++T) {
        f32x16 p0, p1; att::qkt<64>(p0, p1, lds + R3_K + T * R3_KB, qr, r32, hi);
#pragma unroll
        for (int r = 0; r < 16; ++r) {
            const int j0 = 64 * T + crow(r, hi), j1 = j0 + 32;
            const float w0 = (j0 <= ipos) ? __builtin_amdgcn_exp2f(lgf * (float)(ipos - j0)) : __builtin_amdgcn_exp2f(lgb * (float)(j0 - ipos));
            const float w1 = (j1 <= ipos) ? __builtin_amdgcn_exp2f(lgf * (float)(ipos - j1)) : __builtin_amdgcn_exp2f(lgb * (float)(j1 - ipos));
            p0[r] *= KSCALE * w0; p1[r] *= KSCALE * w1;
        }
        bf16x8 pa0, pa1, pa2, pa3; att::pack_p(p0, p1, pa0, pa1, pa2, pa3);
        att::pv_one<128, 0>(o[0], vbase + R3_V + T * 16384, pa0, pa1, pa2, pa3); att::pv_one<128, 1>(o[1], vbase + R3_V + T * 16384, pa0, pa1, pa2, pa3);
    }
#pragma unroll
    for (int dir = 0; dir < 2; ++dir) {
        const float sc = dir ? __builtin_amdgcn_exp2f(lgb * (float)(128 - ipos)) : __builtin_amdgcn_exp2f(lgf * (float)(ipos + 1));
        bf16x8 pa[4];
#pragma unroll
        for (int s = 0; s < 4; ++s) { const u32x4 w = __builtin_bit_cast(u32x4, qr[s]); u32x4 x;
            x.x = cvtpk(bf_lo(w.x) * sc, bf_hi(w.x) * sc); x.y = cvtpk(bf_lo(w.y) * sc, bf_hi(w.y) * sc); x.z = cvtpk(bf_lo(w.z) * sc, bf_hi(w.z) * sc); x.w = cvtpk(bf_lo(w.w) * sc, bf_hi(w.w) * sc);
            pa[s] = __builtin_bit_cast(bf16x8, x); }
        const unsigned sb = vbase + (dir ? R3_SB : R3_SF);
        att::pv_one<128, 0>(o[0], sb, pa[0], pa[1], pa[2], pa[3]); att::pv_one<128, 1>(o[1], sb, pa[0], pa[1], pa[2], pa[3]);
    }
    __syncthreads();
    constexpr int TROW = 128 * 2 + 16;
    LAS unsigned char* tile = lds + R3_V;
#pragma unroll
    for (int r = 0; r < 16; ++r) { LAS unsigned char* rp = tile + (32 * qb + crow(r, hi)) * TROW + (64 * dvh + r32) * 2;
        *(LAS bf16_t*)rp = (bf16_t)f2bf(o[0][r]); *(LAS bf16_t*)(rp + 64) = (bf16_t)f2bf(o[1][r]); }
    __syncthreads();
#pragma unroll
    for (int i = 0; i < 4; ++i) {
        const int idx = i * 512 + tid, row = idx >> 4, ch = idx & 15;
        const u32x4 v = *(const LAS u32x4*)(tile + row * TROW + ch * 16);
        const u32x4 gv = *(const u32x4*)(PROJ + (size_t)(row0 + row) * ODD_IN + PG_ + h * 128 + ch * 8);
        float x[8] = {bf_lo(v.x), bf_hi(v.x), bf_lo(v.y), bf_hi(v.y), bf_lo(v.z), bf_hi(v.z), bf_lo(v.w), bf_hi(v.w)};
        const float g[8] = {bf_lo(gv.x), bf_hi(gv.x), bf_lo(gv.y), bf_hi(gv.y), bf_lo(gv.z), bf_hi(gv.z), bf_lo(gv.w), bf_hi(gv.w)};
        float ss = 0.f;
#pragma unroll
        for (int j = 0; j < 8; ++j) ss += x[j] * x[j];
        ss += xshfl<1>(ss); ss += xshfl<2>(ss); ss += xshfl<4>(ss); ss += xshfl<8>(ss);
        const float rs = rsqrtf(ss * (1.0f / 128.0f) + RMS_EPS);
#pragma unroll
        for (int j = 0; j < 8; ++j) x[j] = x[j] * rs * silu_f(g[j]);
        u32x4 w; w.x = cvtpk(x[0], x[1]); w.y = cvtpk(x[2], x[3]); w.z = cvtpk(x[4], x[5]); w.w = cvtpk(x[6], x[7]);
        *(u32x4*)(ATT + (size_t)(row0 + row) * 1024 + 512 + h * 128 + ch * 8) = w;
    }
    __syncthreads();
}
}
__device__ __forceinline__ void phase_prologue(const Params& P, LAS unsigned char* lds) {
    const int tid = opaque_tid();
    constexpr int N_MODS = 192;
    for (int it = blockIdx.x; it < N_MODS + 2; it += gridDim.x) {
        if (it < N_MODS) mods_item(P, it, (LAS float*)lds, (LAS float*)(lds + 9 * 1024 * 4), tid);
        else if (it == N_MODS) tables_item(P, tid);
        else { u32x4* z = (u32x4*)((bf16_t*)(P.ws + WS_W_OIN) + (size_t)1952 * 1024); for (int i = tid; i < 96 * 1024 / 8; i += NTHREADS) z[i] = (u32x4){0u, 0u, 0u, 0u}; }
    }
    convert_weights(P, 0, true, (LAS float*)lds, tid);
}
__device__ __forceinline__ int xcd_unit(int c, int k) { const int x = c & 7, y = c >> 3; return 256 * k + (((2 * x + (y >> 4)) << 4) | (y & 15)); }
__device__ __forceinline__ void phase_attn_even(const Params& P, LAS unsigned char* lds, int part = 3) {
    constexpr int N_DIFF = 512, N_NA = 1024, N_DIFFC = 32, N_NAC = 64, N_ALL = N_DIFF + N_NA + N_DIFFC + N_NAC;
    const bool remap = (gridDim.x == 256);
    for (int k = 0, u0 = blockIdx.x; u0 < N_ALL; ++k, u0 += gridDim.x) {
        if (u0 < N_DIFF) { if (part & 1) { const int u = remap ? xcd_unit(blockIdx.x, k) : u0; att::diff_unit(P, lds, u >> 6, (u >> 4) & 3, u & 15, false); } }
        else if (u0 < N_DIFF + N_NA) { if (part & 2) { const int r = remap ? xcd_unit(blockIdx.x, k - 2) : u0 - N_DIFF; att::na_unit(P, lds, r >> 7, (r >> 4) & 7, r & 15, false); } }
        else if (u0 < N_DIFF + N_NA + N_DIFFC) { const int r = u0 - N_DIFF - N_NA; att::diff_unit(P, lds, r >> 2, r & 3, 0, true); }
        else { const int r = u0 - N_DIFF - N_NA - N_DIFFC; att::na_unit(P, lds, r >> 3, r & 7, 0, true); }
    }
}
#ifndef ABL_MASK
#define ABL_MASK 0
#endif
#ifndef REPEAT_MASK
#define REPEAT_MASK 0u
#endif
enum { K_PRO = 0, K_NORM1, K_GEMM, K_ATTN_EVEN, K_NORM2, K_TOPK, K_R1, K_MLA, K_R3, K_FINAL };
enum { J_EVEN_IN = 0, J_OUT0, J_UP0, J_DOWN0, J_ODD_IN, J_UPQ, J_UPKV, J_OUT1, J_UP1, J_DOWN1 };
constexpr int NSTEPS = 22;
__device__ __forceinline__ void step_desc(int step, int& kind, int& arg, bool& sync) {
    sync = true;
    switch (step) {
        case 0: kind = K_PRO; arg = 0; break;
        case 1: kind = K_NORM1; arg = 0; break;
        case 2: kind = K_GEMM; arg = J_EVEN_IN; break;
        case 3: kind = K_ATTN_EVEN; arg = 0; break;
        case 4: kind = K_GEMM; arg = J_OUT0; break;
        case 5: kind = K_NORM2; arg = 0; break;
        case 6: kind = K_TOPK; arg = 0; break;
        case 7: kind = K_GEMM; arg = J_UP0; break;
        case 8: kind = K_GEMM; arg = J_DOWN0; break;
        case 9: kind = K_NORM1; arg = 1; break;
        case 10: kind = K_GEMM; arg = J_ODD_IN; break;
        case 11: kind = K_GEMM; arg = J_UPQ; sync = false; break;
        case 12: kind = K_GEMM; arg = J_UPKV; sync = false; break;
        case 13: kind = K_R1; arg = 0; break;
        case 14: kind = K_MLA; arg = 0; break;
        case 15: kind = K_R3; arg = 0; break;
        case 16: kind = K_GEMM; arg = J_OUT1; break;
        case 17: kind = K_NORM2; arg = 1; break;
        case 18: kind = K_TOPK; arg = 1; break;
        case 19: kind = K_GEMM; arg = J_UP1; break;
        case 20: kind = K_GEMM; arg = J_DOWN1; break;
        default: kind = K_FINAL; arg = 0; break;
    }
}
__device__ __forceinline__ void gemm_job(const Params& P, int job, pg8::Gemm& g, pg8::Sched& S, pg8::Epi& E) {
    unsigned char* ws = P.ws;
    g.lda = 1024; g.ldb = 1024; g.K = 1024; E.layer = 0; E.slots = 4352; E.nNe = 1;
    switch (job) {
        case J_EVEN_IN: g.A = (const bf16_t*)(ws + WS_H); g.Bt = (const bf16_t*)(ws + WS_W_EIN); S.init(1, M_ALL / 256, 12); E.mode = pg8::EPI_EVEN_IN; break;
        case J_OUT0: g.A = (const bf16_t*)(ws + WS_ATT); g.Bt = (const bf16_t*)(ws + WS_W_EOUT); S.init(1, M_ALL / 256, 4); E.mode = pg8::EPI_OUT; break;
        case J_UP0: g.A = (const bf16_t*)(ws + WS_H); g.Bt = (const bf16_t*)(ws + WS_W13); S.init(16, 17, 8); E.mode = pg8::EPI_MOE_UP; E.nNe = 8; break;
        case J_DOWN0: g.A = (const bf16_t*)(ws + WS_HID); g.Bt = (const bf16_t*)(ws + WS_W2T); S.init(16, 17, 4); E.mode = pg8::EPI_MOE_DOWN; E.nNe = 4; break;
        case J_ODD_IN: g.A = (const bf16_t*)(ws + WS_H); g.Bt = (const bf16_t*)(ws + WS_W_OIN); S.init(1, M_ALL / 256, 8); E.mode = pg8::EPI_ODD_IN; E.layer = 1; break;
        case J_UPQ: g.A = (const bf16_t*)(ws + WS_PROJ); g.Bt = (const bf16_t*)(ws + WS_W_UQ); g.lda = ODD_IN; g.ldb = 256; g.K = 256; S.init(1, M_LAT / 256, 3); E.mode = pg8::EPI_UPQ; E.layer = 1; break;
        case J_UPKV: g.A = (const bf16_t*)(ws + WS_PROJ) + 256; g.Bt = (const bf16_t*)(ws + WS_W_UKV); g.lda = ODD_IN; g.ldb = 128; g.K = 128; S.init(1, M_ALL / 256, 4); E.mode = pg8::EPI_UPKV; E.layer = 1; break;
        case J_OUT1: g.A = (const bf16_t*)(ws + WS_ATT); g.Bt = (const bf16_t*)(ws + WS_W_OOUT); S.init(1, M_LAT / 256, 4);     E.mode = pg8::EPI_OUT; E.layer = 1; break;
        case J_UP1: g.A = (const bf16_t*)(ws + WS_H); g.Bt = (const bf16_t*)(ws + WS_W13); S.init(16, 16, 8); E.mode = pg8::EPI_MOE_UP; E.nNe = 8; E.layer = 1; E.slots = 4096; break;
        default: g.A = (const bf16_t*)(ws + WS_HID); g.Bt = (const bf16_t*)(ws + WS_W2T); S.init(16, 16, 4); E.mode = pg8::EPI_MOE_DOWN; E.nNe = 4; E.layer = 1; E.slots = 4096; break;
    }
}

__global__ void __launch_bounds__(NTHREADS, 2) mega(KArgs P0) {
    extern __shared__ __attribute__((aligned(16))) unsigned char smem_[];
    LAS unsigned char* lds = (LAS unsigned char*)smem_;
    cg::grid_group grid = cg::this_grid();
    volatile LAS unsigned* st = (volatile LAS unsigned*)(lds + LDS_CTL_OFF);
    if (threadIdx.x < 16) st[threadIdx.x] = 0u;
    if ((threadIdx.x & 63) == 0) ((volatile LAS int*)(uintptr_t)WAVE_TAB_LDS)[hw_wave_slot()] = (int)(threadIdx.x >> 6);
    if (threadIdx.x < 64) ((LAS unsigned*)(lds + att::PROF_LDS_OFF))[threadIdx.x] = 0u;
    __syncthreads();
    XcdBarrier xb = xcd_barrier_post((unsigned*)(P0.ws + WS_CTL), st);
    if (threadIdx.x < 25) ((const float**)(P0.ws + WS_PTRS))[threadIdx.x] = P0.in[threadIdx.x];
    grid.sync();
    {
        Params Q; Q.ws = (GAS unsigned char*)P0.ws; Q.out = (GAS float*)P0.out; asm volatile("" : "+s"(Q.ws), "+s"(Q.out)); Q.in = (const gin_t GAS*)(Q.ws + WS_PTRS);
        const int reps0 = (REPEAT_MASK & 1u) ? 2 : 1;
#pragma unroll 1
        for (int rep = 0; rep < reps0; ++rep) { phase_prologue(Q, lds); xcd_barrier(xb); }
    }
    asm volatile(".fill 512, 4, 0xBF800000");
#pragma unroll 1
    for (int step = 1; step < NSTEPS - 1; ++step) {
        int kind, arg; bool sync; step_desc(step, kind, arg, sync);
        Params Q; Q.ws = (GAS unsigned char*)P0.ws; Q.out = (GAS float*)P0.out;
        asm volatile("" : "+s"(Q.ws), "+s"(Q.out));
        Q.in = (const gin_t GAS*)(Q.ws + WS_PTRS);
        const Params& P = Q;
        const int reps = ((REPEAT_MASK >> step) & 1u) ? 2 : 1;
#pragma unroll 1
        for (int rep = 0; rep < reps; ++rep) {
        if (kind == K_GEMM) { pg8::Gemm g; pg8::Sched S; pg8::Epi E; gemm_job(P, arg, g, S, E);
#ifdef GEMM_ABL
            if (rep == 0 && reps == 2) E.mode = 99;
#endif
            pg8::gemm_phase(lds, g, S, P, E); }
        else if (kind == K_NORM1) { phase_norm1(P, arg); if (arg == 1) convert_weights(P, 1, false, (LAS float*)lds, opaque_tid()); }
        else if (kind == K_ATTN_EVEN) {
#ifdef EVEN_PART
            phase_attn_even(P, lds, (rep == 0 && reps == 2) ? EVEN_PART : 3);
#else
            phase_attn_even(P, lds);
#endif
        }
        else if (kind == K_NORM2) phase_norm2(P, arg, lds);
        else if (kind == K_TOPK) { const int ng = arg ? 128 : 256, slots = arg ? 4096 : 4352; for (int gq = blockIdx.x; gq < ng; gq += gridDim.x) topk_item(P, gq, slots, lds); }
        else if (kind == K_R1) { for (int u = blockIdx.x; u < 32 * 34; u += gridDim.x) ret::r1_unit(P, lds, u / 34, u % 34); }
        else if (kind == K_MLA) { if (rep == 0) ret::r2_scan(P);
#if ABL_MASK != 0
            if (rep == 0 && reps == 2) { for (int k = 0; k < 4; ++k) { const int u = xcd_unit(blockIdx.x, k); att::mla_unit<ABL_MASK>(P, lds, u >> 7, (u >> 4) & 7, u & 15); } }
            else
#endif
            { if (gridDim.x == 256) { for (int k = 0; k < 4; ++k) { const int u = xcd_unit(blockIdx.x, k); att::mla_unit(P, lds, u >> 7, (u >> 4) & 7, u & 15); } }
              else for (int u = blockIdx.x; u < 1024; u += gridDim.x) att::mla_unit(P, lds, u >> 7, (u >> 4) & 7, u & 15); } }
        else { for (int u = blockIdx.x; u < 1024; u += gridDim.x) ret::r3_unit(P, lds, u >> 5, u & 31); }
        if (sync || rep + 1 < reps) xcd_barrier(xb);
        }
    }
    {   Params Q; Q.ws = (GAS unsigned char*)P0.ws; Q.out = (GAS float*)P0.out; asm volatile("" : "+s"(Q.ws), "+s"(Q.out)); Q.in = (const gin_t GAS*)(Q.ws + WS_PTRS);
        phase_final(Q); }
#if PROF_SEG >= 0
    {
        const int wid = __builtin_amdgcn_readfirstlane(opaque_tid() >> 6);
        const unsigned want = ((LAS unsigned*)(lds + att::PROF_LDS_OFF))[wid * 8 + (PROF_SEG & 7)] * (PROF_SEG >= 8 ? 0u : 1u);
        const unsigned long long t0 = __builtin_amdgcn_s_memtime();
        while ((unsigned long long)__builtin_amdgcn_s_memtime() - t0 < (unsigned long long)want) __builtin_amdgcn_s_sleep(8);
    }
#endif
}

extern "C" void kernel_launch(void* const* d_in, const int* in_sizes, int n_in, void* d_out, int out_size, void* d_ws, size_t ws_size, hipStream_t stream) {
    static int grid_blocks = 0;
    if (!grid_blocks) {
        int dev = 0, cus = 0, per_cu = 0;
        (void)hipGetDevice(&dev);
        (void)hipDeviceGetAttribute(&cus, hipDeviceAttributeMultiprocessorCount, dev);
        (void)hipFuncSetAttribute((const void*)mega, hipFuncAttributeMaxDynamicSharedMemorySize, LDS_BYTES);
        (void)hipOccupancyMaxActiveBlocksPerMultiprocessor(&per_cu, mega, NTHREADS, LDS_BYTES);
        if (per_cu < 1) { fprintf(stderr, "mega: occupancy query returned %d\n", per_cu); per_cu = 1; }
        grid_blocks = cus;
        if (ws_size < WS_END || n_in != 25) fprintf(stderr, "mega: ws_size %zu < %zu or n_in %d != 25\n", ws_size, (size_t)WS_END, n_in);
    }
    KArgs p{};
    for (int i = 0; i < 25; ++i) p.in[i] = (const float*)d_in[i];
    p.out = (float*)d_out; p.ws = (unsigned char*)d_ws; p.pad = 0;
    (void)hipMemsetAsync(d_ws, 0, 16384, stream);
    void* args[] = {&p};
    hipError_t e = hipLaunchCooperativeKernel((const void*)mega, dim3(grid_blocks), dim3(NTHREADS), args, LDS_BYTES, stream);
    if (e != hipSuccess) fprintf(stderr, "cooperative launch failed: %s (grid %d)\n", hipGetErrorString(e), grid_blocks);
}
```

```cpp
#include <hip/hip_runtime.h>
#include <hip/hip_cooperative_groups.h>
#include <cstdio>
#include <cstdint>
namespace cg = cooperative_groups;

#define LAS __attribute__((address_space(3)))
typedef unsigned short bf16_t;
typedef short bf16x8 __attribute__((ext_vector_type(8)));
typedef short s16x4 __attribute__((ext_vector_type(4)));
typedef float f32x2 __attribute__((ext_vector_type(2)));
typedef float f32x4 __attribute__((ext_vector_type(4)));
typedef float f32x16 __attribute__((ext_vector_type(16)));
typedef unsigned u32x4 __attribute__((ext_vector_type(4)));
typedef unsigned u32x2 __attribute__((ext_vector_type(2)));

constexpr int NTHREADS = 512;
constexpr int LDS_BYTES = 147456;
constexpr int LDS_CTL_OFF = 147456 - 64;

constexpr int NB = 8, SEQ = 4096, LC = 256, DM = 1024;
constexpr int M_LAT = NB * SEQ, M_CTX = NB * LC, M_ALL = M_LAT + M_CTX;
constexpr int EVEN_IN = 3072, ODD_IN = 1952;
constexpr float RMS_EPS = 1e-6f;
constexpr float LOG2E = 1.4426950408889634f;

constexpr size_t MiB = 1u << 20;
constexpr size_t WS_CTL = 0;
constexpr size_t WS_MODS = 1 * MiB;
constexpr size_t WS_ROPE16 = 1 * MiB + 512 * 1024;
constexpr size_t WS_ROPE8 = WS_ROPE16 + 8192;
constexpr size_t WS_MISC = WS_ROPE8 + 4096;
constexpr size_t WS_PTRS = WS_MISC + 4096;
constexpr size_t WS_PARTQ = 2 * MiB;
constexpr size_t WS_PARTKV = 3 * MiB;
constexpr size_t WS_AFF_LAT = 4 * MiB;
constexpr size_t WS_AFF_CTX = 6 * MiB;
constexpr size_t WS_IDX = 7 * MiB;
constexpr size_t WS_GATE = 7 * MiB + 512 * 1024;
constexpr size_t WS_INV = 8 * MiB;
constexpr size_t WS_XC = 11 * MiB;
constexpr size_t WS_W_EIN = 20 * MiB;
constexpr size_t WS_W_EOUT = 26 * MiB;
constexpr size_t WS_W_OIN = 28 * MiB;
constexpr size_t WS_W_OOUT = 32 * MiB;
constexpr size_t WS_W_UQ = 34 * MiB;
constexpr size_t WS_W_UKV = 34 * MiB + 512 * 1024;
constexpr size_t WS_W13 = 36 * MiB;
constexpr size_t WS_W2T = 100 * MiB;
constexpr size_t WS_H = 132 * MiB;
constexpr size_t WS_BIG = 200 * MiB;
constexpr size_t WS_ATT = 404 * MiB;
constexpr size_t WS_RET = 472 * MiB;
constexpr size_t WS_END = 540 * MiB;
constexpr size_t WS_PROJ = WS_BIG;
constexpr size_t WS_KVM = WS_BIG + 130 * MiB;
constexpr size_t WS_KR = WS_BIG + 198 * MiB;
constexpr size_t WS_QM = WS_H;
constexpr size_t WS_XE = WS_BIG;
constexpr size_t WS_HID = WS_BIG + 136 * MiB;
constexpr size_t WS_Y = WS_XE;
constexpr size_t WS_YMIX = WS_BIG;
static_assert((size_t)M_ALL * 1952 * 2 <= 130 * MiB, "PROJ fits");
static_assert(WS_HID + (size_t)16 * 4352 * 1024 * 2 <= WS_RET, "HID fits");

enum { I_X = 0, I_C, I_CTX, I_CCTX, I_ADAW, I_ADAB, I_NMIX, I_NFFN, I_FNORM, I_EWIN, I_EWOUT, I_DLAM, I_SUBLN, I_RPB, I_OWIN, I_OWOUT,
       I_QNORM, I_WUQ, I_KVNORM, I_WUKV, I_DECAY, I_ROUTER, I_W1, I_W3, I_W2 };

struct KArgs {
    const float* in[25];
    float* out;
    unsigned char* ws;
    unsigned long long pad;
};
#if defined(__HIP_DEVICE_COMPILE__)
#define GAS __attribute__((address_space(1)))
#else
#define GAS
#endif
typedef GAS const float* gin_t;
struct Params {
    const gin_t GAS* in;
    GAS float* out;
    GAS unsigned char* ws;
};

constexpr unsigned WAVE_TAB_LDS = 143872;
__device__ __forceinline__ unsigned hw_wave_slot() { return (unsigned)__builtin_amdgcn_s_getreg((5 << 11) | 4) & 63u; }
__device__ __forceinline__ int opaque_tid() {
    const int lane = (int)__builtin_amdgcn_mbcnt_hi(~0u, __builtin_amdgcn_mbcnt_lo(~0u, 0u));
    int w = ((volatile LAS int*)(uintptr_t)WAVE_TAB_LDS)[hw_wave_slot()];
    w = __builtin_amdgcn_readfirstlane(w);
    int t = (w << 6) | lane; asm volatile("" : "+v"(t)); return t;
}
__device__ __forceinline__ void dma16_asm(const void* gptr, LAS void* ldsp) {
    const unsigned a = __builtin_amdgcn_readfirstlane((unsigned)(uintptr_t)ldsp); unsigned keep;
    asm volatile("s_mov_b32 %0, m0\n\ts_mov_b32 m0, %1\n\ts_nop 0\n\tglobal_load_lds_dwordx4 %2, off\n\ts_mov_b32 m0, %0" : "=&s"(keep) : "s"(a), "v"(gptr) : "memory");
}
__device__ __forceinline__ unsigned f2bf(float f) { unsigned u = __builtin_bit_cast(unsigned, f); return (u + 0x7fffu + ((u >> 16) & 1u)) >> 16; }
__device__ __forceinline__ unsigned pk2(float lo, float hi) { return f2bf(lo) | (f2bf(hi) << 16); }
__device__ __forceinline__ unsigned cvtpk(float lo, float hi) { unsigned r; asm volatile("v_cvt_pk_bf16_f32 %0, %1, %2" : "=v"(r) : "v"(lo), "v"(hi)); return r; }
__device__ __forceinline__ float bf_lo(unsigned w) { return __uint_as_float(w << 16); }
__device__ __forceinline__ float bf_hi(unsigned w) { return __uint_as_float(w & 0xffff0000u); }
__device__ __forceinline__ float bf2f(bf16_t x) { return __uint_as_float(((unsigned)x) << 16); }
template <int M> __device__ __forceinline__ float xshfl(float v) {
    if constexpr (M == 32) { auto rr = __builtin_amdgcn_permlane32_swap(__float_as_uint(v), __float_as_uint(v), false, false); const int lane = (int)__builtin_amdgcn_mbcnt_hi(~0u, __builtin_amdgcn_mbcnt_lo(~0u, 0u)); return __uint_as_float(lane < 32 ? rr[1] : rr[0]); }
    else return __int_as_float(__builtin_amdgcn_ds_swizzle(__float_as_int(v), (M << 10) | 0x1F));
}
__device__ __forceinline__ float wave_sum(float v) {
    v += xshfl<1>(v); v += xshfl<2>(v); v += xshfl<4>(v); v += xshfl<8>(v); v += xshfl<16>(v);
    { auto rr = __builtin_amdgcn_permlane32_swap(__float_as_uint(v), __float_as_uint(v), false, false); v = __uint_as_float(rr[0]) + __uint_as_float(rr[1]); }
    return v;
}
__device__ __forceinline__ float silu_f(float v) { return v / (1.0f + __expf(-v)); }
__device__ __forceinline__ int crow(int r, int hi) { return (r & 3) + 8 * (r >> 2) + 4 * hi; }
__device__ __forceinline__ int sigma32(int p) { return (p < 8 || p >= 24) ? p : (p < 16 ? p + 8 : p - 8); }

#define XB_TMO      128
#define XB_XCNT(j)  (256  + 64 * (j))
#define XB_XSUB(j)  (1280 + 64 * (j))
#define XB_XGEN(j)  (2304 + 64 * (j))
#define XB_TOP      3328
#define XB_TOPGEN   3392
#define XCD_BAR_WORDS 3456
#define XB_SPIN_CAP (1u << 21)
__device__ __forceinline__ unsigned xb_ld(unsigned* p)              { return __hip_atomic_load(p, __ATOMIC_RELAXED, __HIP_MEMORY_SCOPE_AGENT); }
__device__ __forceinline__ unsigned xb_add(unsigned* p, unsigned v) { return __hip_atomic_fetch_add(p, v, __ATOMIC_RELAXED, __HIP_MEMORY_SCOPE_AGENT); }
__device__ __forceinline__ unsigned xb_xcc_id() { return (unsigned)__builtin_amdgcn_s_getreg((3 << 11) | 20) & 0xFu; }
#define XB_SPIN(cond, bar) do { unsigned _sp = 0; while (cond) { __builtin_amdgcn_s_sleep(1); \
    if ((++_sp & 255u) == 0u) { if (xb_ld(&(bar)[XB_TMO])) break; if (_sp > XB_SPIN_CAP) { atomicAdd(&(bar)[XB_TMO], 1u); break; } } } } while (0)
struct XcdBarrier { unsigned* bar; unsigned x; volatile LAS unsigned* st; };
__device__ __forceinline__ XcdBarrier xcd_barrier_post(unsigned* bar, volatile LAS unsigned* st) {
    XcdBarrier b; b.bar = bar; b.x = xb_xcc_id(); b.st = st;
    if (threadIdx.x == 0) (void)xb_add(&bar[XB_XCNT(b.x)], 1u);
    return b;
}
__device__ __forceinline__ void xcd_barrier_complete(unsigned* bar, unsigned x, unsigned& nloc, unsigned& nx) {
    const unsigned G = gridDim.x * gridDim.y * gridDim.z;
    unsigned sum, cnt, mine, sp = 0u;
    for (;;) {
        sum = 0u; cnt = 0u; mine = 0u;
#pragma unroll
        for (unsigned j = 0; j < 16; ++j) { const unsigned c = xb_ld(&bar[XB_XCNT(j)]); sum += c; cnt += (c > 0u) ? 1u : 0u; mine = (j == x) ? c : mine; }
        if (sum == G) break;
        __builtin_amdgcn_s_sleep(1);
        if ((++sp & 255u) == 0u) { if (xb_ld(&bar[XB_TMO])) break; if (sp > XB_SPIN_CAP) { atomicAdd(&bar[XB_TMO], 1u); break; } }
    }
    nloc = mine > 0u ? mine : 1u; nx = cnt > 0u ? cnt : 1u;
}
__device__ __forceinline__ void xcd_barrier(const XcdBarrier& b) {
    asm volatile("s_waitcnt vmcnt(0)" ::: "memory");
    __syncthreads();
    if (opaque_tid() == 0) {
        unsigned* bar = b.bar;
        __builtin_amdgcn_s_waitcnt(0);
        unsigned nloc = b.st[0], nx = b.st[1];
        if (nloc == 0u) { xcd_barrier_complete(bar, b.x, nloc, nx); b.st[0] = nloc; b.st[1] = nx; }
        const unsigned old = xb_add(&bar[XB_XSUB(b.x)], 1u);
        const unsigned gen = old / nloc;
        if (old + 1u == (gen + 1u) * nloc) {
            __builtin_amdgcn_fence(__ATOMIC_RELEASE, "agent");
            asm volatile("s_waitcnt vmcnt(0)" ::: "memory");
            const unsigned og = xb_add(&bar[XB_TOP], 1u);
            const unsigned tg = og / nx;
            if (og + 1u == (tg + 1u) * nx) xb_add(&bar[XB_TOPGEN], 1u);
            else XB_SPIN(xb_ld(&bar[XB_TOPGEN]) == tg, bar);
            __builtin_amdgcn_fence(__ATOMIC_ACQUIRE, "agent");
            xb_add(&bar[XB_XGEN(b.x)], 1u);
            asm volatile("s_waitcnt vmcnt(0)" ::: "memory");
        } else {
            XB_SPIN(xb_ld(&bar[XB_XGEN(b.x)]) == gen, bar);
            __builtin_amdgcn_fence(__ATOMIC_ACQUIRE, "agent");
            asm volatile("s_waitcnt vmcnt(0)" ::: "memory");
        }
    }
    __syncthreads();
}

__device__ __forceinline__ int pos16(int q) { const int n = q >> 4, r = q & 15; return 8 * (r >> 2) + 4 * n + (r & 3); }
__device__ __forceinline__ int pos8(int q) { const int blk = q >> 3, r = q & 7, n = blk & 1, fq = 2 * (blk >> 1) + (r >> 2); return 8 * fq + 4 * n + (r & 3); }
__device__ __forceinline__ int maprow(int n, int mode) {
    if (mode == 1) return (n >> 7) * 256 + (n & 127);
    if (mode == 2) return (n >> 7) * 256 + 128 + (n & 127);
    if (mode == 3) return (n >= 384 && n < 416) ? 384 + pos8(n - 384) : n;
    if (mode == 4) { const int h = n / 96, j = n - h * 96; return (j >= 64) ? h * 96 + 64 + pos8(j - 64) : n; }
    if (mode == 5) return (n < 1024) ? (n & ~31) + pos16(n & 31) : n;
    return n;
}
struct TDesc { const float* src; bf16_t* dst; const float* kscale; int ldsrc, Nvalid, k0, n0, lddst, mode; };
constexpr int TT_TILE_F = 64 * 65;
__device__ __forceinline__ void tt_load(const TDesc (&d)[4], int nvalid, f32x4 (&v)[4][2], int tid) {
#pragma unroll
    for (int t = 0; t < 4; ++t)
#pragma unroll
        for (int i = 0; i < 2; ++i) {
            const int k = (tid >> 4) + 32 * i, n4 = (tid & 15) * 4;
            v[t][i] = (f32x4){0.f, 0.f, 0.f, 0.f};
            if (t < nvalid && d[t].n0 + n4 < d[t].Nvalid) v[t][i] = __builtin_nontemporal_load((const f32x4*)(d[t].src + (size_t)(d[t].k0 + k) * d[t].ldsrc + d[t].n0 + n4));
        }
}
__device__ __forceinline__ void tt_finish(const TDesc (&d)[4], int nvalid, const f32x4 (&v)[4][2], LAS float* tiles, int tid) {
#pragma unroll
    for (int t = 0; t < 4; ++t)
#pragma unroll
        for (int i = 0; i < 2; ++i) {
            const int k = (tid >> 4) + 32 * i, n4 = (tid & 15) * 4;
            f32x4 x = v[t][i];
            if (t < nvalid && d[t].kscale) { const float sc = d[t].kscale[d[t].k0 + k]; x = x * sc; }
            LAS float* tp = tiles + t * TT_TILE_F + k * 65 + n4;
            tp[0] = x[0]; tp[1] = x[1]; tp[2] = x[2]; tp[3] = x[3];
        }
    __syncthreads();
#pragma unroll
    for (int t = 0; t < 4; ++t) {
        const int n = tid >> 3, kc = (tid & 7) * 8;
        if (t < nvalid && d[t].n0 + n < d[t].Nvalid) {
            const LAS float* tp = tiles + t * TT_TILE_F + kc * 65 + n;
            u32x4 w;
            w.x = pk2(tp[0 * 65], tp[1 * 65]); w.y = pk2(tp[2 * 65], tp[3 * 65]); w.z = pk2(tp[4 * 65], tp[5 * 65]); w.w = pk2(tp[6 * 65], tp[7 * 65]);
            __builtin_nontemporal_store(w, (u32x4*)(d[t].dst + (size_t)maprow(d[t].n0 + n, d[t].mode) * d[t].lddst + d[t].k0 + kc));
        }
    }
    __syncthreads();
}
constexpr int SMALL_TILES = 768 + 256 + 496 + 256 + 48 + 32;
__device__ __forceinline__ TDesc small_desc(const Params& P, int idx) {
    unsigned char* ws = P.ws; TDesc d; d.kscale = nullptr; d.mode = 0; d.lddst = 1024;
    if (idx < 768) { d.src = P.in[I_EWIN]; d.ldsrc = 3072; d.Nvalid = 3072; d.k0 = (idx / 48) * 64; d.n0 = (idx % 48) * 64; d.dst = (bf16_t*)(ws + WS_W_EIN); d.mode = 5; return d; } idx -= 768;
    if (idx < 256) { d.src = P.in[I_EWOUT]; d.ldsrc = 1024; d.Nvalid = 1024; d.k0 = (idx / 16) * 64; d.n0 = (idx % 16) * 64; d.dst = (bf16_t*)(ws + WS_W_EOUT); return d; } idx -= 256;
    if (idx < 496) { d.src = P.in[I_OWIN]; d.ldsrc = 1952; d.Nvalid = 1952; d.k0 = (idx / 31) * 64; d.n0 = (idx % 31) * 64; d.dst = (bf16_t*)(ws + WS_W_OIN); d.mode = 3; return d; } idx -= 496;
    if (idx < 256) { d.src = P.in[I_OWOUT]; d.ldsrc = 1024; d.Nvalid = 1024; d.k0 = (idx / 16) * 64; d.n0 = (idx % 16) * 64; d.dst = (bf16_t*)(ws + WS_W_OOUT); return d; } idx -= 256;
    if (idx < 48) { d.src = P.in[I_WUQ]; d.ldsrc = 768; d.Nvalid = 768; d.k0 = (idx / 12) * 64; d.n0 = (idx % 12) * 64; d.dst = (bf16_t*)(ws + WS_W_UQ); d.lddst = 256; d.mode = 4; d.kscale = P.in[I_QNORM]; return d; } idx -= 48;
    d.src = P.in[I_WUKV]; d.ldsrc = 1024; d.Nvalid = 1024; d.k0 = (idx / 16) * 64; d.n0 = (idx % 16) * 64; d.dst = (bf16_t*)(ws + WS_W_UKV); d.lddst = 128; d.kscale = P.in[I_KVNORM]; return d;
}
constexpr int MOE_TILES = 16 * 3 * 256;
__device__ __forceinline__ TDesc moe_desc(const float* w1p, const float* w3p, const float* w2p, unsigned char* ws, int layer, int idx) {
    const int e = idx / 768, r = idx - e * 768, which = r >> 8, t = r & 255;
    const size_t moff = ((size_t)layer * 16 + e) * 1024 * 1024;
    TDesc d; d.kscale = nullptr; d.ldsrc = 1024; d.Nvalid = 1024; d.k0 = (t >> 4) * 64; d.n0 = (t & 15) * 64; d.lddst = 1024;
    if (which == 0) { d.src = w1p + moff; d.dst = (bf16_t*)(ws + WS_W13) + (size_t)e * 2048 * 1024; d.mode = 1; }
    else if (which == 1) { d.src = w3p + moff; d.dst = (bf16_t*)(ws + WS_W13) + (size_t)e * 2048 * 1024; d.mode = 2; }
    else { d.src = w2p + moff; d.dst = (bf16_t*)(ws + WS_W2T) + (size_t)e * 1024 * 1024; d.mode = 0; }
    return d;
}
__device__ __forceinline__ void convert_weights(const Params& P, int layer, bool with_small, LAS float* tiles, int tid) {
    const int nsmall = with_small ? SMALL_TILES : 0, total = nsmall + MOE_TILES;
    const float* w1p = P.in[I_W1]; const float* w3p = P.in[I_W3]; const float* w2p = P.in[I_W2]; unsigned char* wsp = P.ws;
#define CW_DESCS(D, NV, BASE) do { NV = 0; _Pragma("unroll") for (int t = 0; t < 4; ++t) { const int idx_ = (BASE) + t; \
        if (idx_ < total) { D[t] = (idx_ < nsmall) ? small_desc(P, idx_) : moe_desc(w1p, w3p, w2p, wsp, layer, idx_ - nsmall); NV = t + 1; } else D[t] = D[0]; } } while (0)
#define CW_LOAD(V, BASE) do { if ((BASE) < total) { TDesc d_[4]; int nv_; CW_DESCS(d_, nv_, BASE); tt_load(d_, nv_, V, tid); } } while (0)
    const int stride = gridDim.x * 4;
    int b0 = blockIdx.x * 4;
    if (b0 >= total) return;
    f32x4 v0[4][2], v1[4][2], v2[4][2];
    CW_LOAD(v0, b0); CW_LOAD(v1, b0 + stride);
    for (;;) {
        CW_LOAD(v2, b0 + 2 * stride);
        { TDesc d_[4]; int nv_; CW_DESCS(d_, nv_, b0); tt_finish(d_, nv_, v0, tiles, tid); }
        b0 += stride;
        if (b0 >= total) break;
#pragma unroll
        for (int t = 0; t < 4; ++t) { v0[t][0] = v1[t][0]; v0[t][1] = v1[t][1]; v1[t][0] = v2[t][0]; v1[t][1] = v2[t][1]; }
    }
#undef CW_LOAD
#undef CW_DESCS
}
__device__ __forceinline__ void mods_item(const Params& P, int item, LAS float* S, LAS float* red, int tid) {
    const int l = item / 96, n0 = (item % 96) * 64;
    for (int i = tid; i < 9 * 1024; i += NTHREADS) { const int r = i >> 10, k = i & 1023; const float v = (r < 8) ? P.in[I_C][r * 1024 + k] : P.in[I_CCTX][k]; S[i] = v / (1.0f + __expf(-v)); }
    __syncthreads();
    const int kq = tid >> 4, c4 = (tid & 15) * 4;
    f32x4 acc[9];
#pragma unroll
    for (int r = 0; r < 9; ++r) acc[r] = (f32x4){0.f, 0.f, 0.f, 0.f};
    const float* w = P.in[I_ADAW] + (size_t)l * 1024 * 6144 + n0 + c4;
#pragma unroll 8
    for (int k = kq; k < 1024; k += 32) { const f32x4 wv = __builtin_nontemporal_load((const f32x4*)(w + (size_t)k * 6144));
#pragma unroll
        for (int r = 0; r < 9; ++r) acc[r] += S[r * 1024 + k] * wv; }
#pragma unroll
    for (int r = 0; r < 9; ++r) *(LAS f32x4*)(red + (kq * 9 + r) * 64 + c4) = acc[r];
    __syncthreads();
    float* mods = (float*)(P.ws + WS_MODS);
    for (int i = tid; i < 9 * 64; i += NTHREADS) { const int r = i >> 6, c = i & 63; float s = 0.f;
#pragma unroll
        for (int q = 0; q < 32; ++q) s += red[(q * 9 + r) * 64 + c];
        mods[(size_t)(l * 9 + r) * 6144 + n0 + c] = s + P.in[I_ADAB][l * 6144 + n0 + c]; }
    __syncthreads();
}
__device__ __forceinline__ void tables_item(const Params& P, int tid) {
    float* r16 = (float*)(P.ws + WS_ROPE16); float* r8 = (float*)(P.ws + WS_ROPE8); float* misc = (float*)(P.ws + WS_MISC);
    for (int i = tid; i < 64 * 16; i += NTHREADS) { const int pos = i >> 4, f = i & 15; const float fr = exp2f(-(float)f * (13.287712379549449f / 16.0f)); const float ang = (float)pos * fr;
        r16[2 * i] = cosf(ang); r16[2 * i + 1] = sinf(ang); }
    for (int i = tid; i < 64 * 8; i += NTHREADS) { const int pos = i >> 3, f = i & 7; const float fr = exp2f(-(float)f * (13.287712379549449f / 8.0f)); const float ang = (float)pos * fr;
        r8[2 * i] = cosf(ang); r8[2 * i + 1] = sinf(ang); }
    if (tid == 0) { const float* dl = P.in[I_DLAM]; float s1 = 0.f, s2 = 0.f;
        for (int i = 0; i < 64; ++i) { s1 += dl[i] * dl[64 + i]; s2 += dl[128 + i] * dl[192 + i]; }
        misc[0] = expf(s1) - expf(s2) + 0.2f; }
    if (tid >= 64 && tid < 72) { const float x = P.in[I_DECAY][tid - 64]; const float lg = -log1pf(expf(-x)); misc[8 + tid - 64] = lg * 1.4426950408889634f; }
}

struct Row16 { float v[16]; };
__device__ __forceinline__ Row16 ld_row_f32(const float* p, int lane) {
    Row16 r; const f32x4 a = *(const f32x4*)(p + lane * 8), b = *(const f32x4*)(p + lane * 8 + 4), c = *(const f32x4*)(p + 512 + lane * 8), d = *(const f32x4*)(p + 512 + lane * 8 + 4);
#pragma unroll
    for (int j = 0; j < 4; ++j) { r.v[j] = a[j]; r.v[4 + j] = b[j]; r.v[8 + j] = c[j]; r.v[12 + j] = d[j]; }
    return r;
}
__device__ __forceinline__ Row16 ld_row_f32_nt(const float* p, int lane) {
    Row16 r; const f32x4 a = __builtin_nontemporal_load((const f32x4*)(p + lane * 8)), b = __builtin_nontemporal_load((const f32x4*)(p + lane * 8 + 4)),
                         c = __builtin_nontemporal_load((const f32x4*)(p + 512 + lane * 8)), d = __builtin_nontemporal_load((const f32x4*)(p + 512 + lane * 8 + 4));
#pragma unroll
    for (int j = 0; j < 4; ++j) { r.v[j] = a[j]; r.v[4 + j] = b[j]; r.v[8 + j] = c[j]; r.v[12 + j] = d[j]; }
    return r;
}
__device__ __forceinline__ void st_row_f32_nt(float* p, int lane, const Row16& r) {
    __builtin_nontemporal_store((f32x4){r.v[0], r.v[1], r.v[2], r.v[3]}, (f32x4*)(p + lane * 8)); __builtin_nontemporal_store((f32x4){r.v[4], r.v[5], r.v[6], r.v[7]}, (f32x4*)(p + lane * 8 + 4));
    __builtin_nontemporal_store((f32x4){r.v[8], r.v[9], r.v[10], r.v[11]}, (f32x4*)(p + 512 + lane * 8)); __builtin_nontemporal_store((f32x4){r.v[12], r.v[13], r.v[14], r.v[15]}, (f32x4*)(p + 512 + lane * 8 + 4));
}
__device__ __forceinline__ void st_row_f32(float* p, int lane, const Row16& r) {
    *(f32x4*)(p + lane * 8) = (f32x4){r.v[0], r.v[1], r.v[2], r.v[3]}; *(f32x4*)(p + lane * 8 + 4) = (f32x4){r.v[4], r.v[5], r.v[6], r.v[7]};
    *(f32x4*)(p + 512 + lane * 8) = (f32x4){r.v[8], r.v[9], r.v[10], r.v[11]}; *(f32x4*)(p + 512 + lane * 8 + 4) = (f32x4){r.v[12], r.v[13], r.v[14], r.v[15]};
}
__device__ __forceinline__ void st_row_bf16(bf16_t* p, int lane, const Row16& r) {
    u32x4 a, b; a.x = pk2(r.v[0], r.v[1]); a.y = pk2(r.v[2], r.v[3]); a.z = pk2(r.v[4], r.v[5]); a.w = pk2(r.v[6], r.v[7]);
    b.x = pk2(r.v[8], r.v[9]); b.y = pk2(r.v[10], r.v[11]); b.z = pk2(r.v[12], r.v[13]); b.w = pk2(r.v[14], r.v[15]);
    *(u32x4*)(p + lane * 8) = a; *(u32x4*)(p + 512 + lane * 8) = b;
}
__device__ __forceinline__ Row16 ld_row_bf16(const bf16_t* p, int lane) {
    const u32x4 a = *(const u32x4*)(p + lane * 8), b = *(const u32x4*)(p + 512 + lane * 8); Row16 r;
    r.v[0] = bf_lo(a.x); r.v[1] = bf_hi(a.x); r.v[2] = bf_lo(a.y); r.v[3] = bf_hi(a.y); r.v[4] = bf_lo(a.z); r.v[5] = bf_hi(a.z); r.v[6] = bf_lo(a.w); r.v[7] = bf_hi(a.w);
    r.v[8] = bf_lo(b.x); r.v[9] = bf_hi(b.x); r.v[10] = bf_lo(b.y); r.v[11] = bf_hi(b.y); r.v[12] = bf_lo(b.z); r.v[13] = bf_hi(b.z); r.v[14] = bf_lo(b.w); r.v[15] = bf_hi(b.w);
    return r;
}
__device__ __forceinline__ bf16_t* xres_row(const Params& P, int row) {
    return (row < M_LAT) ? (bf16_t*)P.out + (size_t)row * 2048 + 1024 : (bf16_t*)(P.ws + WS_XC) + (size_t)(row - M_LAT) * 1024;
}
__device__ __forceinline__ Row16 ld_row_bf16_nt(const bf16_t* p, int lane) {
    const u32x4 a = __builtin_nontemporal_load((const u32x4*)(p + lane * 8)), b = __builtin_nontemporal_load((const u32x4*)(p + 512 + lane * 8)); Row16 r;
    r.v[0] = bf_lo(a.x); r.v[1] = bf_hi(a.x); r.v[2] = bf_lo(a.y); r.v[3] = bf_hi(a.y); r.v[4] = bf_lo(a.z); r.v[5] = bf_hi(a.z); r.v[6] = bf_lo(a.w); r.v[7] = bf_hi(a.w);
    r.v[8] = bf_lo(b.x); r.v[9] = bf_hi(b.x); r.v[10] = bf_lo(b.y); r.v[11] = bf_hi(b.y); r.v[12] = bf_lo(b.z); r.v[13] = bf_hi(b.z); r.v[14] = bf_lo(b.w); r.v[15] = bf_hi(b.w);
    return r;
}
__device__ __forceinline__ void st_row_bf16_nt(bf16_t* p, int lane, const Row16& r) {
    u32x4 a, b; a.x = pk2(r.v[0], r.v[1]); a.y = pk2(r.v[2], r.v[3]); a.z = pk2(r.v[4], r.v[5]); a.w = pk2(r.v[6], r.v[7]);
    b.x = pk2(r.v[8], r.v[9]); b.y = pk2(r.v[10], r.v[11]); b.z = pk2(r.v[12], r.v[13]); b.w = pk2(r.v[14], r.v[15]);
    __builtin_nontemporal_store(a, (u32x4*)(p + lane * 8)); __builtin_nontemporal_store(b, (u32x4*)(p + 512 + lane * 8));
}
__device__ __forceinline__ void add_row_bf16(Row16& r, const bf16_t* p, int lane, float s) {
    const u32x4 a = *(const u32x4*)(p + lane * 8), b = *(const u32x4*)(p + 512 + lane * 8);
    r.v[0] += s * bf_lo(a.x); r.v[1] += s * bf_hi(a.x); r.v[2] += s * bf_lo(a.y); r.v[3] += s * bf_hi(a.y);
    r.v[4] += s * bf_lo(a.z); r.v[5] += s * bf_hi(a.z); r.v[6] += s * bf_lo(a.w); r.v[7] += s * bf_hi(a.w);
    r.v[8] += s * bf_lo(b.x); r.v[9] += s * bf_hi(b.x); r.v[10] += s * bf_lo(b.y); r.v[11] += s * bf_hi(b.y);
    r.v[12] += s * bf_lo(b.z); r.v[13] += s * bf_hi(b.z); r.v[14] += s * bf_lo(b.w); r.v[15] += s * bf_hi(b.w);
}
__device__ __forceinline__ float row_rstd(const Row16& r) {
    float ss = 0.f;
#pragma unroll
    for (int j = 0; j < 16; ++j) ss += r.v[j] * r.v[j];
    ss = wave_sum(ss);
    return rsqrtf(ss * (1.0f / 1024.0f) + RMS_EPS);
}
__device__ __forceinline__ Row16 moe_combine(const Params& P, int row, int slots_per_e, int lane) {
    Row16 c;
#pragma unroll
    for (int j = 0; j < 16; ++j) c.v[j] = 0.f;
    const int* inv = (const int*)(P.ws + WS_INV) + (size_t)row * 16;
    const int mine = (lane < 16) ? inv[lane] : -1;
    const float gmine = (mine >= 0) ? ((const float*)(P.ws + WS_GATE))[lane * slots_per_e + mine] : 0.f;
    const bf16_t* Y = (const bf16_t*)(P.ws + WS_Y);
    unsigned mask = (unsigned)__ballot(mine >= 0) & 0xffffu;
    while (mask) {
        const int e0 = __builtin_ctz(mask); mask &= mask - 1;
        const int e1 = mask ? __builtin_ctz(mask) : -1; if (e1 >= 0) mask &= mask - 1;
        const int s0 = __builtin_amdgcn_readlane(mine, e0); const float g0 = __builtin_bit_cast(float, __builtin_amdgcn_readlane(__builtin_bit_cast(int, gmine), e0));
        float g1 = 0.f;
        const bf16_t* p0 = Y + ((size_t)e0 * slots_per_e + s0) * 1024;
        const u32x4 a0 = __builtin_nontemporal_load((const u32x4*)(p0 + lane * 8)), b0 = __builtin_nontemporal_load((const u32x4*)(p0 + 512 + lane * 8));
        u32x4 a1 = {0u, 0u, 0u, 0u}, b1 = {0u, 0u, 0u, 0u};
        if (e1 >= 0) { const int s1 = __builtin_amdgcn_readlane(mine, e1); g1 = __builtin_bit_cast(float, __builtin_amdgcn_readlane(__builtin_bit_cast(int, gmine), e1)); const bf16_t* p1 = Y + ((size_t)e1 * slots_per_e + s1) * 1024; a1 = __builtin_nontemporal_load((const u32x4*)(p1 + lane * 8)); b1 = __builtin_nontemporal_load((const u32x4*)(p1 + 512 + lane * 8)); }
        const unsigned wa[8] = {a0.x, a0.y, a0.z, a0.w, b0.x, b0.y, b0.z, b0.w}, wb[8] = {a1.x, a1.y, a1.z, a1.w, b1.x, b1.y, b1.z, b1.w};
#pragma unroll
        for (int q = 0; q < 8; ++q) { c.v[2 * q] += g0 * bf_lo(wa[q]); c.v[2 * q + 1] += g0 * bf_hi(wa[q]); }
#pragma unroll
        for (int q = 0; q < 8; ++q) { c.v[2 * q] += g1 * bf_lo(wb[q]); c.v[2 * q + 1] += g1 * bf_hi(wb[q]); }
    }
    return c;
}
__device__ __forceinline__ void phase_norm1(const Params& P, int layer) {
    const int tid = opaque_tid(), wid = tid >> 6, lane = tid & 63;
    const int gw = blockIdx.x * 8 + wid, nw = gridDim.x * 8;
    const float* mods = (const float*)(P.ws + WS_MODS);
    bf16_t* H = (bf16_t*)(P.ws + WS_H);
    const Row16 gain = ld_row_f32(P.in[I_NMIX] + layer * 1024, lane);
    for (int row = gw; row < M_ALL; row += nw) {
        const bool lat = row < M_LAT; const int r9 = lat ? (row >> 12) : 8;
        Row16 x;
        if (layer == 0) x = ld_row_f32_nt(lat ? P.in[I_X] + (size_t)row * 1024 : P.in[I_CTX] + (size_t)(row - M_LAT) * 1024, lane);
        else {
            bf16_t* xp = xres_row(P, row);
            x = ld_row_bf16_nt(xp, lane);
            const Row16 cmb = moe_combine(P, row, 4352, lane);
            const Row16 g2 = ld_row_f32(mods + (size_t)(0 * 9 + r9) * 6144 + 5120, lane);
#pragma unroll
            for (int j = 0; j < 16; ++j) x.v[j] += g2.v[j] * cmb.v[j];
            st_row_bf16_nt(xp, lane, x);
        }
        const float rs = row_rstd(x);
        const Row16 sh = ld_row_f32(mods + (size_t)(layer * 9 + r9) * 6144 + 0, lane), sc = ld_row_f32(mods + (size_t)(layer * 9 + r9) * 6144 + 1024, lane);
        Row16 h;
#pragma unroll
        for (int j = 0; j < 16; ++j) h.v[j] = x.v[j] * rs * gain.v[j] * (1.0f + sc.v[j]) + sh.v[j];
        st_row_bf16(H + (size_t)row * 1024, lane, h);
    }
}
__device__ __forceinline__ void phase_final(const Params& P) {
    const int tid = opaque_tid(), wid = tid >> 6, lane = tid & 63;
    const int gw = blockIdx.x * 8 + wid, nw = gridDim.x * 8;
    const float* mods = (const float*)(P.ws + WS_MODS);
    const Row16 gain = ld_row_f32(P.in[I_FNORM], lane);
    for (int row = gw; row < M_LAT; row += nw) {
        float* xp = P.out + (size_t)row * 1024;
        Row16 x = ld_row_bf16_nt(xres_row(P, row), lane);
        const Row16 cmb = moe_combine(P, row, 4096, lane);
        const Row16 g2 = ld_row_f32(mods + (size_t)(1 * 9 + (row >> 12)) * 6144 + 5120, lane);
#pragma unroll
        for (int j = 0; j < 16; ++j) x.v[j] += g2.v[j] * cmb.v[j];
        const float rs = row_rstd(x);
#pragma unroll
        for (int j = 0; j < 16; ++j) x.v[j] = x.v[j] * rs * gain.v[j];
        st_row_f32_nt(xp, lane, x);
    }
}
constexpr int N2_RS = 2064;
constexpr int N2_WT_HI = 0, N2_WT_LO = 16 * N2_RS, N2_HS_HI = 32 * N2_RS, N2_HS_LO = 48 * N2_RS, N2_PART = 64 * N2_RS;
static_assert(N2_PART + 8192 <= 143360, "N2 LDS plan");
__device__ __forceinline__ void n2_split8(const float (&v)[8], u32x4& hi, u32x4& lo) {
    hi.x = cvtpk(v[0], v[1]); hi.y = cvtpk(v[2], v[3]); hi.z = cvtpk(v[4], v[5]); hi.w = cvtpk(v[6], v[7]);
    lo.x = cvtpk(v[0] - bf_lo(hi.x), v[1] - bf_hi(hi.x)); lo.y = cvtpk(v[2] - bf_lo(hi.y), v[3] - bf_hi(hi.y));
    lo.z = cvtpk(v[4] - bf_lo(hi.z), v[5] - bf_hi(hi.z)); lo.w = cvtpk(v[6] - bf_lo(hi.w), v[7] - bf_hi(hi.w));
}
__device__ __forceinline__ void phase_norm2(const Params& P, int layer, LAS unsigned char* lds) {
    const int tid = opaque_tid(), wid = tid >> 6, lane = tid & 63;
    const int nw = gridDim.x * 8;
    {
        const float* wsrc = P.in[I_ROUTER] + (size_t)layer * 1024 * 16;
        for (int i = tid; i < 1024 * 16; i += NTHREADS) { const int k = i >> 4, e = i & 15; const float v = wsrc[i];
            const unsigned hi = f2bf(v), lo = f2bf(v - __uint_as_float(hi << 16));
            *(LAS bf16_t*)(lds + N2_WT_HI + e * N2_RS + k * 2) = (bf16_t)hi; *(LAS bf16_t*)(lds + N2_WT_LO + e * N2_RS + k * 2) = (bf16_t)lo; }
    }
    __syncthreads();
    const float* mods = (const float*)(P.ws + WS_MODS);
    bf16_t* H = (bf16_t*)(P.ws + WS_H);
    const Row16 gain = ld_row_f32(P.in[I_NFFN] + layer * 1024, lane);
    const int nrows = (layer == 0) ? M_ALL : M_LAT;
#define N2_ROW(ROW, SLOT) do { const int row_ = (ROW); \
        const bool lat = row_ < M_LAT; const int r9 = lat ? (row_ >> 12) : 8; \
        bf16_t* xo = xres_row(P, row_); \
        Row16 x; \
        if (layer == 0) x = ld_row_f32_nt(lat ? P.in[I_X] + (size_t)row_ * 1024 : P.in[I_CTX] + (size_t)(row_ - M_LAT) * 1024, lane); else x = ld_row_bf16_nt(xo, lane); \
        { const Row16 g1 = ld_row_f32(mods + (size_t)(layer * 9 + r9) * 6144 + 2048, lane); \
          Row16 y; _Pragma("unroll") for (int j = 0; j < 16; ++j) y.v[j] = 0.f; \
          y = ld_row_bf16_nt((const bf16_t*)(P.ws + WS_YMIX) + (size_t)row_ * 1024, lane); \
          _Pragma("unroll") for (int j = 0; j < 16; ++j) x.v[j] += g1.v[j] * y.v[j]; } \
        st_row_bf16_nt(xo, lane, x);        \
        const float rs = row_rstd(x); \
        const Row16 sh = ld_row_f32(mods + (size_t)(layer * 9 + r9) * 6144 + 3072, lane), sc = ld_row_f32(mods + (size_t)(layer * 9 + r9) * 6144 + 4096, lane); \
        Row16 h; \
        _Pragma("unroll") for (int j = 0; j < 16; ++j) h.v[j] = x.v[j] * rs * gain.v[j] * (1.0f + sc.v[j]) + sh.v[j]; \
        st_row_bf16(H + (size_t)row_ * 1024, lane, h); \
        { const float va_[8] = {h.v[0], h.v[1], h.v[2], h.v[3], h.v[4], h.v[5], h.v[6], h.v[7]}, vb_[8] = {h.v[8], h.v[9], h.v[10], h.v[11], h.v[12], h.v[13], h.v[14], h.v[15]}; \
          u32x4 ha_, la_, hb_, lb_; n2_split8(va_, ha_, la_); n2_split8(vb_, hb_, lb_); \
          LAS unsigned char* hp_ = lds + N2_HS_HI + (SLOT) * N2_RS + lane * 16; LAS unsigned char* lp_ = lds + N2_HS_LO + (SLOT) * N2_RS + lane * 16; \
          *(LAS u32x4*)hp_ = ha_; *(LAS u32x4*)(hp_ + 1024) = hb_; *(LAS u32x4*)lp_ = la_; *(LAS u32x4*)(lp_ + 1024) = lb_; } } while (0)
    for (int base = 0; base < nrows; base += 2 * nw) {
        const int row = base + blockIdx.x * 8 + wid;
        if (row < nrows) N2_ROW(row, 2 * wid);
        if (row + nw < nrows) N2_ROW(row + nw, 2 * wid + 1);
        __syncthreads();
        {
            const int r = lane & 15, kq = lane >> 4;
            f32x4 acc = {0.f, 0.f, 0.f, 0.f};
#pragma unroll
            for (int jj = 0; jj < 4; ++jj) {
                const int kb = (32 * (4 * wid + jj) + 8 * kq) * 2;
                const bf16x8 ah = *(const LAS bf16x8*)(lds + N2_HS_HI + r * N2_RS + kb), al = *(const LAS bf16x8*)(lds + N2_HS_LO + r * N2_RS + kb);
                const bf16x8 bh = *(const LAS bf16x8*)(lds + N2_WT_HI + r * N2_RS + kb), bl = *(const LAS bf16x8*)(lds + N2_WT_LO + r * N2_RS + kb);
                acc = __builtin_amdgcn_mfma_f32_16x16x32_bf16(ah, bh, acc, 0, 0, 0);
                acc = __builtin_amdgcn_mfma_f32_16x16x32_bf16(ah, bl, acc, 0, 0, 0);
                acc = __builtin_amdgcn_mfma_f32_16x16x32_bf16(al, bh, acc, 0, 0, 0);
            }
            LAS float* part = (LAS float*)(lds + N2_PART) + wid * 256;
#pragma unroll
            for (int i = 0; i < 4; ++i) part[(4 * kq + i) * 16 + r] = acc[i];
        }
        __syncthreads();
        if (tid < 256) {
            const int m = tid >> 4, e = tid & 15;
            const LAS float* part = (const LAS float*)(lds + N2_PART) + tid;
            float lg = 0.f;
#pragma unroll
            for (int w = 0; w < 8; ++w) lg += part[w * 256];
            float mx = lg;
            mx = fmaxf(mx, xshfl<1>(mx)); mx = fmaxf(mx, xshfl<2>(mx)); mx = fmaxf(mx, xshfl<4>(mx)); mx = fmaxf(mx, xshfl<8>(mx));
            const float ex = __expf(lg - mx);
            float den = ex;
            den += xshfl<1>(den); den += xshfl<2>(den); den += xshfl<4>(den); den += xshfl<8>(den);
            const float aff = ex / den;
            const int row_ = base + blockIdx.x * 8 + (m >> 1) + (m & 1) * nw;
            if (row_ < nrows) {
                if (row_ < M_LAT) ((float*)(P.ws + WS_AFF_LAT))[((size_t)((row_ >> 12) * 16 + e)) * 4096 + (row_ & 4095)] = aff;
                else { const int rc = row_ - M_LAT; ((float*)(P.ws + WS_AFF_CTX))[((size_t)((rc >> 8) * 16 + e)) * 256 + (rc & 255)] = aff; }
            }
        }
    }
    __syncthreads();
#undef N2_ROW
}
__device__ __forceinline__ void topk_item(const Params& P, int group, int slots_per_e, LAS unsigned char* lds) {
    const int tid = opaque_tid(), wid = tid >> 6, lane = tid & 63;
    LAS unsigned* hist = (LAS unsigned*)lds;
    LAS unsigned* suf = hist + 256;
    LAS unsigned* ctl = suf + 256;
    LAS int* sel = (LAS int*)(ctl + 16);
    const bool isctx = group >= 128; const int g = group & 127, b = g >> 4, e = g & 15;
    const int T = isctx ? 256 : 4096, cap = T >> 3;
    const float* aff = isctx ? (const float*)(P.ws + WS_AFF_CTX) + (size_t)g * 256 : (const float*)(P.ws + WS_AFF_LAT) + (size_t)g * 4096;
    unsigned v[8];
#pragma unroll
    for (int i = 0; i < 8; ++i) { const int t = tid + NTHREADS * i; v[i] = (t < T) ? __float_as_uint(aff[t]) : 0u; }
    unsigned prefix = 0u, mask = 0u; int k = cap;
    for (int pass = 3; pass >= 0; --pass) {
        const int shift = pass * 8;
        if (tid < 256) hist[tid] = 0u;
        __syncthreads();
#pragma unroll
        for (int i = 0; i < 8; ++i) { const int t = tid + NTHREADS * i; if (t < T && (v[i] & mask) == prefix) atomicAdd((unsigned*)&hist[(v[i] >> shift) & 255u], 1u); }
        __syncthreads();
        if (tid < 256) suf[tid] = hist[tid];
        __syncthreads();
        for (int off = 1; off < 256; off <<= 1) {
            unsigned t2 = 0u;
            if (tid < 256 && tid + off < 256) t2 = suf[tid + off];
            __syncthreads();
            if (tid < 256) suf[tid] += t2;
            __syncthreads();
        }
        if (tid < 256) { const unsigned sj = suf[tid], sj1 = (tid < 255) ? suf[tid + 1] : 0u; if (sj >= (unsigned)k && sj1 < (unsigned)k) { ctl[0] = (unsigned)tid; ctl[1] = (unsigned)k - sj1; } }
        __syncthreads();
        prefix |= ctl[0] << shift; mask |= 255u << shift; k = (int)ctl[1];
        __syncthreads();
    }
    const unsigned thr = prefix; const int krem = k, ngt = cap - krem;
    int cgt = 0, ceq = 0;
#pragma unroll
    for (int i = 0; i < 8; ++i) { const int t = tid + NTHREADS * i; if (t < T) { cgt += (v[i] > thr) ? 1 : 0; ceq += (v[i] == thr) ? 1 : 0; } }
    int packed = cgt | (ceq << 16), incl = packed;
#pragma unroll
    for (int o = 1; o < 64; o <<= 1) { const int t2 = __builtin_amdgcn_ds_bpermute((lane - o) << 2, incl); if (lane >= o) incl += t2; }
    if (lane == 63) ctl[4 + wid] = (unsigned)incl;
    __syncthreads();
    int base = incl - packed;
    for (int w = 0; w < wid; ++w) base += (int)ctl[4 + w];
    int bgt = base & 0xffff, beq = base >> 16;
    int* IDX = (int*)(P.ws + WS_IDX); float* GATE = (float*)(P.ws + WS_GATE); int* INV = (int*)(P.ws + WS_INV);
    const int gslot0 = isctx ? 4096 + b * 32 : b * 512;
#pragma unroll
    for (int i = 0; i < 8; ++i) {
        const int t = tid + NTHREADS * i;
        if (t < T) {
            int slot = -1;
            if (v[i] > thr) slot = bgt++;
            else if (v[i] == thr) { const int r = beq++; if (r < krem) slot = ngt + r; }
            const int row = isctx ? M_LAT + b * 256 + t : b * 4096 + t;
            INV[(size_t)row * 16 + e] = (slot >= 0) ? gslot0 + slot : -1;
            if (slot >= 0) { IDX[e * slots_per_e + gslot0 + slot] = row; GATE[e * slots_per_e + gslot0 + slot] = __uint_as_float(v[i]); sel[slot] = row; }
        }
    }
    __syncthreads();
    __syncthreads();
}
namespace pg8 {
constexpr int BM = 256, BK = 64, HALF = 128, HTB = HALF * BK * 2, STAGE_BYTES = 8 * HTB;
__device__ __forceinline__ int lds_byte(int r, int c) { const int st = (r >> 4) * 2 + (c >> 5), rr = r & 15, cc = c & 31, ob = rr * 64 + cc * 2; return st * 1024 + (ob ^ (((ob >> 9) & 1) << 5)); }
__device__ __forceinline__ void stage_rc(int b, int& R, int& C) { const int st = b / 1024, sb = b % 1024, swz = sb ^ (((sb >> 9) & 1) << 5); R = (st >> 1) * 16 + swz / 64; C = (st & 1) * 32 + (swz % 64) / 2; }
__device__ __forceinline__ int perm32(int rho) { const int n = rho >> 4, i = rho & 15; return 8 * (i >> 2) + 4 * n + (i & 3); }
struct Unit { int pm, pn, hs, half; };
struct Gemm { const bf16_t* A; const bf16_t* Bt; int lda, ldb, K; };
struct Sched {
    int nUnits, tM, nN, G, c, nFull;
    __device__ __forceinline__ void init(int groups, int tM_, int nN_) { tM = tM_; nN = nN_; G = gridDim.x; c = (G % 8 == 0) ? (int)((blockIdx.x & 7) * (G / 8) + (blockIdx.x >> 3)) : (int)blockIdx.x;
        const int nTiles = groups * tM_ * nN_, R = nTiles % G;
        if (R > 0 && 2 * R <= G) { nFull = nTiles - R; nUnits = nFull + 2 * R; } else { nFull = nTiles; nUnits = nTiles; } }
    __device__ __forceinline__ bool next(int i, Unit& u) const {
        int L = i * G + c; if (L >= nUnits) return false;
        u.hs = 0; u.half = 0;
        if (L >= nFull) { const int h = L - nFull; L = nFull + (h >> 1); u.half = 1; u.hs = (h & 1) * 128; }
        const int per = tM * nN, e = L / per, r = L - e * per, pml = r / nN, pnl = r - pml * nN;
        u.pm = e * tM + pml; u.pn = e * nN + pnl; return true;
    }
};
enum { EPI_EVEN_IN = 0, EPI_OUT = 1, EPI_ODD_IN = 2, EPI_UPQ = 3, EPI_UPKV = 4, EPI_MOE_UP = 5, EPI_MOE_DOWN = 6 };
struct Epi { int mode; int layer; int nNe; int slots; };

__device__ __forceinline__ void epilogue(const Params& P, const Epi& E, const f32x4 (&acc)[2][2][4][2], const Unit& u) {
    const int tid_ = opaque_tid(), wid_ = __builtin_amdgcn_readfirstlane(tid_ >> 6), lane_ = tid_ & 63, wr = wid_ >> 2, wc = wid_ & 3, fr = lane_ & 15, fq = lane_ >> 4;
    unsigned char* ws = P.ws;
    if (E.mode == 99) return;
#define EPI_PACK8(W, A, B) do { W.x = cvtpk(A[0], A[1]); W.y = cvtpk(A[2], A[3]); W.z = cvtpk(B[0], B[1]); W.w = cvtpk(B[2], B[3]); } while (0)
#define EPI_ROT(A, B, CS, SN, RA, RB) do { _Pragma("unroll") for (int j = 0; j < 4; ++j) { RA[j] = A[j] * CS[j] - B[j] * SN[j]; RB[j] = B[j] * CS[j] + A[j] * SN[j]; } } while (0)
    if (E.mode == EPI_EVEN_IN) {
        bf16_t* O = (bf16_t*)(ws + WS_BIG); const float* rope = (const float*)(ws + WS_ROPE16);
        const int rowb = (u.pm * BM + u.hs) + wr * 64;
        bf16_t* rowp0 = O + (size_t)(rowb + fr) * EVEN_IN + u.pn * BM + wc * 32 + 8 * fq;
        const bool rot = ((u.pm * BM + u.hs) < M_LAT) && (u.pn < 4);
#define EPI_EVEN_STORE(CS, SN, AI, M_) do { _Pragma("unroll") for (int bj = 0; bj < 2; ++bj) { \
            const f32x4 a = acc[AI][bj][M_][0], b = acc[AI][bj][M_][1]; float ra[4], rb[4]; EPI_ROT(a, b, CS, SN, ra, rb); u32x4 w; EPI_PACK8(w, ra, rb); \
            *(u32x4*)(rowp0 + (size_t)((AI) * HALF + (M_) * 16) * EVEN_IN + bj * HALF) = w; } } while (0)
        if (!rot) {
#pragma unroll
            for (int ai = 0; ai < 2; ++ai) if (ai == 0 || !u.half)
#pragma unroll
                for (int m = 0; m < 4; ++m)
#pragma unroll
                    for (int bj = 0; bj < 2; ++bj) { const f32x4 a = acc[ai][bj][m][0], b = acc[ai][bj][m][1]; u32x4 w; EPI_PACK8(w, a, b);
                        *(u32x4*)(rowp0 + (size_t)(ai * HALF + m * 16) * EVEN_IN + bj * HALF) = w; }
        } else if (wc & 1) {
            f32x4 c01[4], c23[4];
#pragma unroll
            for (int m = 0; m < 4; ++m) { const f32x4* tp = (const f32x4*)(rope + (size_t)((m * 16 + fr) * 16 + 4 * fq) * 2); c01[m] = tp[0]; c23[m] = tp[1]; }
#pragma unroll
            for (int ai = 0; ai < 2; ++ai) if (ai == 0 || !u.half)
#pragma unroll
                for (int m = 0; m < 4; ++m) { const float cs[4] = {c01[m][0], c01[m][2], c23[m][0], c23[m][2]}, sn[4] = {c01[m][1], c01[m][3], c23[m][1], c23[m][3]}; EPI_EVEN_STORE(cs, sn, ai, m); }
        } else {
            f32x4 c01[2], c23[2];
#pragma unroll
            for (int ai = 0; ai < 2; ++ai) { const int pos = ((rowb + ai * HALF) & 4095) >> 6; const f32x4* tp = (const f32x4*)(rope + (size_t)(pos * 16 + 4 * fq) * 2); c01[ai] = tp[0]; c23[ai] = tp[1]; }
#pragma unroll
            for (int ai = 0; ai < 2; ++ai) if (ai == 0 || !u.half) { const float cs[4] = {c01[ai][0], c01[ai][2], c23[ai][0], c23[ai][2]}, sn[4] = {c01[ai][1], c01[ai][3], c23[ai][1], c23[ai][3]};
#pragma unroll
                for (int m = 0; m < 4; ++m) EPI_EVEN_STORE(cs, sn, ai, m); }
        }
#undef EPI_EVEN_STORE
    } else if (E.mode == EPI_OUT) {
        bf16_t* O = (bf16_t*)(ws + WS_YMIX);
#pragma unroll
        for (int ai = 0; ai < 2; ++ai) if (ai == 0 || !u.half)
#pragma unroll
            for (int m = 0; m < 4; ++m) {
                const int row = (u.pm * BM + u.hs) + ai * HALF + wr * 64 + m * 16 + fr;
                bf16_t* rowp = O + (size_t)row * 1024 + u.pn * BM + wc * 32 + 8 * fq;
#pragma unroll
                for (int bj = 0; bj < 2; ++bj) { const f32x4 a = acc[ai][bj][m][0], b = acc[ai][bj][m][1]; u32x4 w; EPI_PACK8(w, a, b); *(u32x4*)(rowp + bj * HALF) = w; }
            }
    } else if (E.mode == EPI_ODD_IN) {
        bf16_t* O = (bf16_t*)(ws + WS_PROJ); bf16_t* KR = (bf16_t*)(ws + WS_KR); const float* rope = (const float*)(ws + WS_ROPE8);
        float* partq = (float*)(ws + WS_PARTQ); float* partkv = (float*)(ws + WS_PARTKV);
#pragma unroll
        for (int ai = 0; ai < 2; ++ai) if (ai == 0 || !u.half)
#pragma unroll
            for (int m = 0; m < 4; ++m) {
                const int row = (u.pm * BM + u.hs) + ai * HALF + wr * 64 + m * 16 + fr;
                if (u.pn == 0) {
                    float s = 0.f;
#pragma unroll
                    for (int bj = 0; bj < 2; ++bj)
#pragma unroll
                        for (int n = 0; n < 2; ++n) { const f32x4 x = acc[ai][bj][m][n]; s += (x[0] * x[0] + x[1] * x[1]) + (x[2] * x[2] + x[3] * x[3]); }
                    s += xshfl<16>(s); s += xshfl<32>(s);
                    if (fq == 0) partq[(size_t)row * 4 + wc] = s;
                }
                if (u.pn == 1) {
                    float s = 0.f;
#pragma unroll
                    for (int n = 0; n < 2; ++n) { const f32x4 x = acc[ai][0][m][n]; s += (x[0] * x[0] + x[1] * x[1]) + (x[2] * x[2] + x[3] * x[3]); }
                    s += xshfl<16>(s); s += xshfl<32>(s);
                    if (fq == 0) partkv[(size_t)row * 4 + wc] = s;
                }
#pragma unroll
                for (int bj = 0; bj < 2; ++bj) {
                    const int colg = u.pn * BM + bj * HALF + wc * 32;
                    const f32x4 a = acc[ai][bj][m][0], b = acc[ai][bj][m][1];
                    if (colg == 384) {
                        const bool rot = row < M_LAT; const int t = row & 4095, pos = (fq >= 2) ? (t & 63) : (t >> 6);
                        f32x4 c01 = {1.f, 0.f, 1.f, 0.f}, c23 = {1.f, 0.f, 1.f, 0.f};
                        if (rot) { const f32x4* tp = (const f32x4*)(rope + (size_t)(pos * 8 + 4 * (fq & 1)) * 2); c01 = tp[0]; c23 = tp[1]; }
                        const float cs[4] = {c01[0], c01[2], c23[0], c23[2]}, sn[4] = {c01[1], c01[3], c23[1], c23[3]};
                        float ra[4], rb[4]; EPI_ROT(a, b, cs, sn, ra, rb);
                        u32x4 w; EPI_PACK8(w, ra, rb);
                        *(u32x4*)(KR + (size_t)row * 32 + 8 * fq) = w;
                    } else if (colg + 8 * fq < ODD_IN) { u32x4 w; EPI_PACK8(w, a, b); *(u32x4*)(O + (size_t)row * ODD_IN + colg + 8 * fq) = w; }
                }
            }
    } else if (E.mode == EPI_UPQ) {
        bf16_t* O = (bf16_t*)(ws + WS_QM); const float* rope = (const float*)(ws + WS_ROPE8); const float* partq = (const float*)(ws + WS_PARTQ);
        f32x4 pqa[8] = {};
#pragma unroll
        for (int g8 = 0; g8 < 8; ++g8) if (g8 < 4 || !u.half) pqa[g8] = *(const f32x4*)(partq + (size_t)((u.pm * BM + u.hs) + (g8 >> 2) * HALF + wr * 64 + (g8 & 3) * 16 + fr) * 4);
#pragma unroll
        for (int ai = 0; ai < 2; ++ai) if (ai == 0 || !u.half)
#pragma unroll
            for (int m = 0; m < 4; ++m) {
                const int row = (u.pm * BM + u.hs) + ai * HALF + wr * 64 + m * 16 + fr;
                const f32x4 pq = pqa[ai * 4 + m];
                const float rs = rsqrtf(((pq[0] + pq[1]) + (pq[2] + pq[3])) * (1.0f / 256.0f) + RMS_EPS);
                const int t = row & 4095, pos = (fq >= 2) ? (t & 63) : (t >> 6);
                const f32x4* tp = (const f32x4*)(rope + (size_t)(pos * 8 + 4 * (fq & 1)) * 2); f32x4 c01 = tp[0], c23 = tp[1];
                asm volatile("" : "+v"(c01), "+v"(c23));
                const float cs[4] = {c01[0], c01[2], c23[0], c23[2]}, sn[4] = {c01[1], c01[3], c23[1], c23[3]};
#pragma unroll
                for (int bj = 0; bj < 2; ++bj) {
                    const int colg = u.pn * BM + bj * HALF + wc * 32, grp = colg >> 5;
                    const f32x4 a = acc[ai][bj][m][0] * rs, b = acc[ai][bj][m][1] * rs;
                    u32x4 w;
                    if (grp % 3 == 2) { float ra[4], rb[4]; EPI_ROT(a, b, cs, sn, ra, rb); EPI_PACK8(w, ra, rb); }
                    else EPI_PACK8(w, a, b);
                    *(u32x4*)(O + (size_t)row * 768 + colg + 8 * fq) = w;
                }
            }
    } else if (E.mode == EPI_UPKV) {
        bf16_t* O = (bf16_t*)(ws + WS_KVM); const float* partkv = (const float*)(ws + WS_PARTKV);
        f32x4 pqa[8] = {};
#pragma unroll
        for (int g8 = 0; g8 < 8; ++g8) if (g8 < 4 || !u.half) pqa[g8] = *(const f32x4*)(partkv + (size_t)((u.pm * BM + u.hs) + (g8 >> 2) * HALF + wr * 64 + (g8 & 3) * 16 + fr) * 4);
#pragma unroll
        for (int ai = 0; ai < 2; ++ai) if (ai == 0 || !u.half)
#pragma unroll
            for (int m = 0; m < 4; ++m) {
                const int row = (u.pm * BM + u.hs) + ai * HALF + wr * 64 + m * 16 + fr;
                const f32x4 pq = pqa[ai * 4 + m];
                const float rs = rsqrtf(((pq[0] + pq[1]) + (pq[2] + pq[3])) * (1.0f / 128.0f) + RMS_EPS);
                bf16_t* rowp = O + (size_t)row * 1024 + u.pn * BM + wc * 32 + 8 * fq;
#pragma unroll
                for (int bj = 0; bj < 2; ++bj) { const f32x4 a = acc[ai][bj][m][0] * rs, b = acc[ai][bj][m][1] * rs; u32x4 w; EPI_PACK8(w, a, b); *(u32x4*)(rowp + bj * HALF) = w; }
            }
    } else if (E.mode == EPI_MOE_UP) {
        bf16_t* O = (bf16_t*)(ws + WS_HID); const int pnl = u.pn % E.nNe;
#pragma unroll
        for (int ai = 0; ai < 2; ++ai) if (ai == 0 || !u.half)
#pragma unroll
            for (int m = 0; m < 4; ++m) {
                const int row = (u.pm * BM + u.hs) + ai * HALF + wr * 64 + m * 16 + fr;
                float hv[8];
#pragma unroll
                for (int n = 0; n < 2; ++n)
#pragma unroll
                    for (int j = 0; j < 4; ++j) { const float a = acc[ai][0][m][n][j], b = acc[ai][1][m][n][j]; hv[n * 4 + j] = a * __builtin_amdgcn_rcpf(1.0f + __builtin_amdgcn_exp2f(-a * LOG2E)) * b; }
                u32x4 w; w.x = cvtpk(hv[0], hv[1]); w.y = cvtpk(hv[2], hv[3]); w.z = cvtpk(hv[4], hv[5]); w.w = cvtpk(hv[6], hv[7]);
                *(u32x4*)(O + (size_t)row * 1024 + pnl * 128 + wc * 32 + 8 * fq) = w;
            }
    } else {
        bf16_t* O = (bf16_t*)(ws + WS_Y); const int pnl = u.pn % E.nNe;
#pragma unroll
        for (int ai = 0; ai < 2; ++ai) if (ai == 0 || !u.half)
#pragma unroll
            for (int m = 0; m < 4; ++m) {
                const int row = (u.pm * BM + u.hs) + ai * HALF + wr * 64 + m * 16 + fr;
#pragma unroll
                for (int bj = 0; bj < 2; ++bj) { const f32x4 x0 = acc[ai][bj][m][0], x1 = acc[ai][bj][m][1];
                    u32x4 w; EPI_PACK8(w, x0, x1);
                    *(u32x4*)(O + (size_t)row * 1024 + pnl * BM + bj * HALF + wc * 32 + 8 * fq) = w; }
            }
    }
#undef EPI_PACK8
#undef EPI_ROT
}

__device__ __forceinline__ void gemm_phase(LAS unsigned char* lds, const Gemm g, const Sched& S, const Params& P, const Epi& E) {
    const int tid = opaque_tid(), wid = __builtin_amdgcn_readfirstlane(tid >> 6), lane = tid & 63, wr = wid >> 2, wc = wid & 3, fr = lane & 15, fq = lane >> 4;
    const int K = g.K, nt = K / BK;
    const bool perm = true;
    const bool gather = (E.mode == EPI_MOE_UP);
    const int* IDXp = (const int*)(P.ws + WS_IDX);
    unsigned voffB[2]; int Rl[2], Cl[2];
#pragma unroll
    for (int i = 0; i < 2; ++i) { int R, C; stage_rc(tid * 16 + i * 8192, R, C); const int Rb = perm ? ((R & ~31) + perm32(R & 31)) : R; Rl[i] = R; Cl[i] = C;
        voffB[i] = (unsigned)(Rb * g.ldb + C) * 2u; }
    const size_t kstep = (size_t)(BK * 2);
    const size_t hstepA = (size_t)HALF * g.lda * 2, hstepB = (size_t)HALF * g.ldb * 2;
    const size_t tstepA = gather ? 0 : 2 * hstepA, tstepB = 2 * hstepB;
    unsigned voffA_lo[2], voffA_hi[2], voffN_lo[2], voffN_hi[2];
#define PG8_ROWS_NOW(U, R0, R1) do { _Pragma("unroll") for (int i_ = 0; i_ < 2; ++i_) { const int rl_ = (U).hs + Rl[i_], rh_ = ((U).hs ^ HALF) + Rl[i_]; \
        if (gather) { R0[i_] = IDXp[(U).pm * BM + rl_]; R1[i_] = IDXp[(U).pm * BM + rh_]; } else { R0[i_] = rl_; R1[i_] = rh_; } } } while (0)
#define PG8_ROWS_ASYNC(U, R0, R1) do { _Pragma("unroll") for (int i_ = 0; i_ < 2; ++i_) { const int rl_ = (U).hs + Rl[i_], rh_ = ((U).hs ^ HALF) + Rl[i_]; \
        if (gather) { asm volatile("global_load_dword %0, %1, off" : "=v"(R0[i_]) : "v"(IDXp + (U).pm * BM + rl_) : "memory"); \
                      asm volatile("global_load_dword %0, %1, off" : "=v"(R1[i_]) : "v"(IDXp + (U).pm * BM + rh_) : "memory"); } else { R0[i_] = rl_; R1[i_] = rh_; } } } while (0)
#define PG8_VOFF(R0, R1, LO, HI) do { _Pragma("unroll") for (int i_ = 0; i_ < 2; ++i_) { LO[i_] = (unsigned)(R0[i_] * g.lda + Cl[i_]) * 2u; HI[i_] = (unsigned)(R1[i_] * g.lda + Cl[i_]) * 2u; } } while (0)
    const unsigned ldsw = (unsigned)wid * 1024u;
    const int aoff = lds_byte(wr * 64 + fr, fq * 8), boff = lds_byte(wc * 32 + fr, fq * 8);
#define PG8_SA(b, h) (((b) * 2 + (h)) * HTB)
#define PG8_SB(b, h) ((4 + (b) * 2 + (h)) * HTB)
#define PG8_STAGE(bufoff, gbase, voff) do { _Pragma("unroll") for (int _i = 0; _i < 2; ++_i) \
        __builtin_amdgcn_global_load_lds((const unsigned*)((const char*)(gbase) + (voff)[_i]), (LAS unsigned*)(lds + (bufoff) + ldsw + _i * 8192), 16, 0, 0); } while (0)
#define PG8_LDA(dst, b, h) do { _Pragma("unroll") for (int m = 0; m < 4; ++m) _Pragma("unroll") for (int k = 0; k < 2; ++k) dst[m][k] = *(const LAS bf16x8*)(lds + PG8_SA(b, h) + aoff + m * 2048 + k * 1024); } while (0)
#define PG8_LDB(dst, b, h) do { _Pragma("unroll") for (int n = 0; n < 2; ++n) _Pragma("unroll") for (int k = 0; k < 2; ++k) dst[n][k] = *(const LAS bf16x8*)(lds + PG8_SB(b, h) + boff + n * 2048 + k * 1024); } while (0)
#define PG8_MMA(ai, bj, At, Bt) do { __builtin_amdgcn_s_setprio(1); _Pragma("unroll") for (int m = 0; m < 4; ++m) _Pragma("unroll") for (int n = 0; n < 2; ++n) _Pragma("unroll") for (int k = 0; k < 2; ++k) \
        acc[ai][bj][m][n] = __builtin_amdgcn_mfma_f32_16x16x32_bf16(Bt[n][k], At[m][k], acc[ai][bj][m][n], 0, 0, 0); __builtin_amdgcn_s_setprio(0); } while (0)
#define PG8_WAIT_V(n) asm volatile("s_waitcnt vmcnt(" #n ")" ::: "memory")
#define PG8_WAIT_L(n) __builtin_amdgcn_s_waitcnt(0xC07F)
#define PG8_BAR __builtin_amdgcn_s_barrier()
#define PG8_SCHED __builtin_amdgcn_sched_barrier(0)
    Unit cur, nxt; int ui = 0;
    if (!S.next(0, cur)) return;
    float z0_ = 0.f; asm volatile("" : "+v"(z0_));
    const f32x4 zero4 = {z0_, z0_, z0_, z0_};
    f32x4 acc[2][2][4][2];
#pragma unroll
    for (int a = 0; a < 2; ++a)
#pragma unroll
        for (int b = 0; b < 2; ++b)
#pragma unroll
            for (int m = 0; m < 4; ++m)
#pragma unroll
                for (int n = 0; n < 2; ++n) acc[a][b][m][n] = zero4;
    bf16x8 At[4][2], B0[2][2], B1[2][2];
    const char* cA = (const char*)g.A + (size_t)cur.pm * tstepA; const char* cB = (const char*)g.Bt + (size_t)cur.pn * tstepB;
    int crow0[2], crow1[2], nrow0[2], nrow1[2];
    PG8_ROWS_NOW(cur, crow0, crow1); PG8_VOFF(crow0, crow1, voffA_lo, voffA_hi);
    PG8_STAGE(PG8_SB(0, 0), cB, voffB); PG8_STAGE(PG8_SB(0, 1), cB + hstepB, voffB); PG8_STAGE(PG8_SA(0, 0), cA, voffA_lo); PG8_STAGE(PG8_SA(0, 1), cA, voffA_hi);
    if (wr == 1) PG8_BAR;
    PG8_WAIT_V(2); PG8_BAR;
    PG8_STAGE(PG8_SB(1, 0), cB + kstep, voffB); PG8_STAGE(PG8_SA(1, 0), cA + kstep, voffA_lo); PG8_STAGE(PG8_SB(1, 1), cB + hstepB + kstep, voffB);
    PG8_WAIT_V(6); PG8_BAR;
    for (;;) {
        const bool has_next = S.next(ui + 1, nxt);
        const char* nA = has_next ? (const char*)g.A + (size_t)nxt.pm * tstepA : cA; const char* nB = has_next ? (const char*)g.Bt + (size_t)nxt.pn * tstepB : cB;
        if (has_next) PG8_ROWS_ASYNC(nxt, nrow0, nrow1); else { nrow0[0] = crow0[0]; nrow0[1] = crow0[1]; nrow1[0] = crow1[0]; nrow1[1] = crow1[1]; }
#define PG8_KLOOP(FULL) do { for (int t = 0; t < nt; t += 2) { \
            const bool last = (t == nt - 2); \
            asm volatile("" : "+v"(nrow0[0]), "+v"(nrow0[1]), "+v"(nrow1[0]), "+v"(nrow1[1])); PG8_VOFF(nrow0, nrow1, voffN_lo, voffN_hi);     \
            const char* a1 = cA + (size_t)(t + 1) * kstep; \
            const char* a2 = last ? nA : cA + (size_t)(t + 2) * kstep; const char* b2 = last ? nB : cB + (size_t)(t + 2) * kstep; \
            const char* a3 = a2 + kstep; const char* b3 = b2 + kstep; \
            unsigned v2lo[2], v2hi[2]; v2lo[0] = last ? voffN_lo[0] : voffA_lo[0]; v2lo[1] = last ? voffN_lo[1] : voffA_lo[1]; v2hi[0] = last ? voffN_hi[0] : voffA_hi[0]; v2hi[1] = last ? voffN_hi[1] : voffA_hi[1]; \
              \
            PG8_LDB(B0, 0, 0); PG8_LDB(B1, 0, 1); PG8_SCHED; PG8_LDA(At, 0, 0); PG8_STAGE(PG8_SA(1, 1), a1, voffA_hi); \
            PG8_WAIT_V(8); PG8_WAIT_L(0); PG8_BAR; PG8_MMA(0, 0, At, B0); PG8_MMA(0, 1, At, B1); PG8_BAR; PG8_SCHED; \
            if (FULL) PG8_LDA(At, 0, 1); PG8_STAGE(PG8_SB(0, 0), b2, voffB); PG8_STAGE(PG8_SB(0, 1), b2 + hstepB, voffB); PG8_STAGE(PG8_SA(0, 0), a2, v2lo); \
            PG8_WAIT_V(8); PG8_WAIT_L(0); PG8_BAR; if (FULL) { PG8_MMA(1, 0, At, B0); PG8_MMA(1, 1, At, B1); } PG8_BAR; PG8_SCHED; \
              \
            PG8_LDB(B0, 1, 0); PG8_LDB(B1, 1, 1); PG8_SCHED; PG8_LDA(At, 1, 0); PG8_STAGE(PG8_SA(0, 1), a2, v2hi); \
            PG8_WAIT_V(8); PG8_WAIT_L(0); PG8_BAR; PG8_MMA(0, 0, At, B0); PG8_MMA(0, 1, At, B1); PG8_BAR; PG8_SCHED; \
            if (FULL) PG8_LDA(At, 1, 1); PG8_STAGE(PG8_SB(1, 0), b3, voffB); PG8_STAGE(PG8_SB(1, 1), b3 + hstepB, voffB); PG8_STAGE(PG8_SA(1, 0), a3, v2lo); \
            PG8_WAIT_V(8); PG8_WAIT_L(0); PG8_BAR; if (FULL) { PG8_MMA(1, 0, At, B0); PG8_MMA(1, 1, At, B1); } PG8_BAR; PG8_SCHED; \
        } } while (0)
        { const bool full = (cur.half == 0); PG8_KLOOP(full); }
#undef PG8_KLOOP
        if (wr == 0) PG8_BAR;
        epilogue(P, E, acc, cur);
        if (!has_next) break;
#pragma unroll
        for (int a = 0; a < 2; ++a)
#pragma unroll
            for (int b = 0; b < 2; ++b)
#pragma unroll
                for (int m = 0; m < 4; ++m)
#pragma unroll
                    for (int n = 0; n < 2; ++n) acc[a][b][m][n] = zero4;
        cur = nxt; cA = nA; cB = nB; ++ui;
        voffA_lo[0] = voffN_lo[0]; voffA_lo[1] = voffN_lo[1]; voffA_hi[0] = voffN_hi[0]; voffA_hi[1] = voffN_hi[1];
        crow0[0] = nrow0[0]; crow0[1] = nrow0[1]; crow1[0] = nrow1[0]; crow1[1] = nrow1[1];
        if (wr == 1) PG8_BAR;
    }
    PG8_WAIT_V(0);
    PG8_BAR;
#undef PG8_ROWS_NOW
#undef PG8_ROWS_ASYNC
#undef PG8_VOFF
#undef PG8_SA
#undef PG8_SB
#undef PG8_STAGE
#undef PG8_LDA
#undef PG8_LDB
#undef PG8_MMA
#undef PG8_WAIT_V
#undef PG8_WAIT_L
#undef PG8_BAR
#undef PG8_SCHED
}
}
namespace att {
#define SBAR() __builtin_amdgcn_sched_barrier(0)
#ifndef PROF_SEG
#define PROF_SEG -1
#endif
constexpr int PROF_LDS_OFF = 143360;
#if PROF_SEG >= 0
__device__ __forceinline__ unsigned long long prof_stamp() { unsigned long long t; SBAR(); asm volatile("s_memtime %0\n\ts_waitcnt lgkmcnt(0)" : "=s"(t) :: "memory"); SBAR(); return t; }
#define PROF_DECL() unsigned prof_acc[8] = {0u, 0u, 0u, 0u, 0u, 0u, 0u, 0u}; unsigned long long prof_last = prof_stamp()
#define PROF_MARK(seg) do { const unsigned long long t_now_ = prof_stamp(); prof_acc[seg] += (unsigned)(t_now_ - prof_last); prof_last = t_now_; } while (0)
#define PROF_FLUSH(lds, wid, lane) do { if (lane == 0) { LAS unsigned* pp_ = (LAS unsigned*)((lds) + PROF_LDS_OFF) + (wid) * 8; _Pragma("unroll") for (int q_ = 0; q_ < 8; ++q_) pp_[q_] += prof_acc[q_]; } } while (0)
#else
#define PROF_DECL() do {} while (0)
#define PROF_MARK(seg) do {} while (0)
#define PROF_FLUSH(lds, wid, lane) do {} while (0)
#endif
template <int OFF> __device__ __forceinline__ s16x4 tr_read(unsigned vb) {
    s16x4 r; asm volatile("ds_read_b64_tr_b16 %0, %1 offset:%2" : "=&v"(r) : "v"(vb), "i"(OFF) : "memory"); return r;
}
template <int DV> __device__ __forceinline__ int v_st(int k, int c) {
    const int kk = (k & ~0xC) | ((k & 4) << 1) | ((k & 8) >> 1);
    return ((kk >> 3) * (DV / 32) + (c >> 5)) * 512 + ((kk & 7) * 32 + (c & 31)) * 2;
}
__device__ __forceinline__ int v_rd_base(int lane) { return ((lane & 3) << 3) | (((lane >> 2) & 3) << 6) | (((lane >> 4) & 1) << 5) | (((lane >> 5) & 1) << 8); }
template <int DV> constexpr int v_rd_off(int d0, int ks, int half) { return d0 * 512 + ks * (DV / 32) * 1024 + half * (DV / 32) * 512; }
#define PK8(L, H) (bf16x8){L[0], L[1], L[2], L[3], H[0], H[1], H[2], H[3]}
template <int DV, int D0> __device__ __forceinline__ void pv_one(f32x16& od, unsigned vb, bf16x8 pa0, bf16x8 pa1, bf16x8 pa2, bf16x8 pa3) {
    const s16x4 l0 = tr_read<v_rd_off<DV>(D0, 0, 0)>(vb), h0 = tr_read<v_rd_off<DV>(D0, 0, 1)>(vb), l1 = tr_read<v_rd_off<DV>(D0, 1, 0)>(vb), h1 = tr_read<v_rd_off<DV>(D0, 1, 1)>(vb);
    const s16x4 l2 = tr_read<v_rd_off<DV>(D0, 2, 0)>(vb), h2 = tr_read<v_rd_off<DV>(D0, 2, 1)>(vb), l3 = tr_read<v_rd_off<DV>(D0, 3, 0)>(vb), h3 = tr_read<v_rd_off<DV>(D0, 3, 1)>(vb);
    asm volatile("s_waitcnt lgkmcnt(0)" ::: "memory"); SBAR();
    od = __builtin_amdgcn_mfma_f32_32x32x16_bf16(pa0, PK8(l0, h0), od, 0, 0, 0);
    od = __builtin_amdgcn_mfma_f32_32x32x16_bf16(pa1, PK8(l1, h1), od, 0, 0, 0);
    od = __builtin_amdgcn_mfma_f32_32x32x16_bf16(pa2, PK8(l2, h2), od, 0, 0, 0);
    od = __builtin_amdgcn_mfma_f32_32x32x16_bf16(pa3, PK8(l3, h3), od, 0, 0, 0);
}
#define PK4(P, BASE, OUT) do { unsigned a0 = cvtpk(P[BASE + 0], P[BASE + 1]), a1 = cvtpk(P[BASE + 2], P[BASE + 3]);   \
    unsigned b0 = cvtpk(P[BASE + 4], P[BASE + 5]), b1 = cvtpk(P[BASE + 6], P[BASE + 7]);                              \
    auto r0 = __builtin_amdgcn_permlane32_swap(a0, b0, false, false); auto r1 = __builtin_amdgcn_permlane32_swap(a1, b1, false, false); \
    u32x4 w = {r0[0], r1[0], r0[1], r1[1]}; OUT = __builtin_bit_cast(bf16x8, w); } while (0)
__device__ __forceinline__ void pack_p(const f32x16& p0, const f32x16& p1, bf16x8& pa0, bf16x8& pa1, bf16x8& pa2, bf16x8& pa3) {
    PK4(p0, 0, pa0); PK4(p0, 8, pa1); PK4(p1, 0, pa2); PK4(p1, 8, pa3);
}
__device__ __forceinline__ float half_swap_max(float x) { auto rr = __builtin_amdgcn_permlane32_swap(__float_as_uint(x), __float_as_uint(x), false, false); return fmaxf(__uint_as_float(rr[0]), __uint_as_float(rr[1])); }
__device__ __forceinline__ float half_swap_add(float x) { auto rr = __builtin_amdgcn_permlane32_swap(__float_as_uint(x), __float_as_uint(x), false, false); return __uint_as_float(rr[0]) + __uint_as_float(rr[1]); }

template <int DQK> constexpr int KROW = DQK * 2 + 16;
template <int DQK, int DV> struct Lay {
    static constexpr int KB = 64 * KROW<DQK>, VB = 64 * DV * 2;
    static constexpr int K_OFF = 0, V_OFF = 2 * KB, SCR_OFF = 2 * KB + 2 * VB;
    static constexpr int TAB_OFF = SCR_OFF + 8 * 256, END = TAB_OFF + 2048;
};
struct KVSrc {
    const bf16_t* k0; int ldk0;
    const bf16_t* k1; int ldk1;
    const bf16_t* v; int ldv;
    int row_lat0, n_lat, row_ctx0;
};
__device__ __forceinline__ int tile_row0(const KVSrc& s, int j) { return (j < s.n_lat) ? s.row_lat0 + 64 * j : s.row_ctx0 + 64 * (j - s.n_lat); }

template <int DQK, int DV> struct Stage {
    static constexpr int KC = DQK / 8, VC = DV / 8;
    static constexpr int NK = (64 * KC + 511) / 512, NV = (64 * VC + 511) / 512;
    u32x4 kr[NK], vr[NV];
    __device__ __forceinline__ void load(const KVSrc& s, int j, int tid) {
        const int row0 = tile_row0(s, j);
#pragma unroll
        for (int i = 0; i < NK; ++i) { const int c = tid + 512 * i;
            if (c < 64 * KC) { const int key = c / KC, part = c - key * KC;
                const bf16_t* p = (DQK == 96 && part >= 8) ? s.k1 + (size_t)(row0 + key) * s.ldk1 + (part - 8) * 8 : s.k0 + (size_t)(row0 + key) * s.ldk0 + part * 8;
                kr[i] = *(const u32x4*)p; } }
#pragma unroll
        for (int i = 0; i < NV; ++i) { const int c = tid + 512 * i; const int key = c / VC, c8 = c - key * VC;
            vr[i] = *(const u32x4*)(s.v + (size_t)(row0 + key) * s.ldv + c8 * 8); }
    }
    __device__ __forceinline__ void write(LAS unsigned char* kbuf, LAS unsigned char* vbuf, int tid) const {
#pragma unroll
        for (int i = 0; i < NK; ++i) { const int c = tid + 512 * i;
            if (c < 64 * KC) { const int key = c / KC, part = c - key * KC; *(LAS u32x4*)(kbuf + key * KROW<DQK> + part * 16) = kr[i]; } }
#pragma unroll
        for (int i = 0; i < NV; ++i) { const int c = tid + 512 * i; const int key = c / VC, c8 = c - key * VC; *(LAS u32x4*)(vbuf + v_st<DV>(key, c8 * 8)) = vr[i]; }
    }
};
template <int DQK> __device__ __forceinline__ void qkt(f32x16& p0, f32x16& p1, const LAS unsigned char* kbuf, const bf16x8 (&qr)[DQK / 16], int r32, int hi) {
    p0 = (f32x16){}; p1 = (f32x16){};
    bf16x8 kf[DQK / 8];
    const LAS unsigned char* kp = kbuf + r32 * KROW<DQK> + hi * 16;
#pragma unroll
    for (int d0 = 0; d0 < DQK / 16; ++d0) { kf[2 * d0] = *(const LAS bf16x8*)(kp + d0 * 32); kf[2 * d0 + 1] = *(const LAS bf16x8*)(kp + 32 * KROW<DQK> + d0 * 32); }
    asm volatile("s_waitcnt lgkmcnt(0)" ::: "memory"); SBAR();
    __builtin_amdgcn_s_setprio(1);
#pragma unroll
    for (int d0 = 0; d0 < DQK / 16; ++d0) {
        p0 = __builtin_amdgcn_mfma_f32_32x32x16_bf16(kf[2 * d0], qr[d0], p0, 0, 0, 0);
        p1 = __builtin_amdgcn_mfma_f32_32x32x16_bf16(kf[2 * d0 + 1], qr[d0], p1, 0, 0, 0);
    }
    __builtin_amdgcn_s_setprio(0);
}
struct VFrag { s16x4 l0, h0, l1, h1, l2, h2, l3, h3; };
template <int DV, int D0> __device__ __forceinline__ void v_issue(VFrag& f, unsigned vb) {
    f.l0 = tr_read<v_rd_off<DV>(D0, 0, 0)>(vb); f.h0 = tr_read<v_rd_off<DV>(D0, 0, 1)>(vb); f.l1 = tr_read<v_rd_off<DV>(D0, 1, 0)>(vb); f.h1 = tr_read<v_rd_off<DV>(D0, 1, 1)>(vb);
    f.l2 = tr_read<v_rd_off<DV>(D0, 2, 0)>(vb); f.h2 = tr_read<v_rd_off<DV>(D0, 2, 1)>(vb); f.l3 = tr_read<v_rd_off<DV>(D0, 3, 0)>(vb); f.h3 = tr_read<v_rd_off<DV>(D0, 3, 1)>(vb);
}
__device__ __forceinline__ void v_mma(f32x16& od, const VFrag& f, bf16x8 pa0, bf16x8 pa1, bf16x8 pa2, bf16x8 pa3) {
    __builtin_amdgcn_s_setprio(1);
    od = __builtin_amdgcn_mfma_f32_32x32x16_bf16(pa0, PK8(f.l0, f.h0), od, 0, 0, 0);
    od = __builtin_amdgcn_mfma_f32_32x32x16_bf16(pa1, PK8(f.l1, f.h1), od, 0, 0, 0);
    od = __builtin_amdgcn_mfma_f32_32x32x16_bf16(pa2, PK8(f.l2, f.h2), od, 0, 0, 0);
    od = __builtin_amdgcn_mfma_f32_32x32x16_bf16(pa3, PK8(f.l3, f.h3), od, 0, 0, 0);
    __builtin_amdgcn_s_setprio(0);
}
#define LGKM_WAIT(n) do { asm volatile("s_waitcnt lgkmcnt(" #n ")" ::: "memory"); SBAR(); } while (0)
template <int DV> __device__ __forceinline__ void pv_pipe(f32x16 (&o)[DV / 32], VFrag& f0, unsigned vb, bf16x8 pa0, bf16x8 pa1, bf16x8 pa2, bf16x8 pa3) {
    VFrag f1; v_issue<DV, 1>(f1, vb);
    LGKM_WAIT(8); v_mma(o[0], f0, pa0, pa1, pa2, pa3);
    if constexpr (DV == 128) {
        v_issue<DV, 2>(f0, vb);
        LGKM_WAIT(8); v_mma(o[1], f1, pa0, pa1, pa2, pa3);
        v_issue<DV, 3>(f1, vb);
        LGKM_WAIT(8); v_mma(o[2], f0, pa0, pa1, pa2, pa3);
        LGKM_WAIT(0); v_mma(o[3], f1, pa0, pa1, pa2, pa3);
    } else {
        LGKM_WAIT(0); v_mma(o[1], f1, pa0, pa1, pa2, pa3);
    }
}
template <int DV> __device__ __forceinline__ void pv_all(f32x16 (&o)[DV / 32], unsigned vb, bf16x8 pa0, bf16x8 pa1, bf16x8 pa2, bf16x8 pa3) {
    pv_one<DV, 0>(o[0], vb, pa0, pa1, pa2, pa3); pv_one<DV, 1>(o[1], vb, pa0, pa1, pa2, pa3);
    if constexpr (DV == 128) { pv_one<DV, 2>(o[2], vb, pa0, pa1, pa2, pa3); pv_one<DV, 3>(o[3], vb, pa0, pa1, pa2, pa3); }
}
constexpr float THR2 = 10.0f;
template <int DV, bool RAW> __device__ __forceinline__ void softmax_step(f32x16& p0, f32x16& p1, float C, float& m_reg, float& l_reg, f32x16 (&o)[DV / 32], LAS float* al_l, int r32, int hi,
                                                               bf16x8& pa0, bf16x8& pa1, bf16x8& pa2, bf16x8& pa3) {
    float pmax = p0[0];
#pragma unroll
    for (int r = 1; r < 16; ++r) pmax = fmaxf(pmax, p0[r]);
#pragma unroll
    for (int r = 0; r < 16; ++r) pmax = fmaxf(pmax, p1[r]);
    pmax = half_swap_max(pmax);
    if (RAW) pmax *= C;
    if (!__all(pmax - m_reg <= THR2)) {
        const float mn = fmaxf(m_reg, pmax), alpha = __builtin_amdgcn_exp2f(m_reg - mn);
        m_reg = mn; l_reg *= alpha;
        if (hi == 0) al_l[r32] = alpha;
        asm volatile("s_waitcnt lgkmcnt(0)" ::: "memory");
#pragma unroll
        for (int r = 0; r < 16; ++r) { const float a = al_l[crow(r, hi)];
#pragma unroll
            for (int d = 0; d < DV / 32; ++d) o[d][r] *= a; }
        asm volatile("s_waitcnt lgkmcnt(0)" ::: "memory");
    }
    float ps = 0.f; const float nm = -m_reg;
#pragma unroll
    for (int r = 0; r < 16; ++r) { p0[r] = __builtin_amdgcn_exp2f(RAW ? fmaf(p0[r], C, nm) : p0[r] + nm); ps += p0[r]; }
#pragma unroll
    for (int r = 0; r < 16; ++r) { p1[r] = __builtin_amdgcn_exp2f(RAW ? fmaf(p1[r], C, nm) : p1[r] + nm); ps += p1[r]; }
    l_reg += half_swap_add(ps);
    pack_p(p0, p1, pa0, pa1, pa2, pa3);
}
struct NaWave { int active_lo, active_hi;
                int dr0;
                int c, cs; };
template <int DQK, int DV> struct LayD {
    static constexpr int KRB = (DQK == 96) ? 4096 : 0, VB = 64 * DV * 2;
    static constexpr int KR_OFF = 8192, V_OFF = 8192 + KRB;
    static constexpr int NI = (8192 + KRB + VB + 8191) / 8192;
    static constexpr int TILE = NI * 8192, NB = 4;
    static constexpr int SCR_OFF = NB * TILE, TAB_OFF = SCR_OFF + 2048, END = TAB_OFF + 2048;
};
template <int DQK, int DV> struct Dma {
    typedef LayD<DQK, DV> L;
    unsigned voff[L::NI];
    const char* base[L::NI];
    unsigned rowb[L::NI];
    int row_lat0, n_lat, row_ctx0;
    __device__ __forceinline__ void setup(const KVSrc& s, int wid, int lane) {
        row_lat0 = s.row_lat0; n_lat = s.n_lat; row_ctx0 = s.row_ctx0;
#pragma unroll
        for (int i = 0; i < L::NI; ++i) {
            const int Pw = (wid + 8 * i) * 1024;
            if (Pw < 8192) { base[i] = (const char*)s.k0; rowb[i] = (unsigned)s.ldk0 * 2u; }
            else if (Pw < 8192 + L::KRB) { base[i] = (const char*)s.k1; rowb[i] = (unsigned)s.ldk1 * 2u; }
            else { base[i] = (const char*)s.v; rowb[i] = (unsigned)s.ldv * 2u; }
            const int P = Pw + lane * 16;
            if (P < 8192) { const int key = P >> 7, slot = (P >> 4) & 7, c = slot ^ (key & 7); voff[i] = (unsigned)(key * s.ldk0 + c * 8) * 2u; }
            else if (P < 8192 + L::KRB) { const int Pp = P - 8192, key = Pp >> 6, slot = (Pp >> 4) & 3, c = slot ^ ((key >> 2) & 3); voff[i] = (unsigned)(key * s.ldk1 + c * 8) * 2u; }
            else { int Pp = P - L::V_OFF; if (Pp >= L::VB) Pp -= 4096;
                const int sub = Pp >> 9, within = Pp & 511, kkh = sub / (DV / 32), cb = sub % (DV / 32), kkl = within >> 6, cl = (within & 63) >> 1;
                const int kk = kkh * 8 + kkl, key = (kk & ~0xC) | ((kk & 4) << 1) | ((kk & 8) >> 1), c = cb * 32 + cl;
                voff[i] = (unsigned)(key * s.ldv + c) * 2u; }
        }
    }
    __device__ __forceinline__ void issue(const KVSrc&, int j, LAS unsigned char* buf, int wid) const {
        const unsigned row0 = (unsigned)((j < n_lat) ? row_lat0 + 64 * j : row_ctx0 + 64 * (j - n_lat));
#pragma unroll
        for (int i = 0; i < L::NI; ++i)
            dma16_asm(base[i] + (size_t)row0 * rowb[i] + voff[i], buf + (wid + 8 * i) * 1024);
    }
};
template <int DQK> __device__ __forceinline__ void qkt_sw(f32x16& p0, f32x16& p1, const LAS unsigned char* img, const bf16x8 (&qr)[DQK / 16], int r32, int hi) {
    p0 = (f32x16){}; p1 = (f32x16){};
    bf16x8 kf[DQK / 8];
    const LAS unsigned char* kp = img + r32 * 128;
    const int sw = r32 & 7;
#pragma unroll
    for (int d0 = 0; d0 < 4; ++d0) { const int off = ((d0 * 2 + hi) ^ sw) << 4; kf[2 * d0] = *(const LAS bf16x8*)(kp + off); kf[2 * d0 + 1] = *(const LAS bf16x8*)(kp + 4096 + off); }
    if constexpr (DQK == 96) {
        const LAS unsigned char* rp = img + 8192 + r32 * 64; const int sr = (r32 >> 2) & 3;
#pragma unroll
        for (int d0 = 4; d0 < 6; ++d0) { const int off = (((d0 - 4) * 2 + hi) ^ sr) << 4; kf[2 * d0] = *(const LAS bf16x8*)(rp + off); kf[2 * d0 + 1] = *(const LAS bf16x8*)(rp + 2048 + off); }
    }
    asm volatile("s_waitcnt lgkmcnt(0)" ::: "memory"); SBAR();
    __builtin_amdgcn_s_setprio(1);
#pragma unroll
    for (int d0 = 0; d0 < DQK / 16; ++d0) {
        p0 = __builtin_amdgcn_mfma_f32_32x32x16_bf16(kf[2 * d0], qr[d0], p0, 0, 0, 0);
        p1 = __builtin_amdgcn_mfma_f32_32x32x16_bf16(kf[2 * d0 + 1], qr[d0], p1, 0, 0, 0);
    }
    __builtin_amdgcn_s_setprio(0);
}
template <int DQK, int DV, int MODE>
__device__ __forceinline__ void flash_loop(LAS unsigned char* lds, const KVSrc& src, int nt, const bf16x8 (&qr)[DQK / 16], float C,
                                           f32x16 (&o)[DV / 32], float& m_reg, float& l_reg, const NaWave& nw) {
    typedef LayD<DQK, DV> L;
    const int tid = opaque_tid(), wid = __builtin_amdgcn_readfirstlane(tid >> 6), lane = tid & 63, r32 = lane & 31, hi = lane >> 5;
    const bool skew = wid >= 4;
    LAS float* al_l = (LAS float*)(lds + L::SCR_OFF) + wid * 64;
    const LAS float* tab = (const LAS float*)(lds + L::TAB_OFF);
    const unsigned vlane = (unsigned)(uintptr_t)lds + (unsigned)L::V_OFF + (unsigned)v_rd_base(lane);
    Dma<DQK, DV> dma; dma.setup(src, wid, lane);
#pragma unroll
    for (int t = 0; t < 2; ++t) dma.issue(src, min(t, nt - 1), lds + t * L::TILE, wid);
    bf16x8 pa0, pa1, pa2, pa3; bool pend = false;
    PROF_DECL();
#pragma unroll 1
    for (int j = 0; j <= nt; ++j) {
        PROF_MARK(7);
        if constexpr (L::NI == 3) asm volatile("s_waitcnt vmcnt(3) lgkmcnt(0)" ::: "memory"); else asm volatile("s_waitcnt vmcnt(2) lgkmcnt(0)" ::: "memory");
        __builtin_amdgcn_s_barrier();
        PROF_MARK(0);
        dma.issue(src, min(j + 2, nt - 1), lds + ((j + 2) & 3) * L::TILE, wid);
        PROF_MARK(1);
        if (skew && pend) {
            const unsigned vb = vlane + ((j - 1) & 3) * L::TILE;
            VFrag vf0; v_issue<DV, 0>(vf0, vb);
            pv_pipe<DV>(o, vf0, vb, pa0, pa1, pa2, pa3);
            pend = false;
        }
        PROF_MARK(2);
        const int cur = j & 3;
        bool act = j < nt;
        if (MODE == 1) act = act && ((j >= src.n_lat) || (j >= nw.active_lo && j <= nw.active_hi));
        if (act) {
            f32x16 p0, p1;
            qkt_sw<DQK>(p0, p1, lds + cur * L::TILE, qr, r32, hi);
            PROF_MARK(3);
            VFrag vf0;
            if (!skew) v_issue<DV, 0>(vf0, vlane + cur * L::TILE);
            if (MODE == 1 && j < src.n_lat) {
                const LAS float* brow = tab + (nw.dr0 + j) * 31 + 15 - nw.c;
#pragma unroll
                for (int r = 0; r < 16; ++r) { const int kj = crow(r, hi);
                    p0[r] = (kj >= nw.cs && kj < nw.cs + 16) ? fmaf(p0[r], C, brow[kj]) : -1e30f;
                    const int kj1 = 32 + kj;
                    p1[r] = (kj1 >= nw.cs && kj1 < nw.cs + 16) ? fmaf(p1[r], C, brow[kj1]) : -1e30f; }
                softmax_step<DV, false>(p0, p1, C, m_reg, l_reg, o, al_l, r32, hi, pa0, pa1, pa2, pa3);
            } else {
                softmax_step<DV, true>(p0, p1, C, m_reg, l_reg, o, al_l, r32, hi, pa0, pa1, pa2, pa3);
            }
            PROF_MARK(4);
            if (!skew) pv_pipe<DV>(o, vf0, vlane + cur * L::TILE, pa0, pa1, pa2, pa3);
            else pend = true;
            PROF_MARK(5);
        }
    }
    asm volatile("s_waitcnt vmcnt(0) lgkmcnt(0)" ::: "memory");
    __builtin_amdgcn_s_barrier();
    PROF_FLUSH(lds, wid, lane);
}
typedef __bf16 bf16x2_t __attribute__((ext_vector_type(2)));
typedef float f32x2_t __attribute__((ext_vector_type(2)));
__device__ __forceinline__ unsigned cvtpk_s(float lo, float hi) { f32x2_t v = {lo, hi}; bf16x2_t b = __builtin_convertvector(v, bf16x2_t); return __builtin_bit_cast(unsigned, b); }
#define PK4S(P, BASE, OUT) do { unsigned a0 = cvtpk_s(P[BASE + 0], P[BASE + 1]), a1 = cvtpk_s(P[BASE + 2], P[BASE + 3]);   \
    unsigned b0 = cvtpk_s(P[BASE + 4], P[BASE + 5]), b1 = cvtpk_s(P[BASE + 6], P[BASE + 7]);                              \
    auto r0 = __builtin_amdgcn_permlane32_swap(a0, b0, false, false); auto r1 = __builtin_amdgcn_permlane32_swap(a1, b1, false, false); \
    u32x4 w = {r0[0], r1[0], r0[1], r1[1]}; OUT = __builtin_bit_cast(bf16x8, w); } while (0)
#define SGB(mask, n) __builtin_amdgcn_sched_group_barrier(mask, n, 0)
struct SmState { float m, l; };
__device__ __forceinline__ float sm_decide(const f32x16& p0, const f32x16& p1, float C, float& m_reg) {
    float pmax = p0[0];
#pragma unroll
    for (int r = 1; r < 16; ++r) pmax = fmaxf(pmax, p0[r]);
#pragma unroll
    for (int r = 0; r < 16; ++r) pmax = fmaxf(pmax, p1[r]);
    pmax = half_swap_max(pmax) * C;
    const bool keep = __all(pmax - m_reg <= THR2);
    const float mn = keep ? m_reg : fmaxf(m_reg, pmax);
    const float alpha = __builtin_amdgcn_exp2f(m_reg - mn);
    m_reg = mn;
    return alpha;
}
template <int DQK, int DV, int ABL = 0, bool SKEW = true>
__device__ __forceinline__ void flash_loop2(LAS unsigned char* lds, const KVSrc& src, int nt, const bf16x8 (&qr)[DQK / 16], float C,
                                            f32x16 (&o)[DV / 32], float& l_out) {
    typedef LayD<DQK, DV> L;
    const int tid = opaque_tid(), wid = __builtin_amdgcn_readfirstlane(tid >> 6), lane = tid & 63, r32 = lane & 31, hi = lane >> 5;
    LAS float* al_l = (LAS float*)(lds + L::SCR_OFF) + wid * 64;
    const unsigned vlane = (unsigned)(uintptr_t)lds + (unsigned)L::V_OFF + (unsigned)v_rd_base(lane);
    Dma<DQK, DV> dma; dma.setup(src, wid, lane);
#pragma unroll
    for (int t = 0; t < 2; ++t) dma.issue(src, min(t, nt - 1), lds + t * L::TILE, wid);
    float m_reg = -1e30f, l_reg = 0.f;
    f32x16 pA0, pA1, pB0, pB1; float alA, alB; bf16x8 pa0, pa1, pa2, pa3;
#define WAITBAR_ISSUE(J) do { if constexpr (L::NI == 3) asm volatile("s_waitcnt vmcnt(3) lgkmcnt(0)" ::: "memory"); else asm volatile("s_waitcnt vmcnt(2) lgkmcnt(0)" ::: "memory"); \
        if constexpr (!(ABL & 16)) __builtin_amdgcn_s_barrier(); if constexpr (!(ABL & 8)) dma.issue(src, min((J) + 2, nt - 1), lds + (((J) + 2) & 3) * L::TILE, wid); } while (0)
#define KISSUE(KF, IMG, H) do { \
        if ((H) < 2) { const LAS unsigned char* kp_ = (IMG) + r32 * 128; const int sw_ = r32 & 7; \
            _Pragma("unroll") for (int dd = 0; dd < 2; ++dd) { const int off_ = ((((H) * 2 + dd) * 2 + hi) ^ sw_) << 4; KF[2 * dd] = *(const LAS bf16x8*)(kp_ + off_); KF[2 * dd + 1] = *(const LAS bf16x8*)(kp_ + 4096 + off_); } } \
        else { const LAS unsigned char* rp_ = (IMG) + 8192 + r32 * 64; const int sr_ = (r32 >> 2) & 3; \
            _Pragma("unroll") for (int dd = 0; dd < 2; ++dd) { const int off_ = ((dd * 2 + hi) ^ sr_) << 4; KF[2 * dd] = *(const LAS bf16x8*)(rp_ + off_); KF[2 * dd + 1] = *(const LAS bf16x8*)(rp_ + 2048 + off_); } } } while (0)
#define QK_MMA_H(KF, P0, P1, H) do { \
        _Pragma("unroll") for (int dd = 0; dd < 2; ++dd) { P0 = __builtin_amdgcn_mfma_f32_32x32x16_bf16(KF[2 * dd], qr[(H) * 2 + dd], P0, 0, 0, 0); P1 = __builtin_amdgcn_mfma_f32_32x32x16_bf16(KF[2 * dd + 1], qr[(H) * 2 + dd], P1, 0, 0, 0); } } while (0)
#define FIN1(P0, P1) do { _Pragma("unroll") for (int r = 0; r < 16; ++r) { P1[r] = __builtin_amdgcn_exp2f(P1[r]); } } while (0)
#define FIN2(P0, P1, AL) do { float ps_ = 0.f; \
        _Pragma("unroll") for (int r = 0; r < 16; ++r) { ps_ += P0[r]; } \
        _Pragma("unroll") for (int r = 0; r < 16; ++r) { ps_ += P1[r]; } \
        l_reg = l_reg * (AL) + half_swap_add(ps_); } while (0)
#define FIN3(P0, P1) do { PK4S(P0, 0, pa0); PK4S(P0, 8, pa1); PK4S(P1, 0, pa2); PK4S(P1, 8, pa3); } while (0)
#define FINISH_SM(P0, P1, AL) do { FIN1(P0, P1); FIN2(P0, P1, AL); FIN3(P0, P1); } while (0)
#define SGB4(k) do { SGB(0x8, 1); SGB(0x2, k); SGB(0x8, 1); SGB(0x2, k); SGB(0x8, 1); SGB(0x2, k); SGB(0x8, 1); SGB(0x2, k); } while (0)
#define AF1(O0, O1) do { if constexpr (!(ABL & 1)) FIN1(O0, O1); } while (0)
#define AF2(O0, O1, OAL) do { if constexpr (!(ABL & 1)) FIN2(O0, O1, OAL); } while (0)
#define SEG_QK(IMG, N0, N1) do { if constexpr (!(ABL & 4)) { bf16x8 kfA[4], kfB[4]; N0 = (f32x16){}; N1 = (f32x16){}; \
        KISSUE(kfA, IMG, 0); KISSUE(kfB, IMG, 1); LGKM_WAIT(4); __builtin_amdgcn_s_setprio(1); QK_MMA_H(kfA, N0, N1, 0); \
        if constexpr (DQK == 96) { KISSUE(kfA, IMG, 2); LGKM_WAIT(4); QK_MMA_H(kfB, N0, N1, 1); LGKM_WAIT(0); QK_MMA_H(kfA, N0, N1, 2); } \
        else { LGKM_WAIT(0); QK_MMA_H(kfB, N0, N1, 1); } __builtin_amdgcn_s_setprio(0); SBAR(); } } while (0)
#define SEG_QK_LEAN(IMG, N0, N1) do { if constexpr (!(ABL & 4)) { bf16x8 kfA[4]; N0 = (f32x16){}; N1 = (f32x16){}; \
        KISSUE(kfA, IMG, 0); LGKM_WAIT(0); __builtin_amdgcn_s_setprio(1); QK_MMA_H(kfA, N0, N1, 0); SBAR(); \
        KISSUE(kfA, IMG, 1); LGKM_WAIT(0); QK_MMA_H(kfA, N0, N1, 1); __builtin_amdgcn_s_setprio(0); SBAR(); } } while (0)
#define SEG_FIN(VB, O0, O1, OAL) do { if constexpr (!(ABL & 2) && DV == 64) v_issue<DV, 0>(vf0, VB); \
        if constexpr (!(ABL & 1)) { FIN1(O0, O1); FIN2(O0, O1, OAL); } \
        if constexpr (!(ABL & 2) && DV == 128) { SBAR(); v_issue<DV, 0>(vf0, VB); }     \
        FIN3(O0, O1); SBAR(); } while (0)
#define SEG_PV(VB) do { if constexpr (!(ABL & 2)) { const unsigned vb_ = (VB); LGKM_WAIT(0); v_issue<DV, 1>(vf1, vb_); v_mma(o[0], vf0, pa0, pa1, pa2, pa3); LGKM_WAIT(0); \
        if constexpr (DV == 128) { v_issue<DV, 2>(vf0, vb_); v_mma(o[1], vf1, pa0, pa1, pa2, pa3); LGKM_WAIT(0); v_issue<DV, 3>(vf1, vb_); v_mma(o[2], vf0, pa0, pa1, pa2, pa3); LGKM_WAIT(0); v_mma(o[3], vf1, pa0, pa1, pa2, pa3); } \
        else { v_mma(o[1], vf1, pa0, pa1, pa2, pa3); } SBAR(); } } while (0)
#define SEG_PART(X0, X1, XAL) do { XAL = 1.f; if constexpr (!(ABL & 1)) { XAL = sm_decide(X0, X1, C, m_reg); const float nm_ = -m_reg; \
        _Pragma("unroll") for (int r = 0; r < 16; ++r) { X0[r] = __builtin_amdgcn_exp2f(fmaf(X0[r], C, nm_)); X1[r] = fmaf(X1[r], C, nm_); } \
        RESC(XAL); } SBAR(); } while (0)
#define RESC(AL) do { if (__any((AL) < 1.f)) { if (hi == 0) al_l[r32] = (AL); asm volatile("s_waitcnt lgkmcnt(0)" ::: "memory"); \
        _Pragma("unroll") for (int r = 0; r < 16; ++r) { const float a_ = al_l[crow(r, hi)]; _Pragma("unroll") for (int d = 0; d < DV / 32; ++d) o[d][r] *= a_; } \
        asm volatile("s_waitcnt lgkmcnt(0)" ::: "memory"); } } while (0)
#define STEP(J, N0, N1, NAL, O0, O1, OAL) do { \
        if (!skew) WAITBAR_ISSUE(J); \
        { const unsigned vbp_ = vlane + (((J) - 1) & 3) * L::TILE; \
          SEG_QK(lds + ((J) & 3) * L::TILE, N0, N1); \
          SEG_FIN(vbp_, O0, O1, OAL); SEG_PV(vbp_); } \
        if (skew) WAITBAR_ISSUE((J) + 1); \
        SEG_PART(N0, N1, NAL); } while (0)
    VFrag vf0, vf1;
    const bool skew = SKEW && (wid >= 4);
    WAITBAR_ISSUE(0);
    SEG_QK(lds, pA0, pA1);
    if (skew) WAITBAR_ISSUE(1);
    SEG_PART(pA0, pA1, alA);
#pragma unroll 1
    for (int j = 1; j + 1 < nt; j += 2) {
        STEP(j, pB0, pB1, alB, pA0, pA1, alA);
        STEP(j + 1, pA0, pA1, alA, pB0, pB1, alB);
    }
    STEP(nt - 1, pB0, pB1, alB, pA0, pA1, alA);
    if (!skew) WAITBAR_ISSUE(nt);
    { const unsigned vbl_ = vlane + ((nt - 1) & 3) * L::TILE; SEG_FIN(vbl_, pB0, pB1, alB); SEG_PV(vbl_); }
    asm volatile("s_waitcnt vmcnt(0) lgkmcnt(0)" ::: "memory");
    __builtin_amdgcn_s_barrier();
    l_out = l_reg;
#undef WAITBAR_ISSUE
#undef KISSUE
#undef QK_MMA_H
#undef FIN1
#undef FIN2
#undef FIN3
#undef FINISH_SM
#undef SGB4
#undef AF1
#undef AF2
#undef SEG_QK
#undef SEG_QK_LEAN
#undef SEG_FIN
#undef SEG_PV
#undef SEG_PART
#undef RESC
#undef STEP
}
__device__ __forceinline__ void row_recips(float l_reg, LAS float* li_l, int r32, int hi, float (&rl)[16]) {
    if (hi == 0) li_l[r32] = l_reg;
    asm volatile("s_waitcnt lgkmcnt(0)" ::: "memory");
#pragma unroll
    for (int r = 0; r < 16; ++r) rl[r] = __builtin_amdgcn_rcpf(li_l[crow(r, hi)]);
    asm volatile("s_waitcnt lgkmcnt(0)" ::: "memory");
}
template <int DQK> __device__ __forceinline__ void load_q(bf16x8 (&qr)[DQK / 16], const bf16_t* qrow, int hi) {
#pragma unroll
    for (int d0 = 0; d0 < DQK / 16; ++d0) qr[d0] = *(const bf16x8*)(qrow + d0 * 16 + hi * 8);
}
template <int DV> constexpr int OROW = DV * 2 + 16;
template <int DV> __device__ __forceinline__ void stage_o(LAS unsigned char* wst, const f32x16 (&o)[DV / 32], const float (&sc)[16], int r32, int hi) {
#pragma unroll
    for (int r = 0; r < 16; ++r) { LAS unsigned char* rp = wst + crow(r, hi) * OROW<DV> + r32 * 2;
#pragma unroll
        for (int d = 0; d < DV / 32; ++d) *(LAS bf16_t*)(rp + d * 64) = (bf16_t)f2bf(o[d][r] * sc[r]); }
    asm volatile("s_waitcnt lgkmcnt(0)" ::: "memory");
}
template <int DV> __device__ __forceinline__ void store_rows(const LAS unsigned char* wst, bf16_t* O, int ldo, int row0, int col0, int lane) {
    constexpr int CPR = DV / 8;
#pragma unroll
    for (int i = 0; i < 32 * CPR / 64; ++i) { const int idx = i * 64 + lane, row = idx / CPR, ch = idx % CPR;
        const u32x4 v = *(const LAS u32x4*)(wst + row * OROW<DV> + ch * 16);
        *(u32x4*)(O + (size_t)(row0 + row) * ldo + col0 + ch * 8) = v; }
}

}
namespace att {
typedef short v4i16_t __attribute__((ext_vector_type(4)));
__device__ __forceinline__ s16x4 vtr(const LAS unsigned char* p) { return __builtin_bit_cast(s16x4, __builtin_amdgcn_ds_read_tr16_b64_v4i16((LAS v4i16_t*)p)); }
#define PIN(x) asm volatile("" : "+v"(x))
#define MFMA32(a, b, c) __builtin_amdgcn_mfma_f32_32x32x16_bf16(a, b, c, 0, 0, 0)
#define MX3(a, b, c) __builtin_fmaxf(__builtin_fmaxf((a), (b)), (c))
#define F3_THR 8.0f
__device__ __forceinline__ float rowmax3(const f32x16& p0, const f32x16& p1) {
    float a = MX3(p0[0], p0[1], p1[0]), b = MX3(p0[2], p0[3], p1[1]); a = MX3(a, p1[2], p1[3]);
#pragma unroll
    for (int r = 4; r < 16; r += 4) { a = MX3(a, p0[r], p0[r + 1]); b = MX3(b, p0[r + 2], p0[r + 3]); a = MX3(a, p1[r], p1[r + 1]); b = MX3(b, p1[r + 2], p1[r + 3]); }
    return half_swap_max(__builtin_fmaxf(a, b));
}
template <int DQK, int DV> struct LayE {
    static constexpr int KBYTES = 64 * DQK * 2, VB = 64 * DV * 2, V_OFF = KBYTES;
    static constexpr int NI = (KBYTES + VB + 8191) / 8192;
    static constexpr int TILE = NI * 8192, NB = 5;
    static constexpr int SCR_OFF = NB * TILE, TAB_OFF = SCR_OFF + 2048, END = TAB_OFF + 2048;
};
template <int DQK, int DV> struct Dma3 {
    typedef LayE<DQK, DV> L;
    unsigned voff[L::NI]; const char* base[L::NI]; unsigned rowb[L::NI];
    int row_lat0, n_lat, row_ctx0;
    __device__ __forceinline__ void setup(const KVSrc& s, int wid, int lane) {
        row_lat0 = s.row_lat0; n_lat = s.n_lat; row_ctx0 = s.row_ctx0;
#pragma unroll
        for (int i = 0; i < L::NI; ++i) {
            const int q = wid + 8 * i, Pw = q * 1024;
            if (Pw < L::KBYTES) {
                if (q < 8) { base[i] = (const char*)s.k0; rowb[i] = (unsigned)s.ldk0 * 2u; voff[i] = (unsigned)(lane * s.ldk0 + q * 8) * 2u; }
                else { base[i] = (const char*)s.k1; rowb[i] = (unsigned)s.ldk1 * 2u; voff[i] = (unsigned)(lane * s.ldk1 + (q - 8) * 8) * 2u; }
            } else {
                base[i] = (const char*)s.v; rowb[i] = (unsigned)s.ldv * 2u;
                int Pp = Pw + lane * 16 - L::V_OFF; if (Pp >= L::VB) Pp -= 4096;
                const int sub = Pp >> 9, within = Pp & 511, kkh = sub / (DV / 32), cb = sub % (DV / 32), kkl = within >> 6, cl = (within & 63) >> 1;
                const int key = kkh * 8 + kkl, c = cb * 32 + cl;
                voff[i] = (unsigned)(key * s.ldv + c) * 2u;
            }
        }
    }
    __device__ __forceinline__ void issue(int j, LAS unsigned char* buf, int wid) const {
        const unsigned row0 = (unsigned)((j < n_lat) ? row_lat0 + 64 * j : row_ctx0 + 64 * (j - n_lat));
#pragma unroll
        for (int i = 0; i < L::NI; ++i)
            dma16_asm(base[i] + (size_t)row0 * rowb[i] + voff[i], buf + (wid + 8 * i) * 1024);
    }
};
__device__ __forceinline__ void flash3_diff(LAS unsigned char* lds, const KVSrc& src, int nt, const bf16x8 (&qr)[4], float C, f32x16 (&o)[4], float& l_out) {
    typedef LayE<64, 128> L;
    const int tid = opaque_tid(), wid = __builtin_amdgcn_readfirstlane(tid >> 6), lane = tid & 63, r32 = lane & 31, hi = lane >> 5;
    Dma3<64, 128> dma; dma.setup(src, wid, lane);
    const LAS unsigned char* kb0 = lds + hi * 1024 + r32 * 16;
    const LAS unsigned char* vb0 = lds + L::V_OFF + v_rd_base(lane);
    dma.issue(0, lds, wid); dma.issue(min(1, nt - 1), lds + L::TILE, wid); dma.issue(min(2, nt - 1), lds + 2 * L::TILE, wid);
    float mhat = 0.f, l_reg = 0.f; bool resc = false; f32x16 negm;
    f32x16 c0, c1; bf16x8 kf[8]; u32x4 pa0, pa1, pa2, pa3, pb0, pb1, pb2, pb3; s16x4 vR0l, vR0h, vR1l, vR1h, vR2l, vR2h, vR3l, vR3h, vR4l, vR4h, vR5l, vR5h;
#define F3_WAITB2() do { if constexpr (L::NI == 3) asm volatile("s_waitcnt vmcnt(6) lgkmcnt(0)\n\ts_barrier" ::: "memory"); else asm volatile("s_waitcnt vmcnt(4) lgkmcnt(0)\n\ts_barrier" ::: "memory"); } while (0)
#define F3_WAITB1() do { if constexpr (L::NI == 3) asm volatile("s_waitcnt vmcnt(3) lgkmcnt(0)\n\ts_barrier" ::: "memory"); else asm volatile("s_waitcnt vmcnt(2) lgkmcnt(0)\n\ts_barrier" ::: "memory"); } while (0)
#define F3_KLOADR(KP, d0, sl) do { kf[2 * (sl)] = *(const LAS bf16x8*)((KP) + (d0) * 2048); kf[2 * (sl) + 1] = *(const LAS bf16x8*)((KP) + (d0) * 2048 + 512); } while (0)
#define F3_EX(v) __builtin_amdgcn_exp2f(v)
#define F3_BF(w) __builtin_bit_cast(bf16x8, w)
#define F3_VF(l, h) (bf16x8){l[0], l[1], l[2], l[3], h[0], h[1], h[2], h[3]}
#define F3_RESC() do { if (resc) { const int t2_ = opaque_tid(); const LAS float* ws2_ = (const LAS float*)(lds + L::SCR_OFF) + (t2_ >> 6) * 64; const int h2_ = (t2_ & 63) >> 5; _Pragma("unroll") for (int r = 0; r < 16; ++r) { const float a_ = ws2_[crow(r, h2_)]; _Pragma("unroll") for (int d = 0; d < 4; ++d) o[d][r] *= a_; } } } while (0)
    F3_WAITB2();
    { bf16x8 k0f[8];
      _Pragma("unroll") for (int d0 = 0; d0 < 4; ++d0) { k0f[2 * d0] = *(const LAS bf16x8*)(kb0 + d0 * 2048); k0f[2 * d0 + 1] = *(const LAS bf16x8*)(kb0 + d0 * 2048 + 512); }
      c0 = MFMA32(k0f[0], qr[0], (f32x16){}); c1 = MFMA32(k0f[1], qr[0], (f32x16){});
      c0 = MFMA32(k0f[2], qr[1], c0); c1 = MFMA32(k0f[3], qr[1], c1);
      c0 = MFMA32(k0f[4], qr[2], c0); c1 = MFMA32(k0f[5], qr[2], c1);
      c0 = MFMA32(k0f[6], qr[3], c0); c1 = MFMA32(k0f[7], qr[3], c1);
    }
    { const float rm = rowmax3(c0, c1); mhat = rm; const float nmh = -mhat; float sacc = 0.f;
      _Pragma("unroll") for (int r = 0; r < 16; ++r) { c0[r] = F3_EX(c0[r] + nmh); c1[r] = F3_EX(c1[r] + nmh); sacc += c0[r]; sacc += c1[r]; negm[r] = nmh; } PIN(negm);
      l_reg = sacc;
      pa0 = (u32x4){cvtpk_s(c0[0], c0[1]), cvtpk_s(c0[2], c0[3]), cvtpk_s(c0[4], c0[5]), cvtpk_s(c0[6], c0[7])}; pa1 = (u32x4){cvtpk_s(c0[8], c0[9]), cvtpk_s(c0[10], c0[11]), cvtpk_s(c0[12], c0[13]), cvtpk_s(c0[14], c0[15])};
      pa2 = (u32x4){cvtpk_s(c1[0], c1[1]), cvtpk_s(c1[2], c1[3]), cvtpk_s(c1[4], c1[5]), cvtpk_s(c1[6], c1[7])}; pa3 = (u32x4){cvtpk_s(c1[8], c1[9]), cvtpk_s(c1[10], c1[11]), cvtpk_s(c1[12], c1[13]), cvtpk_s(c1[14], c1[15])}; }
    dma.issue(min(3, nt - 1), lds + 3 * L::TILE, wid);
    F3_WAITB1();
    F3_KLOADR(kb0 + L::TILE, 0, 0); F3_KLOADR(kb0 + L::TILE, 1, 1); F3_KLOADR(kb0 + L::TILE, 2, 2); F3_KLOADR(kb0 + L::TILE, 3, 3);
#define F3_STEP(PO0, PO1, PO2, PO3, PN0, PN1, PN2, PN3, T) do { SBAR(); \
    const int sp_ = (((T) + 4) % 5) * L::TILE, sn_ = (((T) + 1) % 5) * L::TILE; \
    unsigned vpa_ = (unsigned)(uintptr_t)(vb0 + sp_), kna_ = (unsigned)(uintptr_t)(kb0 + sn_), kca_ = (unsigned)(uintptr_t)(kb0 + ((T) % 5) * L::TILE); asm volatile("" : "+v"(vpa_), "+v"(kna_), "+v"(kca_));     \
    const LAS unsigned char* vp_ = (const LAS unsigned char*)(uintptr_t)vpa_; const LAS unsigned char* kn_ = (const LAS unsigned char*)(uintptr_t)kna_; const LAS unsigned char* kc_ = (const LAS unsigned char*)(uintptr_t)kca_; \
    c0 = MFMA32(kf[0], qr[0], negm); SBAR(); \
    c1 = MFMA32(kf[1], qr[0], negm); SBAR(); \
    vR0l = vtr(vp_ + 0); vR0h = vtr(vp_ + 2048); c0 = MFMA32(kf[2], qr[1], c0); SBAR(); \
    vR1l = vtr(vp_ + 512); vR1h = vtr(vp_ + 2560); c1 = MFMA32(kf[3], qr[1], c1); SBAR(); \
    vR2l = vtr(vp_ + 1024); vR2h = vtr(vp_ + 3072); c0 = MFMA32(kf[4], qr[2], c0); SBAR(); \
    vR3l = vtr(vp_ + 1536); vR3h = vtr(vp_ + 3584); c1 = MFMA32(kf[5], qr[2], c1); SBAR(); \
    vR4l = vtr(vp_ + 4096); vR4h = vtr(vp_ + 6144); c0 = MFMA32(kf[6], qr[3], c0); SBAR(); \
    vR5l = vtr(vp_ + 4608); vR5h = vtr(vp_ + 6656); c1 = MFMA32(kf[7], qr[3], c1); SBAR(); \
    dma.issue(min((T) + 3, nt - 1), lds + (((T) + 3) % 5) * L::TILE, wid); \
    { const float rm = rowmax3(c0, c1); resc = false; \
      if (__builtin_expect(__any(rm > F3_THR), 0)) { const float dl = __builtin_fmaxf(rm, 0.f); mhat += dl; const float f_ = __builtin_amdgcn_exp2f(-dl); l_reg *= f_; { const int t2_ = opaque_tid(); if ((t2_ & 63) < 32) ((LAS float*)(lds + L::SCR_OFF))[(t2_ >> 6) * 64 + (t2_ & 63)] = f_; } resc = true; \
        _Pragma("unroll") for (int r = 0; r < 16; ++r) { c0[r] -= dl; c1[r] -= dl; negm[r] = -mhat; } PIN(negm); } } \
    float sacc = 0.f; SBAR(); \
    o[0] = MFMA32(F3_BF(PO0), F3_VF(vR0l, vR0h), o[0]); vR0l = vtr(vp_ + 5120); vR0h = vtr(vp_ + 7168); c0[0] = F3_EX(c0[0]); sacc += c0[0]; c0[1] = F3_EX(c0[1]); sacc += c0[1]; PN0[0] = cvtpk_s(c0[0], c0[1]); PIN(PN0); PIN(sacc); SBAR(); \
    F3_KLOADR(kn_, 0, 0); o[1] = MFMA32(F3_BF(PO0), F3_VF(vR1l, vR1h), o[1]); vR1l = vtr(vp_ + 5632); vR1h = vtr(vp_ + 7680); c0[2] = F3_EX(c0[2]); sacc += c0[2]; c0[3] = F3_EX(c0[3]); sacc += c0[3]; PN0[1] = cvtpk_s(c0[2], c0[3]); PIN(PN0); PIN(sacc); SBAR(); \
    o[2] = MFMA32(F3_BF(PO0), F3_VF(vR2l, vR2h), o[2]); vR2l = vtr(vp_ + 8192); vR2h = vtr(vp_ + 10240); c0[4] = F3_EX(c0[4]); sacc += c0[4]; c0[5] = F3_EX(c0[5]); sacc += c0[5]; PN0[2] = cvtpk_s(c0[4], c0[5]); PIN(PN0); PIN(sacc); SBAR(); \
    o[3] = MFMA32(F3_BF(PO0), F3_VF(vR3l, vR3h), o[3]); vR3l = vtr(vp_ + 8704); vR3h = vtr(vp_ + 10752); c0[6] = F3_EX(c0[6]); sacc += c0[6]; c0[7] = F3_EX(c0[7]); sacc += c0[7]; PN0[3] = cvtpk_s(c0[6], c0[7]); PIN(PN0); PIN(sacc); SBAR(); \
    o[0] = MFMA32(F3_BF(PO1), F3_VF(vR4l, vR4h), o[0]); vR4l = vtr(vp_ + 9216); vR4h = vtr(vp_ + 11264); c0[8] = F3_EX(c0[8]); sacc += c0[8]; c0[9] = F3_EX(c0[9]); sacc += c0[9]; PN1[0] = cvtpk_s(c0[8], c0[9]); PIN(PN1); PIN(sacc); SBAR(); \
    F3_KLOADR(kn_, 1, 1); o[1] = MFMA32(F3_BF(PO1), F3_VF(vR5l, vR5h), o[1]); vR5l = vtr(vp_ + 9728); vR5h = vtr(vp_ + 11776); c0[10] = F3_EX(c0[10]); sacc += c0[10]; c0[11] = F3_EX(c0[11]); sacc += c0[11]; PN1[1] = cvtpk_s(c0[10], c0[11]); PIN(PN1); PIN(sacc); SBAR(); \
    o[2] = MFMA32(F3_BF(PO1), F3_VF(vR0l, vR0h), o[2]); vR0l = vtr(vp_ + 12288); vR0h = vtr(vp_ + 14336); c0[12] = F3_EX(c0[12]); sacc += c0[12]; c0[13] = F3_EX(c0[13]); sacc += c0[13]; PN1[2] = cvtpk_s(c0[12], c0[13]); PIN(PN1); PIN(sacc); SBAR(); \
    o[3] = MFMA32(F3_BF(PO1), F3_VF(vR1l, vR1h), o[3]); vR1l = vtr(vp_ + 12800); vR1h = vtr(vp_ + 14848); c0[14] = F3_EX(c0[14]); sacc += c0[14]; c0[15] = F3_EX(c0[15]); sacc += c0[15]; PN1[3] = cvtpk_s(c0[14], c0[15]); PIN(PN1); PIN(sacc); SBAR(); \
    o[0] = MFMA32(F3_BF(PO2), F3_VF(vR2l, vR2h), o[0]); vR2l = vtr(vp_ + 13312); vR2h = vtr(vp_ + 15360); c1[0] = F3_EX(c1[0]); sacc += c1[0]; c1[1] = F3_EX(c1[1]); sacc += c1[1]; PN2[0] = cvtpk_s(c1[0], c1[1]); PIN(PN2); PIN(sacc); SBAR(); \
    F3_KLOADR(kn_, 2, 2); o[1] = MFMA32(F3_BF(PO2), F3_VF(vR3l, vR3h), o[1]); vR3l = vtr(vp_ + 13824); vR3h = vtr(vp_ + 15872); c1[2] = F3_EX(c1[2]); sacc += c1[2]; c1[3] = F3_EX(c1[3]); sacc += c1[3]; PN2[1] = cvtpk_s(c1[2], c1[3]); PIN(PN2); PIN(sacc); SBAR(); \
    o[2] = MFMA32(F3_BF(PO2), F3_VF(vR4l, vR4h), o[2]); c1[4] = F3_EX(c1[4]); sacc += c1[4]; c1[5] = F3_EX(c1[5]); sacc += c1[5]; PN2[2] = cvtpk_s(c1[4], c1[5]); PIN(PN2); PIN(sacc); SBAR(); \
    o[3] = MFMA32(F3_BF(PO2), F3_VF(vR5l, vR5h), o[3]); c1[6] = F3_EX(c1[6]); sacc += c1[6]; c1[7] = F3_EX(c1[7]); sacc += c1[7]; PN2[3] = cvtpk_s(c1[6], c1[7]); PIN(PN2); PIN(sacc); SBAR(); \
    o[0] = MFMA32(F3_BF(PO3), F3_VF(vR0l, vR0h), o[0]); c1[8] = F3_EX(c1[8]); sacc += c1[8]; c1[9] = F3_EX(c1[9]); sacc += c1[9]; PN3[0] = cvtpk_s(c1[8], c1[9]); PIN(PN3); PIN(sacc); SBAR(); \
    F3_KLOADR(kn_, 3, 3); o[1] = MFMA32(F3_BF(PO3), F3_VF(vR1l, vR1h), o[1]); c1[10] = F3_EX(c1[10]); sacc += c1[10]; c1[11] = F3_EX(c1[11]); sacc += c1[11]; PN3[1] = cvtpk_s(c1[10], c1[11]); PIN(PN3); PIN(sacc); SBAR(); \
    o[2] = MFMA32(F3_BF(PO3), F3_VF(vR2l, vR2h), o[2]); c1[12] = F3_EX(c1[12]); sacc += c1[12]; c1[13] = F3_EX(c1[13]); sacc += c1[13]; PN3[2] = cvtpk_s(c1[12], c1[13]); PIN(PN3); PIN(sacc); SBAR(); \
    o[3] = MFMA32(F3_BF(PO3), F3_VF(vR3l, vR3h), o[3]); c1[14] = F3_EX(c1[14]); sacc += c1[14]; c1[15] = F3_EX(c1[15]); sacc += c1[15]; PN3[3] = cvtpk_s(c1[14], c1[15]); PIN(PN3); PIN(sacc); SBAR(); \
    l_reg += sacc; \
    } while (0)
#pragma unroll 1
    for (int t = 1; t + 1 < nt; t += 2) {
        F3_STEP(pa0, pa1, pa2, pa3, pb0, pb1, pb2, pb3, t); F3_WAITB1(); F3_RESC();
        F3_STEP(pb0, pb1, pb2, pb3, pa0, pa1, pa2, pa3, t + 1); F3_WAITB1(); F3_RESC();
    }
    F3_STEP(pa0, pa1, pa2, pa3, pb0, pb1, pb2, pb3, nt - 1); F3_WAITB1(); F3_RESC();
    { const LAS unsigned char* vp_ = vb0 + ((nt - 1) % 5) * L::TILE;
      { const s16x4 l_ = vtr(vp_ + 0), h_ = vtr(vp_ + 2048); const bf16x8 vf_ = {l_[0], l_[1], l_[2], l_[3], h_[0], h_[1], h_[2], h_[3]}; o[0] = MFMA32(F3_BF(pb0), vf_, o[0]); }
      { const s16x4 l_ = vtr(vp_ + 512), h_ = vtr(vp_ + 2560); const bf16x8 vf_ = {l_[0], l_[1], l_[2], l_[3], h_[0], h_[1], h_[2], h_[3]}; o[1] = MFMA32(F3_BF(pb0), vf_, o[1]); }
      { const s16x4 l_ = vtr(vp_ + 1024), h_ = vtr(vp_ + 3072); const bf16x8 vf_ = {l_[0], l_[1], l_[2], l_[3], h_[0], h_[1], h_[2], h_[3]}; o[2] = MFMA32(F3_BF(pb0), vf_, o[2]); }
      { const s16x4 l_ = vtr(vp_ + 1536), h_ = vtr(vp_ + 3584); const bf16x8 vf_ = {l_[0], l_[1], l_[2], l_[3], h_[0], h_[1], h_[2], h_[3]}; o[3] = MFMA32(F3_BF(pb0), vf_, o[3]); }
      { const s16x4 l_ = vtr(vp_ + 4096), h_ = vtr(vp_ + 6144); const bf16x8 vf_ = {l_[0], l_[1], l_[2], l_[3], h_[0], h_[1], h_[2], h_[3]}; o[0] = MFMA32(F3_BF(pb1), vf_, o[0]); }
      { const s16x4 l_ = vtr(vp_ + 4608), h_ = vtr(vp_ + 6656); const bf16x8 vf_ = {l_[0], l_[1], l_[2], l_[3], h_[0], h_[1], h_[2], h_[3]}; o[1] = MFMA32(F3_BF(pb1), vf_, o[1]); }
      { const s16x4 l_ = vtr(vp_ + 5120), h_ = vtr(vp_ + 7168); const bf16x8 vf_ = {l_[0], l_[1], l_[2], l_[3], h_[0], h_[1], h_[2], h_[3]}; o[2] = MFMA32(F3_BF(pb1), vf_, o[2]); }
      { const s16x4 l_ = vtr(vp_ + 5632), h_ = vtr(vp_ + 7680); const bf16x8 vf_ = {l_[0], l_[1], l_[2], l_[3], h_[0], h_[1], h_[2], h_[3]}; o[3] = MFMA32(F3_BF(pb1), vf_, o[3]); }
      { const s16x4 l_ = vtr(vp_ + 8192), h_ = vtr(vp_ + 10240); const bf16x8 vf_ = {l_[0], l_[1], l_[2], l_[3], h_[0], h_[1], h_[2], h_[3]}; o[0] = MFMA32(F3_BF(pb2), vf_, o[0]); }
      { const s16x4 l_ = vtr(vp_ + 8704), h_ = vtr(vp_ + 10752); const bf16x8 vf_ = {l_[0], l_[1], l_[2], l_[3], h_[0], h_[1], h_[2], h_[3]}; o[1] = MFMA32(F3_BF(pb2), vf_, o[1]); }
      { const s16x4 l_ = vtr(vp_ + 9216), h_ = vtr(vp_ + 11264); const bf16x8 vf_ = {l_[0], l_[1], l_[2], l_[3], h_[0], h_[1], h_[2], h_[3]}; o[2] = MFMA32(F3_BF(pb2), vf_, o[2]); }
      { const s16x4 l_ = vtr(vp_ + 9728), h_ = vtr(vp_ + 11776); const bf16x8 vf_ = {l_[0], l_[1], l_[2], l_[3], h_[0], h_[1], h_[2], h_[3]}; o[3] = MFMA32(F3_BF(pb2), vf_, o[3]); }
      { const s16x4 l_ = vtr(vp_ + 12288), h_ = vtr(vp_ + 14336); const bf16x8 vf_ = {l_[0], l_[1], l_[2], l_[3], h_[0], h_[1], h_[2], h_[3]}; o[0] = MFMA32(F3_BF(pb3), vf_, o[0]); }
      { const s16x4 l_ = vtr(vp_ + 12800), h_ = vtr(vp_ + 14848); const bf16x8 vf_ = {l_[0], l_[1], l_[2], l_[3], h_[0], h_[1], h_[2], h_[3]}; o[1] = MFMA32(F3_BF(pb3), vf_, o[1]); }
      { const s16x4 l_ = vtr(vp_ + 13312), h_ = vtr(vp_ + 15360); const bf16x8 vf_ = {l_[0], l_[1], l_[2], l_[3], h_[0], h_[1], h_[2], h_[3]}; o[2] = MFMA32(F3_BF(pb3), vf_, o[2]); }
      { const s16x4 l_ = vtr(vp_ + 13824), h_ = vtr(vp_ + 15872); const bf16x8 vf_ = {l_[0], l_[1], l_[2], l_[3], h_[0], h_[1], h_[2], h_[3]}; o[3] = MFMA32(F3_BF(pb3), vf_, o[3]); }
    }
    l_reg = half_swap_add(l_reg);
    asm volatile("s_waitcnt vmcnt(0) lgkmcnt(0)\n\ts_barrier" ::: "memory");
    l_out = l_reg;
#undef F3_WAITB2
#undef F3_WAITB1
#undef F3_KLOADR
#undef F3_EX
#undef F3_BF
#undef F3_VF
#undef F3_RESC
#undef F3_STEP
}
__device__ __forceinline__ void flash3_mla(LAS unsigned char* lds, const KVSrc& src, int nt, const bf16x8 (&qr)[6], float C, f32x16 (&o)[2], float& l_out) {
    typedef LayE<96, 64> L;
    const int tid = opaque_tid(), wid = __builtin_amdgcn_readfirstlane(tid >> 6), lane = tid & 63, r32 = lane & 31, hi = lane >> 5;
    Dma3<96, 64> dma; dma.setup(src, wid, lane);
    const LAS unsigned char* kb0 = lds + hi * 1024 + r32 * 16;
    const LAS unsigned char* vb0 = lds + L::V_OFF + v_rd_base(lane);
    dma.issue(0, lds, wid); dma.issue(min(1, nt - 1), lds + L::TILE, wid); dma.issue(min(2, nt - 1), lds + 2 * L::TILE, wid);
    float mhat = 0.f, l_reg = 0.f; bool resc = false; f32x16 negm;
    f32x16 pA0, pA1, pB0, pB1; bf16x8 kf[12]; u32x4 pw0, pw1, pw2, pw3; s16x4 vlo[8], vhi[8];
#define F3_WAITB2() do { if constexpr (L::NI == 3) asm volatile("s_waitcnt vmcnt(6) lgkmcnt(0)\n\ts_barrier" ::: "memory"); else asm volatile("s_waitcnt vmcnt(4) lgkmcnt(0)\n\ts_barrier" ::: "memory"); } while (0)
#define F3_WAITB1() do { if constexpr (L::NI == 3) asm volatile("s_waitcnt vmcnt(3) lgkmcnt(0)\n\ts_barrier" ::: "memory"); else asm volatile("s_waitcnt vmcnt(2) lgkmcnt(0)\n\ts_barrier" ::: "memory"); } while (0)
#define F3_KLOAD2(KP, d0) do { kf[2 * (d0)] = *(const LAS bf16x8*)((KP) + (d0) * 2048); kf[2 * (d0) + 1] = *(const LAS bf16x8*)((KP) + (d0) * 2048 + 512); } while (0)
#define F3_EX(v) __builtin_amdgcn_exp2f(v)
#define F3_PK(P, i) cvtpk_s(P[i], P[i + 1])
#define F3_PAF(k) __builtin_bit_cast(bf16x8, pw##k)
#define F3_VF(i) (bf16x8){vlo[i][0], vlo[i][1], vlo[i][2], vlo[i][3], vhi[i][0], vhi[i][1], vhi[i][2], vhi[i][3]}
#define F3_RESC() do { if (resc) { const int t2_ = opaque_tid(); const LAS float* ws2_ = (const LAS float*)(lds + L::SCR_OFF) + (t2_ >> 6) * 64; const int h2_ = (t2_ & 63) >> 5; _Pragma("unroll") for (int r = 0; r < 16; ++r) { const float a_ = ws2_[crow(r, h2_)]; _Pragma("unroll") for (int d = 0; d < 2; ++d) o[d][r] *= a_; } } } while (0)
    F3_WAITB2();
    _Pragma("unroll") for (int d0 = 0; d0 < 6; ++d0) F3_KLOAD2(kb0, d0);
    pA0 = MFMA32(kf[0], qr[0], (f32x16){}); pA1 = MFMA32(kf[1], qr[0], (f32x16){});
    pA0 = MFMA32(kf[2], qr[1], pA0); pA1 = MFMA32(kf[3], qr[1], pA1);
    pA0 = MFMA32(kf[4], qr[2], pA0); pA1 = MFMA32(kf[5], qr[2], pA1);
    pA0 = MFMA32(kf[6], qr[3], pA0); pA1 = MFMA32(kf[7], qr[3], pA1);
    pA0 = MFMA32(kf[8], qr[4], pA0); pA1 = MFMA32(kf[9], qr[4], pA1);
    pA0 = MFMA32(kf[10], qr[5], pA0); pA1 = MFMA32(kf[11], qr[5], pA1);
    { const float rm = rowmax3(pA0, pA1); mhat = rm; const float nmh = -mhat;
      _Pragma("unroll") for (int r = 0; r < 16; ++r) { pA0[r] = F3_EX(pA0[r] + nmh); pA1[r] = F3_EX(pA1[r] + nmh); negm[r] = nmh; } PIN(negm); }
    dma.issue(min(3, nt - 1), lds + 3 * L::TILE, wid);
    F3_WAITB1();
    _Pragma("unroll") for (int d0 = 0; d0 < 6; ++d0) F3_KLOAD2(kb0 + L::TILE, d0);
#define F3_STEP(C0, C1, P0, P1, T) do { SBAR(); \
    const int sp_ = (((T) + 4) % 5) * L::TILE, sn_ = (((T) + 1) % 5) * L::TILE; \
    const LAS unsigned char* vp_ = vb0 + sp_; const LAS unsigned char* kn_ = kb0 + sn_; \
    float sacc = P0[0] + P0[1]; \
    vlo[0] = vtr(vp_ + 0); vhi[0] = vtr(vp_ + 1024); SBAR(); C0 = MFMA32(kf[0], qr[0], negm); sacc += P0[2]; sacc += P0[3]; sacc += P0[4]; sacc += P0[5]; pw0[0] = F3_PK(P0, 0); pw0[1] = F3_PK(P0, 2); PIN(pw0); PIN(sacc); SBAR(); \
    vlo[4] = vtr(vp_ + 512); vhi[4] = vtr(vp_ + 1536); SBAR(); C1 = MFMA32(kf[1], qr[0], negm); sacc += P0[6]; sacc += P0[7]; sacc += P0[8]; sacc += P0[9]; pw0[2] = F3_PK(P0, 4); pw0[3] = F3_PK(P0, 6); PIN(pw0); PIN(sacc); SBAR(); \
    vlo[1] = vtr(vp_ + 2048); vhi[1] = vtr(vp_ + 3072); SBAR(); C0 = MFMA32(kf[2], qr[1], C0); sacc += P0[10]; sacc += P0[11]; sacc += P0[12]; sacc += P0[13]; pw1[0] = F3_PK(P0, 8); pw1[1] = F3_PK(P0, 10); PIN(pw1); PIN(sacc); SBAR(); \
    vlo[5] = vtr(vp_ + 2560); vhi[5] = vtr(vp_ + 3584); SBAR(); C1 = MFMA32(kf[3], qr[1], C1); sacc += P0[14]; sacc += P0[15]; sacc += P1[0]; sacc += P1[1]; pw1[2] = F3_PK(P0, 12); pw1[3] = F3_PK(P0, 14); PIN(pw1); PIN(sacc); SBAR(); \
    vlo[2] = vtr(vp_ + 4096); vhi[2] = vtr(vp_ + 5120); SBAR(); C0 = MFMA32(kf[4], qr[2], C0); sacc += P1[2]; sacc += P1[3]; sacc += P1[4]; sacc += P1[5]; pw2[0] = F3_PK(P1, 0); pw2[1] = F3_PK(P1, 2); PIN(pw2); PIN(sacc); SBAR(); \
    vlo[6] = vtr(vp_ + 4608); vhi[6] = vtr(vp_ + 5632); SBAR(); C1 = MFMA32(kf[5], qr[2], C1); sacc += P1[6]; sacc += P1[7]; sacc += P1[8]; sacc += P1[9]; pw2[2] = F3_PK(P1, 4); pw2[3] = F3_PK(P1, 6); PIN(pw2); PIN(sacc); SBAR(); \
    vlo[3] = vtr(vp_ + 6144); vhi[3] = vtr(vp_ + 7168); SBAR(); C0 = MFMA32(kf[6], qr[3], C0); sacc += P1[10]; sacc += P1[11]; sacc += P1[12]; sacc += P1[13]; pw3[0] = F3_PK(P1, 8); pw3[1] = F3_PK(P1, 10); PIN(pw3); PIN(sacc); SBAR(); \
    vlo[7] = vtr(vp_ + 6656); vhi[7] = vtr(vp_ + 7680); SBAR(); C1 = MFMA32(kf[7], qr[3], C1); sacc += P1[14]; sacc += P1[15]; pw3[2] = F3_PK(P1, 12); pw3[3] = F3_PK(P1, 14); PIN(pw3); PIN(sacc); SBAR(); \
    C0 = MFMA32(kf[8], qr[4], C0); SBAR(); \
    C1 = MFMA32(kf[9], qr[4], C1); SBAR(); \
    C0 = MFMA32(kf[10], qr[5], C0); SBAR(); \
    C1 = MFMA32(kf[11], qr[5], C1); SBAR(); \
    l_reg += sacc; \
    dma.issue(min((T) + 3, nt - 1), lds + (((T) + 3) % 5) * L::TILE, wid); \
    { const float rm = rowmax3(C0, C1); resc = false; \
      if (__builtin_expect(__any(rm > F3_THR), 0)) { const float dl = __builtin_fmaxf(rm, 0.f); mhat += dl; const float f_ = __builtin_amdgcn_exp2f(-dl); l_reg *= f_; { const int t2_ = opaque_tid(); if ((t2_ & 63) < 32) ((LAS float*)(lds + L::SCR_OFF))[(t2_ >> 6) * 64 + (t2_ & 63)] = f_; } resc = true; \
        _Pragma("unroll") for (int r = 0; r < 16; ++r) { C0[r] -= dl; C1[r] -= dl; negm[r] = -mhat; } PIN(negm); } } \
    SBAR(); \
    o[0] = MFMA32(F3_PAF(0), F3_VF(0), o[0]); C0[0] = F3_EX(C0[0]); C0[1] = F3_EX(C0[1]); C0[2] = F3_EX(C0[2]); C0[3] = F3_EX(C0[3]); PIN(C0); SBAR(); \
    F3_KLOAD2(kn_, 0); SBAR(); o[1] = MFMA32(F3_PAF(0), F3_VF(4), o[1]); C0[4] = F3_EX(C0[4]); C0[5] = F3_EX(C0[5]); C0[6] = F3_EX(C0[6]); C0[7] = F3_EX(C0[7]); PIN(C0); SBAR(); \
    F3_KLOAD2(kn_, 1); SBAR(); o[0] = MFMA32(F3_PAF(1), F3_VF(1), o[0]); C0[8] = F3_EX(C0[8]); C0[9] = F3_EX(C0[9]); C0[10] = F3_EX(C0[10]); C0[11] = F3_EX(C0[11]); PIN(C0); SBAR(); \
    F3_KLOAD2(kn_, 2); SBAR(); o[1] = MFMA32(F3_PAF(1), F3_VF(5), o[1]); C0[12] = F3_EX(C0[12]); C0[13] = F3_EX(C0[13]); C0[14] = F3_EX(C0[14]); C0[15] = F3_EX(C0[15]); PIN(C0); SBAR(); \
    F3_KLOAD2(kn_, 3); SBAR(); o[0] = MFMA32(F3_PAF(2), F3_VF(2), o[0]); C1[0] = F3_EX(C1[0]); C1[1] = F3_EX(C1[1]); C1[2] = F3_EX(C1[2]); C1[3] = F3_EX(C1[3]); PIN(C1); SBAR(); \
    F3_KLOAD2(kn_, 4); SBAR(); o[1] = MFMA32(F3_PAF(2), F3_VF(6), o[1]); C1[4] = F3_EX(C1[4]); C1[5] = F3_EX(C1[5]); C1[6] = F3_EX(C1[6]); C1[7] = F3_EX(C1[7]); PIN(C1); SBAR(); \
    F3_KLOAD2(kn_, 5); SBAR(); o[0] = MFMA32(F3_PAF(3), F3_VF(3), o[0]); C1[8] = F3_EX(C1[8]); C1[9] = F3_EX(C1[9]); C1[10] = F3_EX(C1[10]); C1[11] = F3_EX(C1[11]); PIN(C1); SBAR(); \
    o[1] = MFMA32(F3_PAF(3), F3_VF(7), o[1]); C1[12] = F3_EX(C1[12]); C1[13] = F3_EX(C1[13]); C1[14] = F3_EX(C1[14]); C1[15] = F3_EX(C1[15]); PIN(C1); SBAR(); \
    } while (0)
#pragma unroll 1
    for (int t = 1; t + 1 < nt; t += 2) {
        F3_STEP(pB0, pB1, pA0, pA1, t); F3_WAITB1(); F3_RESC();
        F3_STEP(pA0, pA1, pB0, pB1, t + 1); F3_WAITB1(); F3_RESC();
    }
    F3_STEP(pB0, pB1, pA0, pA1, nt - 1); F3_WAITB1(); F3_RESC();
    { float sacc = pB0[0] + pB0[1];
      _Pragma("unroll") for (int r = 2; r < 16; ++r) sacc += pB0[r];
      _Pragma("unroll") for (int r = 0; r < 16; ++r) sacc += pB1[r];
      l_reg += sacc;
      pw0 = (u32x4){F3_PK(pB0, 0), F3_PK(pB0, 2), F3_PK(pB0, 4), F3_PK(pB0, 6)}; pw1 = (u32x4){F3_PK(pB0, 8), F3_PK(pB0, 10), F3_PK(pB0, 12), F3_PK(pB0, 14)};
      pw2 = (u32x4){F3_PK(pB1, 0), F3_PK(pB1, 2), F3_PK(pB1, 4), F3_PK(pB1, 6)}; pw3 = (u32x4){F3_PK(pB1, 8), F3_PK(pB1, 10), F3_PK(pB1, 12), F3_PK(pB1, 14)};
      const LAS unsigned char* vp_ = vb0 + ((nt - 1) % 5) * L::TILE;
      { const s16x4 l_ = vtr(vp_ + 0), h_ = vtr(vp_ + 1024); const bf16x8 vf_ = {l_[0], l_[1], l_[2], l_[3], h_[0], h_[1], h_[2], h_[3]}; o[0] = MFMA32(F3_PAF(0), vf_, o[0]); }
      { const s16x4 l_ = vtr(vp_ + 2048), h_ = vtr(vp_ + 3072); const bf16x8 vf_ = {l_[0], l_[1], l_[2], l_[3], h_[0], h_[1], h_[2], h_[3]}; o[0] = MFMA32(F3_PAF(1), vf_, o[0]); }
      { const s16x4 l_ = vtr(vp_ + 4096), h_ = vtr(vp_ + 5120); const bf16x8 vf_ = {l_[0], l_[1], l_[2], l_[3], h_[0], h_[1], h_[2], h_[3]}; o[0] = MFMA32(F3_PAF(2), vf_, o[0]); }
      { const s16x4 l_ = vtr(vp_ + 6144), h_ = vtr(vp_ + 7168); const bf16x8 vf_ = {l_[0], l_[1], l_[2], l_[3], h_[0], h_[1], h_[2], h_[3]}; o[0] = MFMA32(F3_PAF(3), vf_, o[0]); }
      { const s16x4 l_ = vtr(vp_ + 512), h_ = vtr(vp_ + 1536); const bf16x8 vf_ = {l_[0], l_[1], l_[2], l_[3], h_[0], h_[1], h_[2], h_[3]}; o[1] = MFMA32(F3_PAF(0), vf_, o[1]); }
      { const s16x4 l_ = vtr(vp_ + 2560), h_ = vtr(vp_ + 3584); const bf16x8 vf_ = {l_[0], l_[1], l_[2], l_[3], h_[0], h_[1], h_[2], h_[3]}; o[1] = MFMA32(F3_PAF(1), vf_, o[1]); }
      { const s16x4 l_ = vtr(vp_ + 4608), h_ = vtr(vp_ + 5632); const bf16x8 vf_ = {l_[0], l_[1], l_[2], l_[3], h_[0], h_[1], h_[2], h_[3]}; o[1] = MFMA32(F3_PAF(2), vf_, o[1]); }
      { const s16x4 l_ = vtr(vp_ + 6656), h_ = vtr(vp_ + 7680); const bf16x8 vf_ = {l_[0], l_[1], l_[2], l_[3], h_[0], h_[1], h_[2], h_[3]}; o[1] = MFMA32(F3_PAF(3), vf_, o[1]); }
    }
    l_reg = half_swap_add(l_reg);
    asm volatile("s_waitcnt vmcnt(0) lgkmcnt(0)\n\ts_barrier" ::: "memory");
    l_out = l_reg;
#undef F3_WAITB2
#undef F3_WAITB1
#undef F3_KLOAD2
#undef F3_EX
#undef F3_PK
#undef F3_PAF
#undef F3_VF
#undef F3_RESC
#undef F3_STEP
}
__device__ __forceinline__ void flash3_na(LAS unsigned char* lds, const KVSrc& src, int nt, const bf16x8 (&qr)[4], float C, f32x16 (&o)[2], float& l_out, const LAS float* tab, const NaWave& nw) {
    typedef LayE<64, 64> L;
    const int tid = opaque_tid(), wid = __builtin_amdgcn_readfirstlane(tid >> 6), lane = tid & 63, r32 = lane & 31, hi = lane >> 5;
    Dma3<64, 64> dma; dma.setup(src, wid, lane);
    const LAS unsigned char* kb0 = lds + hi * 1024 + r32 * 16;
    const LAS unsigned char* vb0 = lds + L::V_OFF + v_rd_base(lane);
    dma.issue(0, lds, wid); dma.issue(min(1, nt - 1), lds + L::TILE, wid); dma.issue(min(2, nt - 1), lds + 2 * L::TILE, wid);
    float mhat = 0.f, l_reg = 0.f; bool resc = false; f32x16 negm;
    f32x16 pA0, pA1, pB0, pB1; bf16x8 kf[8]; u32x4 pw0, pw1, pw2, pw3; s16x4 vlo[8], vhi[8];
#define F3_WAITB2() do { if constexpr (L::NI == 3) asm volatile("s_waitcnt vmcnt(6) lgkmcnt(0)\n\ts_barrier" ::: "memory"); else asm volatile("s_waitcnt vmcnt(4) lgkmcnt(0)\n\ts_barrier" ::: "memory"); } while (0)
#define F3_WAITB1() do { if constexpr (L::NI == 3) asm volatile("s_waitcnt vmcnt(3) lgkmcnt(0)\n\ts_barrier" ::: "memory"); else asm volatile("s_waitcnt vmcnt(2) lgkmcnt(0)\n\ts_barrier" ::: "memory"); } while (0)
#define F3_KLOAD2(KP, d0) do { kf[2 * (d0)] = *(const LAS bf16x8*)((KP) + (d0) * 2048); kf[2 * (d0) + 1] = *(const LAS bf16x8*)((KP) + (d0) * 2048 + 512); } while (0)
#define F3_EX(v) __builtin_amdgcn_exp2f(v)
#define F3_PK(P, i) cvtpk_s(P[i], P[i + 1])
#define F3_PAF(k) __builtin_bit_cast(bf16x8, pw##k)
#define F3_VF(i) (bf16x8){vlo[i][0], vlo[i][1], vlo[i][2], vlo[i][3], vhi[i][0], vhi[i][1], vhi[i][2], vhi[i][3]}
#define F3_RESC() do { if (resc) { const int t2_ = opaque_tid(); const LAS float* ws2_ = (const LAS float*)(lds + L::SCR_OFF) + (t2_ >> 6) * 64; const int h2_ = (t2_ & 63) >> 5; _Pragma("unroll") for (int r = 0; r < 16; ++r) { const float a_ = ws2_[crow(r, h2_)]; _Pragma("unroll") for (int d = 0; d < 2; ++d) o[d][r] *= a_; } } } while (0)
    f32x16 negm1;
#define NA_BIAS(CA, CB, T) do { if ((T) >= nw.active_lo && (T) <= nw.active_hi) { const LAS float* bl_ = tab + (nw.dr0 + (T)) * 31 + 15 - nw.c + 4 * hi; \
        float ba_[16], bb_[16]; _Pragma("unroll") for (int r = 0; r < 16; ++r) { ba_[r] = bl_[8 * (r >> 2) + (r & 3)]; bb_[r] = bl_[32 + 8 * (r >> 2) + (r & 3)]; } \
        _Pragma("unroll") for (int r = 0; r < 16; ++r) asm volatile("" : "+v"(ba_[r]), "+v"(bb_[r])); \
        _Pragma("unroll") for (int r = 0; r < 16; ++r) { CA[r] += ba_[r]; CB[r] += bb_[r]; } \
      } else { _Pragma("unroll") for (int r = 0; r < 16; ++r) { CA[r] = -1e30f; CB[r] = -1e30f; } } } while (0)
    F3_WAITB2();
    _Pragma("unroll") for (int d0 = 0; d0 < 4; ++d0) F3_KLOAD2(kb0, d0);
    pA0 = MFMA32(kf[0], qr[0], (f32x16){}); pA1 = MFMA32(kf[1], qr[0], (f32x16){});
    pA0 = MFMA32(kf[2], qr[1], pA0); pA1 = MFMA32(kf[3], qr[1], pA1);
    pA0 = MFMA32(kf[4], qr[2], pA0); pA1 = MFMA32(kf[5], qr[2], pA1);
    pA0 = MFMA32(kf[6], qr[3], pA0); pA1 = MFMA32(kf[7], qr[3], pA1);
    { const int xb_ = 4 * hi - nw.cs;
      _Pragma("unroll") for (int r = 0; r < 16; ++r) { const int k_ = 8 * (r >> 2) + (r & 3); negm[r] = ((unsigned)(xb_ + k_) < 16u) ? 0.f : -1e30f; negm1[r] = ((unsigned)(xb_ + 32 + k_) < 16u) ? 0.f : -1e30f; pA0[r] += negm[r]; pA1[r] += negm1[r]; } }
    NA_BIAS(pA0, pA1, 0);
    { const float rm = rowmax3(pA0, pA1); mhat = (rm < -1e29f) ? 0.f : rm; const float nmh = -mhat;
      _Pragma("unroll") for (int r = 0; r < 16; ++r) { pA0[r] = F3_EX(pA0[r] + nmh); pA1[r] = F3_EX(pA1[r] + nmh); negm[r] += nmh; negm1[r] += nmh; } PIN(negm); PIN(negm1); }
    dma.issue(min(3, nt - 1), lds + 3 * L::TILE, wid);
    F3_WAITB1();
    _Pragma("unroll") for (int d0 = 0; d0 < 4; ++d0) F3_KLOAD2(kb0 + L::TILE, d0);
#define F3_STEPL(C0, C1, P0, P1, T) do { SBAR(); \
    const int sp_ = (((T) + 4) % 5) * L::TILE, sn_ = (((T) + 1) % 5) * L::TILE; \
    unsigned vpa_ = (unsigned)(uintptr_t)(vb0 + sp_), kna_ = (unsigned)(uintptr_t)(kb0 + sn_); asm volatile("" : "+v"(vpa_), "+v"(kna_));     \
    const LAS unsigned char* vp_ = (const LAS unsigned char*)(uintptr_t)vpa_; const LAS unsigned char* kn_ = (const LAS unsigned char*)(uintptr_t)kna_; \
    float sacc = P0[0] + P0[1]; \
    vlo[0] = vtr(vp_ + 0); vhi[0] = vtr(vp_ + 1024); SBAR(); C0 = MFMA32(kf[0], qr[0], negm); sacc += P0[2]; sacc += P0[3]; sacc += P0[4]; sacc += P0[5]; pw0[0] = F3_PK(P0, 0); pw0[1] = F3_PK(P0, 2); PIN(pw0); PIN(sacc); SBAR(); \
    vlo[4] = vtr(vp_ + 512); vhi[4] = vtr(vp_ + 1536); SBAR(); C1 = MFMA32(kf[1], qr[0], negm1); sacc += P0[6]; sacc += P0[7]; sacc += P0[8]; sacc += P0[9]; pw0[2] = F3_PK(P0, 4); pw0[3] = F3_PK(P0, 6); PIN(pw0); PIN(sacc); SBAR(); \
    vlo[1] = vtr(vp_ + 2048); vhi[1] = vtr(vp_ + 3072); SBAR(); C0 = MFMA32(kf[2], qr[1], C0); sacc += P0[10]; sacc += P0[11]; sacc += P0[12]; sacc += P0[13]; pw1[0] = F3_PK(P0, 8); pw1[1] = F3_PK(P0, 10); PIN(pw1); PIN(sacc); SBAR(); \
    vlo[5] = vtr(vp_ + 2560); vhi[5] = vtr(vp_ + 3584); SBAR(); C1 = MFMA32(kf[3], qr[1], C1); sacc += P0[14]; sacc += P0[15]; sacc += P1[0]; sacc += P1[1]; pw1[2] = F3_PK(P0, 12); pw1[3] = F3_PK(P0, 14); PIN(pw1); PIN(sacc); SBAR(); \
    vlo[2] = vtr(vp_ + 4096); vhi[2] = vtr(vp_ + 5120); SBAR(); C0 = MFMA32(kf[4], qr[2], C0); sacc += P1[2]; sacc += P1[3]; sacc += P1[4]; sacc += P1[5]; pw2[0] = F3_PK(P1, 0); pw2[1] = F3_PK(P1, 2); PIN(pw2); PIN(sacc); SBAR(); \
    vlo[6] = vtr(vp_ + 4608); vhi[6] = vtr(vp_ + 5632); SBAR(); C1 = MFMA32(kf[5], qr[2], C1); sacc += P1[6]; sacc += P1[7]; sacc += P1[8]; sacc += P1[9]; pw2[2] = F3_PK(P1, 4); pw2[3] = F3_PK(P1, 6); PIN(pw2); PIN(sacc); SBAR(); \
    vlo[3] = vtr(vp_ + 6144); vhi[3] = vtr(vp_ + 7168); SBAR(); C0 = MFMA32(kf[6], qr[3], C0); sacc += P1[10]; sacc += P1[11]; sacc += P1[12]; sacc += P1[13]; pw3[0] = F3_PK(P1, 8); pw3[1] = F3_PK(P1, 10); PIN(pw3); PIN(sacc); SBAR(); \
    vlo[7] = vtr(vp_ + 6656); vhi[7] = vtr(vp_ + 7680); SBAR(); C1 = MFMA32(kf[7], qr[3], C1); sacc += P1[14]; sacc += P1[15]; pw3[2] = F3_PK(P1, 12); pw3[3] = F3_PK(P1, 14); PIN(pw3); PIN(sacc); SBAR(); \
    l_reg += sacc; \
    dma.issue(min((T) + 3, nt - 1), lds + (((T) + 3) % 5) * L::TILE, wid); \
    NA_BIAS(C0, C1, T); \
    { const float rm = rowmax3(C0, C1); resc = false; \
      if (__builtin_expect(__any(rm > F3_THR), 0)) { const float dl = __builtin_fmaxf(rm, 0.f); mhat += dl; const float f_ = __builtin_amdgcn_exp2f(-dl); l_reg *= f_; { const int t2_ = opaque_tid(); if ((t2_ & 63) < 32) ((LAS float*)(lds + L::SCR_OFF))[(t2_ >> 6) * 64 + (t2_ & 63)] = f_; } resc = true; \
        _Pragma("unroll") for (int r = 0; r < 16; ++r) { C0[r] -= dl; C1[r] -= dl; negm[r] -= dl; negm1[r] -= dl; } PIN(negm); PIN(negm1); } } \
    SBAR(); \
    o[0] = MFMA32(F3_PAF(0), F3_VF(0), o[0]); C0[0] = F3_EX(C0[0]); C0[1] = F3_EX(C0[1]); C0[2] = F3_EX(C0[2]); C0[3] = F3_EX(C0[3]); PIN(C0); SBAR(); \
    o[1] = MFMA32(F3_PAF(0), F3_VF(4), o[1]); C0[4] = F3_EX(C0[4]); C0[5] = F3_EX(C0[5]); C0[6] = F3_EX(C0[6]); C0[7] = F3_EX(C0[7]); PIN(C0); SBAR(); \
    F3_KLOAD2(kn_, 0); SBAR(); o[0] = MFMA32(F3_PAF(1), F3_VF(1), o[0]); C0[8] = F3_EX(C0[8]); C0[9] = F3_EX(C0[9]); C0[10] = F3_EX(C0[10]); C0[11] = F3_EX(C0[11]); PIN(C0); SBAR(); \
    F3_KLOAD2(kn_, 1); SBAR(); o[1] = MFMA32(F3_PAF(1), F3_VF(5), o[1]); C0[12] = F3_EX(C0[12]); C0[13] = F3_EX(C0[13]); C0[14] = F3_EX(C0[14]); C0[15] = F3_EX(C0[15]); PIN(C0); SBAR(); \
    F3_KLOAD2(kn_, 2); SBAR(); o[0] = MFMA32(F3_PAF(2), F3_VF(2), o[0]); C1[0] = F3_EX(C1[0]); C1[1] = F3_EX(C1[1]); C1[2] = F3_EX(C1[2]); C1[3] = F3_EX(C1[3]); PIN(C1); SBAR(); \
    F3_KLOAD2(kn_, 3); SBAR(); o[1] = MFMA32(F3_PAF(2), F3_VF(6), o[1]); C1[4] = F3_EX(C1[4]); C1[5] = F3_EX(C1[5]); C1[6] = F3_EX(C1[6]); C1[7] = F3_EX(C1[7]); PIN(C1); SBAR(); \
    o[0] = MFMA32(F3_PAF(3), F3_VF(3), o[0]); C1[8] = F3_EX(C1[8]); C1[9] = F3_EX(C1[9]); C1[10] = F3_EX(C1[10]); C1[11] = F3_EX(C1[11]); PIN(C1); SBAR(); \
    o[1] = MFMA32(F3_PAF(3), F3_VF(7), o[1]); C1[12] = F3_EX(C1[12]); C1[13] = F3_EX(C1[13]); C1[14] = F3_EX(C1[14]); C1[15] = F3_EX(C1[15]); PIN(C1); SBAR(); \
    } while (0)
#define F3_STEPC(C0, C1, P0, P1, T) do { SBAR(); \
    const int sp_ = (((T) + 4) % 5) * L::TILE, sn_ = (((T) + 1) % 5) * L::TILE; \
    unsigned vpa_ = (unsigned)(uintptr_t)(vb0 + sp_), kna_ = (unsigned)(uintptr_t)(kb0 + sn_); asm volatile("" : "+v"(vpa_), "+v"(kna_));     \
    const LAS unsigned char* vp_ = (const LAS unsigned char*)(uintptr_t)vpa_; const LAS unsigned char* kn_ = (const LAS unsigned char*)(uintptr_t)kna_; \
    float sacc = P0[0] + P0[1]; \
    vlo[0] = vtr(vp_ + 0); vhi[0] = vtr(vp_ + 1024); SBAR(); C0 = MFMA32(kf[0], qr[0], (f32x16){}); sacc += P0[2]; sacc += P0[3]; sacc += P0[4]; sacc += P0[5]; pw0[0] = F3_PK(P0, 0); pw0[1] = F3_PK(P0, 2); PIN(pw0); PIN(sacc); SBAR(); \
    vlo[4] = vtr(vp_ + 512); vhi[4] = vtr(vp_ + 1536); SBAR(); C1 = MFMA32(kf[1], qr[0], (f32x16){}); sacc += P0[6]; sacc += P0[7]; sacc += P0[8]; sacc += P0[9]; pw0[2] = F3_PK(P0, 4); pw0[3] = F3_PK(P0, 6); PIN(pw0); PIN(sacc); SBAR(); \
    vlo[1] = vtr(vp_ + 2048); vhi[1] = vtr(vp_ + 3072); SBAR(); C0 = MFMA32(kf[2], qr[1], C0); sacc += P0[10]; sacc += P0[11]; sacc += P0[12]; sacc += P0[13]; pw1[0] = F3_PK(P0, 8); pw1[1] = F3_PK(P0, 10); PIN(pw1); PIN(sacc); SBAR(); \
    vlo[5] = vtr(vp_ + 2560); vhi[5] = vtr(vp_ + 3584); SBAR(); C1 = MFMA32(kf[3], qr[1], C1); sacc += P0[14]; sacc += P0[15]; sacc += P1[0]; sacc += P1[1]; pw1[2] = F3_PK(P0, 12); pw1[3] = F3_PK(P0, 14); PIN(pw1); PIN(sacc); SBAR(); \
    vlo[2] = vtr(vp_ + 4096); vhi[2] = vtr(vp_ + 5120); SBAR(); C0 = MFMA32(kf[4], qr[2], C0); sacc += P1[2]; sacc += P1[3]; sacc += P1[4]; sacc += P1[5]; pw2[0] = F3_PK(P1, 0); pw2[1] = F3_PK(P1, 2); PIN(pw2); PIN(sacc); SBAR(); \
    vlo[6] = vtr(vp_ + 4608); vhi[6] = vtr(vp_ + 5632); SBAR(); C1 = MFMA32(kf[5], qr[2], C1); sacc += P1[6]; sacc += P1[7]; sacc += P1[8]; sacc += P1[9]; pw2[2] = F3_PK(P1, 4); pw2[3] = F3_PK(P1, 6); PIN(pw2); PIN(sacc); SBAR(); \
    vlo[3] = vtr(vp_ + 6144); vhi[3] = vtr(vp_ + 7168); SBAR(); C0 = MFMA32(kf[6], qr[3], C0); sacc += P1[10]; sacc += P1[11]; sacc += P1[12]; sacc += P1[13]; pw3[0] = F3_PK(P1, 8); pw3[1] = F3_PK(P1, 10); PIN(pw3); PIN(sacc); SBAR(); \
    vlo[7] = vtr(vp_ + 6656); vhi[7] = vtr(vp_ + 7680); SBAR(); C1 = MFMA32(kf[7], qr[3], C1); sacc += P1[14]; sacc += P1[15]; pw3[2] = F3_PK(P1, 12); pw3[3] = F3_PK(P1, 14); PIN(pw3); PIN(sacc); SBAR(); \
    l_reg += sacc; \
    dma.issue(min((T) + 3, nt - 1), lds + (((T) + 3) % 5) * L::TILE, wid); \
    _Pragma("unroll") for (int r = 0; r < 16; ++r) { C0[r] -= mhat; C1[r] -= mhat; } \
    { const float rm = rowmax3(C0, C1); resc = false; \
      if (__builtin_expect(__any(rm > F3_THR), 0)) { const float dl = __builtin_fmaxf(rm, 0.f); mhat += dl; const float f_ = __builtin_amdgcn_exp2f(-dl); l_reg *= f_; { const int t2_ = opaque_tid(); if ((t2_ & 63) < 32) ((LAS float*)(lds + L::SCR_OFF))[(t2_ >> 6) * 64 + (t2_ & 63)] = f_; } resc = true; \
        _Pragma("unroll") for (int r = 0; r < 16; ++r) { C0[r] -= dl; C1[r] -= dl; negm[r] -= dl; negm1[r] -= dl; } PIN(negm); PIN(negm1); } } \
    SBAR(); \
    o[0] = MFMA32(F3_PAF(0), F3_VF(0), o[0]); C0[0] = F3_EX(C0[0]); C0[1] = F3_EX(C0[1]); C0[2] = F3_EX(C0[2]); C0[3] = F3_EX(C0[3]); PIN(C0); SBAR(); \
    o[1] = MFMA32(F3_PAF(0), F3_VF(4), o[1]); C0[4] = F3_EX(C0[4]); C0[5] = F3_EX(C0[5]); C0[6] = F3_EX(C0[6]); C0[7] = F3_EX(C0[7]); PIN(C0); SBAR(); \
    F3_KLOAD2(kn_, 0); SBAR(); o[0] = MFMA32(F3_PAF(1), F3_VF(1), o[0]); C0[8] = F3_EX(C0[8]); C0[9] = F3_EX(C0[9]); C0[10] = F3_EX(C0[10]); C0[11] = F3_EX(C0[11]); PIN(C0); SBAR(); \
    F3_KLOAD2(kn_, 1); SBAR(); o[1] = MFMA32(F3_PAF(1), F3_VF(5), o[1]); C0[12] = F3_EX(C0[12]); C0[13] = F3_EX(C0[13]); C0[14] = F3_EX(C0[14]); C0[15] = F3_EX(C0[15]); PIN(C0); SBAR(); \
    F3_KLOAD2(kn_, 2); SBAR(); o[0] = MFMA32(F3_PAF(2), F3_VF(2), o[0]); C1[0] = F3_EX(C1[0]); C1[1] = F3_EX(C1[1]); C1[2] = F3_EX(C1[2]); C1[3] = F3_EX(C1[3]); PIN(C1); SBAR(); \
    F3_KLOAD2(kn_, 3); SBAR(); o[1] = MFMA32(F3_PAF(2), F3_VF(6), o[1]); C1[4] = F3_EX(C1[4]); C1[5] = F3_EX(C1[5]); C1[6] = F3_EX(C1[6]); C1[7] = F3_EX(C1[7]); PIN(C1); SBAR(); \
    o[0] = MFMA32(F3_PAF(3), F3_VF(3), o[0]); C1[8] = F3_EX(C1[8]); C1[9] = F3_EX(C1[9]); C1[10] = F3_EX(C1[10]); C1[11] = F3_EX(C1[11]); PIN(C1); SBAR(); \
    o[1] = MFMA32(F3_PAF(3), F3_VF(7), o[1]); C1[12] = F3_EX(C1[12]); C1[13] = F3_EX(C1[13]); C1[14] = F3_EX(C1[14]); C1[15] = F3_EX(C1[15]); PIN(C1); SBAR(); \
    } while (0)
#pragma unroll 1
    for (int t = 1; t < src.n_lat; t += 2) {
        F3_STEPL(pB0, pB1, pA0, pA1, t); F3_WAITB1(); F3_RESC();
        F3_STEPL(pA0, pA1, pB0, pB1, t + 1); F3_WAITB1(); F3_RESC();
    }
#pragma unroll 1
    for (int t = src.n_lat; t < nt; t += 2) {
        F3_STEPC(pB0, pB1, pA0, pA1, t); F3_WAITB1(); F3_RESC();
        F3_STEPC(pA0, pA1, pB0, pB1, t + 1); F3_WAITB1(); F3_RESC();
    }
    { float sacc = pA0[0] + pA0[1];
      _Pragma("unroll") for (int r = 2; r < 16; ++r) sacc += pA0[r];
      _Pragma("unroll") for (int r = 0; r < 16; ++r) sacc += pA1[r];
      l_reg += sacc;
      pw0 = (u32x4){F3_PK(pA0, 0), F3_PK(pA0, 2), F3_PK(pA0, 4), F3_PK(pA0, 6)}; pw1 = (u32x4){F3_PK(pA0, 8), F3_PK(pA0, 10), F3_PK(pA0, 12), F3_PK(pA0, 14)};
      pw2 = (u32x4){F3_PK(pA1, 0), F3_PK(pA1, 2), F3_PK(pA1, 4), F3_PK(pA1, 6)}; pw3 = (u32x4){F3_PK(pA1, 8), F3_PK(pA1, 10), F3_PK(pA1, 12), F3_PK(pA1, 14)};
      const LAS unsigned char* vp_ = vb0 + ((nt - 1) % 5) * L::TILE;
      { const s16x4 l_ = vtr(vp_ + 0), h_ = vtr(vp_ + 1024); const bf16x8 vf_ = {l_[0], l_[1], l_[2], l_[3], h_[0], h_[1], h_[2], h_[3]}; o[0] = MFMA32(F3_PAF(0), vf_, o[0]); }
      { const s16x4 l_ = vtr(vp_ + 2048), h_ = vtr(vp_ + 3072); const bf16x8 vf_ = {l_[0], l_[1], l_[2], l_[3], h_[0], h_[1], h_[2], h_[3]}; o[0] = MFMA32(F3_PAF(1), vf_, o[0]); }
      { const s16x4 l_ = vtr(vp_ + 4096), h_ = vtr(vp_ + 5120); const bf16x8 vf_ = {l_[0], l_[1], l_[2], l_[3], h_[0], h_[1], h_[2], h_[3]}; o[0] = MFMA32(F3_PAF(2), vf_, o[0]); }
      { const s16x4 l_ = vtr(vp_ + 6144), h_ = vtr(vp_ + 7168); const bf16x8 vf_ = {l_[0], l_[1], l_[2], l_[3], h_[0], h_[1], h_[2], h_[3]}; o[0] = MFMA32(F3_PAF(3), vf_, o[0]); }
      { const s16x4 l_ = vtr(vp_ + 512), h_ = vtr(vp_ + 1536); const bf16x8 vf_ = {l_[0], l_[1], l_[2], l_[3], h_[0], h_[1], h_[2], h_[3]}; o[1] = MFMA32(F3_PAF(0), vf_, o[1]); }
      { const s16x4 l_ = vtr(vp_ + 2560), h_ = vtr(vp_ + 3584); const bf16x8 vf_ = {l_[0], l_[1], l_[2], l_[3], h_[0], h_[1], h_[2], h_[3]}; o[1] = MFMA32(F3_PAF(1), vf_, o[1]); }
      { const s16x4 l_ = vtr(vp_ + 4608), h_ = vtr(vp_ + 5632); const bf16x8 vf_ = {l_[0], l_[1], l_[2], l_[3], h_[0], h_[1], h_[2], h_[3]}; o[1] = MFMA32(F3_PAF(2), vf_, o[1]); }
      { const s16x4 l_ = vtr(vp_ + 6656), h_ = vtr(vp_ + 7680); const bf16x8 vf_ = {l_[0], l_[1], l_[2], l_[3], h_[0], h_[1], h_[2], h_[3]}; o[1] = MFMA32(F3_PAF(3), vf_, o[1]); }
    }
    l_reg = half_swap_add(l_reg);
    asm volatile("s_waitcnt vmcnt(0) lgkmcnt(0)\n\ts_barrier" ::: "memory");
    l_out = l_reg;
#undef F3_WAITB2
#undef F3_WAITB1
#undef F3_KLOAD2
#undef F3_EX
#undef F3_PK
#undef F3_PAF
#undef F3_VF
#undef F3_RESC
#undef F3_STEP
#undef NA_BIAS
#undef F3_STEPL
#undef F3_STEPC
}
#undef PIN
#undef MFMA32
#undef MX3
}
namespace att {
__device__ __forceinline__ void scale_q(bf16x8& q, float c) {
    const u32x4 w = __builtin_bit_cast(u32x4, q); u32x4 x;
    x.x = cvtpk(bf_lo(w.x) * c, bf_hi(w.x) * c); x.y = cvtpk(bf_lo(w.y) * c, bf_hi(w.y) * c); x.z = cvtpk(bf_lo(w.z) * c, bf_hi(w.z) * c); x.w = cvtpk(bf_lo(w.w) * c, bf_hi(w.w) * c);
    q = __builtin_bit_cast(bf16x8, x);
}
template <int ABL = 0>
__device__ __forceinline__ void diff_unit(const Params& P, LAS unsigned char* lds, int b, int h, int qb, bool isctx) {
    typedef LayE<64, 128> L;
    const bf16_t* QKV0 = (const bf16_t*)(P.ws + WS_BIG); bf16_t* ATT = (bf16_t*)(P.ws + WS_ATT);
    f32x16 o[4]; float rl[16];
#pragma unroll 1
    for (int map = 0; map < 2; ++map) {
        float l_reg = 0.f;
        {   const int tid = opaque_tid(), wid = tid >> 6, lane = tid & 63, r32 = lane & 31, hi = lane >> 5;
            const int qrow0 = isctx ? M_LAT + b * 256 + wid * 32 : b * 4096 + qb * 256 + wid * 32;
            GAS const bf16_t* QKV = (GAS const bf16_t*)QKV0; asm volatile("" : "+s"(QKV));
            KVSrc src; src.k0 = QKV + 512 + h * 128 + map * 64; src.ldk0 = EVEN_IN; src.k1 = nullptr; src.ldk1 = 0; src.v = QKV + 1024 + h * 128; src.ldv = EVEN_IN;
            src.row_lat0 = b * 4096; src.n_lat = isctx ? 0 : 64; src.row_ctx0 = M_LAT + b * 256;
            bf16x8 qr[4]; load_q<64>(qr, QKV + (size_t)(qrow0 + r32) * EVEN_IN + h * 128 + map * 64, hi);
#pragma unroll
            for (int i_ = 0; i_ < 4; ++i_) scale_q(qr[i_], 0.125f * LOG2E);
#pragma unroll
            for (int d = 0; d < 4; ++d) o[d] = (f32x16){};
            flash3_diff(lds, src, src.n_lat + 4, qr, 0.125f * LOG2E, o, l_reg); }
        {   const int tid = opaque_tid(), wid = tid >> 6, lane = tid & 63, r32 = lane & 31, hi = lane >> 5;
            LAS float* scr = (LAS float*)(lds + L::SCR_OFF) + wid * 64;
            row_recips(l_reg, scr, r32, hi, rl);
            if (map == 0) {
                unsigned* stash = (unsigned*)(P.ws + WS_RET) + ((size_t)blockIdx.x * 8 + wid) * 2048 + lane;
#pragma unroll
                for (int d = 0; d < 4; ++d)
#pragma unroll
                    for (int r = 0; r < 8; ++r) stash[(d * 8 + r) * 64] = cvtpk(o[d][2 * r] * rl[2 * r], o[d][2 * r + 1] * rl[2 * r + 1]);
            } }
    }
    const int tid = opaque_tid(), wid = tid >> 6, lane = tid & 63, r32 = lane & 31, hi = lane >> 5;
    const float lam = ((const float*)(P.ws + WS_MISC))[0];
    const int qrow0 = isctx ? M_LAT + b * 256 + wid * 32 : b * 4096 + qb * 256 + wid * 32;
    const unsigned* stash_r = (const unsigned*)(P.ws + WS_RET) + ((size_t)blockIdx.x * 8 + wid) * 2048 + lane;
    bf16_t* att_e = ATT + (size_t)qrow0 * 1024 + h * 128;
    LAS unsigned char* wst = lds + wid * (32 * OROW<128>);
#pragma unroll
    for (int r = 0; r < 16; ++r) {
#pragma unroll
        for (int d = 0; d < 4; ++d) { const unsigned w = stash_r[(d * 8 + (r >> 1)) * 64]; const float o1 = (r & 1) ? bf_hi(w) : bf_lo(w); o[d][r] = o1 - lam * (o[d][r] * rl[r]); }
    }
    { float one[16];
#pragma unroll
      for (int r = 0; r < 16; ++r) one[r] = 1.0f;
      stage_o<128>(wst, o, one, r32, hi); }
    { const float* subln = P.in[I_SUBLN];
      const int ch = lane & 15;
      const f32x4 g0 = *(const f32x4*)(subln + ch * 8), g1 = *(const f32x4*)(subln + ch * 8 + 4);
#pragma unroll
      for (int i = 0; i < 8; ++i) {
          const int row = i * 4 + (lane >> 4);
          const u32x4 v = *(const LAS u32x4*)(wst + row * OROW<128> + ch * 16);
          float x[8] = {bf_lo(v.x), bf_hi(v.x), bf_lo(v.y), bf_hi(v.y), bf_lo(v.z), bf_hi(v.z), bf_lo(v.w), bf_hi(v.w)};
          float ss = 0.f;
#pragma unroll
          for (int j = 0; j < 8; ++j) ss += x[j] * x[j];
          ss += xshfl<1>(ss); ss += xshfl<2>(ss); ss += xshfl<4>(ss); ss += xshfl<8>(ss);
          const float rs = rsqrtf(ss * (1.0f / 128.0f) + RMS_EPS) * 0.8f;
          u32x4 w; w.x = cvtpk(x[0] * rs * g0[0], x[1] * rs * g0[1]); w.y = cvtpk(x[2] * rs * g0[2], x[3] * rs * g0[3]);
          w.z = cvtpk(x[4] * rs * g1[0], x[5] * rs * g1[1]); w.w = cvtpk(x[6] * rs * g1[2], x[7] * rs * g1[3]);
          *(u32x4*)(att_e + (size_t)row * 1024 + ch * 8) = w;
      } }
    __syncthreads();
}
__device__ __forceinline__ void na_unit(const Params& P, LAS unsigned char* lds, int b, int h, int g4, bool isctx) {
    typedef LayD<64, 64> L; typedef LayE<64, 64> LE;
    const int tid = opaque_tid(), wid = tid >> 6, lane = tid & 63, r32 = lane & 31, hi = lane >> 5;
    const bf16_t* QKV = (const bf16_t*)(P.ws + WS_BIG);
    LAS float* tab = (LAS float*)(lds + (isctx ? L::TAB_OFF : LE::TAB_OFF));
    KVSrc src; src.k0 = QKV + 2048 + h * 64; src.ldk0 = EVEN_IN; src.k1 = nullptr; src.ldk1 = 0; src.v = QKV + 2560 + h * 64; src.ldv = EVEN_IN;
    src.row_ctx0 = M_LAT + b * 256;
    NaWave nw{}; int qrow0;
    if (isctx) { src.row_lat0 = 0; src.n_lat = 0; qrow0 = M_LAT + b * 256 + wid * 32; }
    else {
        const int r0 = 4 * g4, rq = r0 + (wid >> 1), ch = wid & 1;
        const int kr_first = min(max(r0 - 4, 0), 56), kr_last = min(max(r0 + 3 - 4, 0), 56) + 7;
        const int rs_w = min(max(rq - 4, 0), 56);
        src.row_lat0 = b * 4096 + kr_first * 64; src.n_lat = (kr_last - kr_first + 1) | 1;
        nw.active_lo = rs_w - kr_first; nw.active_hi = rs_w + 7 - kr_first; nw.dr0 = kr_first - rq + 7;
        nw.c = 32 * ch + r32; nw.cs = min(max(nw.c - 8, 0), 48);
        qrow0 = b * 4096 + rq * 64 + 32 * ch;
        const float* rpb = P.in[I_RPB] + (size_t)h * 15 * 31;
        for (int i = tid; i < 15 * 31; i += NTHREADS) tab[i] = rpb[i] * LOG2E;
    }
    bf16x8 qr[4]; load_q<64>(qr, QKV + (size_t)(qrow0 + r32) * EVEN_IN + 1536 + h * 64, hi);
    f32x16 o[2]; o[0] = (f32x16){}; o[1] = (f32x16){};
    float m_reg = -1e30f, l_reg = 0.f;
    if (isctx) flash_loop<64, 64, 0>(lds, src, 4, qr, 0.125f * LOG2E, o, m_reg, l_reg, nw);
    else {
#pragma unroll
        for (int i_ = 0; i_ < 4; ++i_) scale_q(qr[i_], 0.125f * LOG2E);
        flash3_na(lds, src, src.n_lat + 4, qr, 1.0f, o, l_reg, (const LAS float*)tab, nw);
    }
    {
        const int tid2 = opaque_tid(), wid2 = tid2 >> 6, lane2 = tid2 & 63, r32b = lane2 & 31, hib = lane2 >> 5;
        const int qrow0b = isctx ? M_LAT + b * 256 + wid2 * 32 : b * 4096 + (4 * g4 + (wid2 >> 1)) * 64 + 32 * (wid2 & 1);
        LAS float* scr2 = (LAS float*)(lds + (isctx ? L::SCR_OFF : LE::SCR_OFF)) + wid2 * 64;
        float rl[16]; row_recips(l_reg, scr2, r32b, hib, rl);
        LAS unsigned char* wst = lds + wid2 * (32 * OROW<64>);
        stage_o<64>(wst, o, rl, r32b, hib);
        store_rows<64>(wst, (bf16_t*)(P.ws + WS_ATT), 1024, qrow0b, 512 + h * 64, lane2);
    }
    __syncthreads();
}
template <int ABL = 0>
__device__ __forceinline__ void mla_unit(const Params& P, LAS unsigned char* lds, int b, int h, int qb) {
    typedef LayE<96, 64> L;
    const int tid = opaque_tid(), wid = tid >> 6, lane = tid & 63, r32 = lane & 31, hi = lane >> 5;
    const bf16_t* QM = (const bf16_t*)(P.ws + WS_QM); const bf16_t* KVM = (const bf16_t*)(P.ws + WS_KVM); const bf16_t* KR = (const bf16_t*)(P.ws + WS_KR);
    bf16_t* ATT = (bf16_t*)(P.ws + WS_ATT);
    LAS float* scr = (LAS float*)(lds + L::SCR_OFF) + wid * 64;
    KVSrc src; src.k0 = KVM + h * 128; src.ldk0 = 1024; src.k1 = KR; src.ldk1 = 32; src.v = KVM + h * 128 + 64; src.ldv = 1024;
    src.row_lat0 = b * 4096; src.n_lat = 64; src.row_ctx0 = M_LAT + b * 256;
    const int qrow0 = b * 4096 + qb * 256 + wid * 32;
    NaWave nw{};
    bf16x8 qr[6]; load_q<96>(qr, QM + (size_t)(qrow0 + r32) * 768 + h * 96, hi);
#pragma unroll
    for (int i_ = 0; i_ < 6; ++i_) scale_q(qr[i_], 0.10206207261596575f * LOG2E);
    f32x16 o[2]; o[0] = (f32x16){}; o[1] = (f32x16){};
    float m_reg = -1e30f, l_reg = 0.f;
    flash3_mla(lds, src, 68, qr, 0.10206207261596575f * LOG2E, o, l_reg);
    float rl[16]; row_recips(l_reg, scr, r32, hi, rl);
    LAS unsigned char* wst = lds + wid * (32 * OROW<64>);
    stage_o<64>(wst, o, rl, r32, hi);
    store_rows<64>(wst, ATT, 1024, qrow0, h * 64, lane);
    __syncthreads();
}
}
namespace ret {
using att::tr_read; using att::v_st; using att::v_rd_base; using att::v_rd_off;
constexpr int PQ = 416, PK_ = 672, PV_ = 928, PG_ = 1440;
constexpr float KSCALE = 0.125f;
__device__ __forceinline__ size_t ret_off(int bh, int n, int dir) { return (((size_t)bh * 34 + n) * 2 + dir) * 8192; }
__device__ __forceinline__ int chunk_row0(int b, int n) { return (n < 32) ? b * 4096 + n * 128 : M_LAT + b * 256 + (n - 32) * 128; }

constexpr int R1_KF = 0, R1_KB = 16384, R1_V = 32768, R1_END = 65536;
__device__ __forceinline__ void r1_unit(const Params& P, LAS unsigned char* lds, int bh, int n) {
    const int tid = opaque_tid(), wid = tid >> 6, lane = tid & 63, r32 = lane & 31, hi = lane >> 5;
    const int b = bh >> 2, h = bh & 3;
    const bf16_t* PROJ = (const bf16_t*)(P.ws + WS_PROJ);
    const float* misc = (const float*)(P.ws + WS_MISC);
    const float lgf = misc[8 + h], lgb = misc[12 + h];
    const int row0 = chunk_row0(b, n);
#pragma unroll
    for (int i = 0; i < 2; ++i) {
        const int c = tid + 512 * i, j = c >> 3, part = c & 7;
        const u32x4 kv = *(const u32x4*)(PROJ + (size_t)(row0 + j) * ODD_IN + PK_ + h * 64 + part * 8);
        const float wf = KSCALE * __builtin_amdgcn_exp2f(lgf * (float)(127 - j)), wb = KSCALE * __builtin_amdgcn_exp2f(lgb * (float)j);
        u32x4 kf, kb;
        kf.x = cvtpk(bf_lo(kv.x) * wf, bf_hi(kv.x) * wf); kf.y = cvtpk(bf_lo(kv.y) * wf, bf_hi(kv.y) * wf); kf.z = cvtpk(bf_lo(kv.z) * wf, bf_hi(kv.z) * wf); kf.w = cvtpk(bf_lo(kv.w) * wf, bf_hi(kv.w) * wf);
        kb.x = cvtpk(bf_lo(kv.x) * wb, bf_hi(kv.x) * wb); kb.y = cvtpk(bf_lo(kv.y) * wb, bf_hi(kv.y) * wb); kb.z = cvtpk(bf_lo(kv.z) * wb, bf_hi(kv.z) * wb); kb.w = cvtpk(bf_lo(kv.w) * wb, bf_hi(kv.w) * wb);
        const int off = (j >> 6) * 8192 + v_st<64>(j & 63, part * 8);
        *(LAS u32x4*)(lds + R1_KF + off) = kf; *(LAS u32x4*)(lds + R1_KB + off) = kb;
    }
#pragma unroll
    for (int i = 0; i < 4; ++i) {
        const int c = tid + 512 * i, j = c >> 4, c8 = c & 15;
        const u32x4 vv = *(const u32x4*)(PROJ + (size_t)(row0 + j) * ODD_IN + PV_ + h * 128 + c8 * 8);
        *(LAS u32x4*)(lds + R1_V + (j >> 6) * 16384 + v_st<128>(j & 63, c8 * 8)) = vv;
    }
    __syncthreads();
    const int db = wid & 1, vb = wid >> 1;
    const unsigned base = (unsigned)(uintptr_t)lds + (unsigned)v_rd_base(lane);
    const unsigned kfa = base + R1_KF + db * 512, kba = base + R1_KB + db * 512, va = base + R1_V + vb * 512;
    f32x16 af = (f32x16){}, ab = (f32x16){};
#define R1_STEP(T, KS) do { \
        const s16x4 fl = tr_read<v_rd_off<64>(0, KS, 0) + T * 8192>(kfa), fh = tr_read<v_rd_off<64>(0, KS, 1) + T * 8192>(kfa); \
        const s16x4 bl = tr_read<v_rd_off<64>(0, KS, 0) + T * 8192>(kba), bh_ = tr_read<v_rd_off<64>(0, KS, 1) + T * 8192>(kba); \
        const s16x4 vl = tr_read<v_rd_off<128>(0, KS, 0) + T * 16384>(va), vh = tr_read<v_rd_off<128>(0, KS, 1) + T * 16384>(va); \
        asm volatile("s_waitcnt lgkmcnt(0)" ::: "memory"); SBAR(); \
        af = __builtin_amdgcn_mfma_f32_32x32x16_bf16(PK8(fl, fh), PK8(vl, vh), af, 0, 0, 0); \
        ab = __builtin_amdgcn_mfma_f32_32x32x16_bf16(PK8(bl, bh_), PK8(vl, vh), ab, 0, 0, 0); } while (0)
    R1_STEP(0, 0); R1_STEP(0, 1); R1_STEP(0, 2); R1_STEP(0, 3); R1_STEP(1, 0); R1_STEP(1, 1); R1_STEP(1, 2); R1_STEP(1, 3);
#undef R1_STEP
    float* U = (float*)(P.ws + WS_RET);
    float* uf = U + ret_off(bh, n, 0); float* ub = U + ret_off(bh, n, 1);
#pragma unroll
    for (int r = 0; r < 16; ++r) { const int d = 32 * db + crow(r, hi); __builtin_nontemporal_store(af[r], uf + d * 128 + 32 * vb + r32); __builtin_nontemporal_store(ab[r], ub + d * 128 + 32 * vb + r32); }
    __syncthreads();
}
__device__ __forceinline__ size_t sbf_off(int slot, int e) { return ((size_t)(8 * slot + (e >> 10)) * 2048) + (e & 1023); }
__device__ __forceinline__ void r2_scan(const Params& P) {
    const float* misc = (const float*)(P.ws + WS_MISC);
    const float* U = (const float*)(P.ws + WS_RET);
    bf16_t* SB = (bf16_t*)P.out;
    const int gt = blockIdx.x * NTHREADS + opaque_tid(), nth = gridDim.x * NTHREADS;
    for (int idx = gt; idx < 32 * 2 * 4096; idx += nth) {
        const int e = (idx & 4095) * 2, dir = (idx >> 12) & 1, bh = idx >> 13, h = bh & 3;
        const float gC = __builtin_amdgcn_exp2f(128.0f * misc[8 + dir * 4 + h]);
        const float* base = U + ret_off(bh, 0, dir) + e;
        f32x2 u[34];
#pragma unroll
        for (int n = 0; n < 34; ++n) u[n] = __builtin_nontemporal_load((const f32x2*)(base + (size_t)n * 16384));
        if (dir == 0) {
            f32x2 carry = gC * u[32] + u[33];
#pragma unroll
            for (int n = 0; n < 32; ++n) { __builtin_nontemporal_store(cvtpk(carry[0], carry[1]), (unsigned*)(SB + sbf_off((bh * 32 + n) * 2 + dir, e))); carry = gC * carry + u[n]; }
        } else {
            f32x2 carry = u[32] + gC * u[33];
#pragma unroll
            for (int n = 31; n >= 0; --n) { __builtin_nontemporal_store(cvtpk(carry[0], carry[1]), (unsigned*)(SB + sbf_off((bh * 32 + n) * 2 + dir, e))); carry = gC * carry + u[n]; }
        }
    }
}
constexpr int R3_K = 0, R3_KB = 64 * 144, R3_V = 2 * R3_KB  , R3_SF = R3_V + 32768, R3_SB = R3_SF + 16384, R3_RED = R3_SB + 16384, R3_END = R3_RED + 1024;
__device__ __forceinline__ void r3_unit(const Params& P, LAS unsigned char* lds, int bh, int n) {
    const int tid = opaque_tid(), wid = tid >> 6, lane = tid & 63, r32 = lane & 31, hi = lane >> 5;
    const int b = bh >> 2, h = bh & 3;
    const bf16_t* PROJ = (const bf16_t*)(P.ws + WS_PROJ); bf16_t* ATT = (bf16_t*)(P.ws + WS_ATT);
    const float* misc = (const float*)(P.ws + WS_MISC);
    const float lgf = misc[8 + h], lgb = misc[12 + h];
    const int row0 = b * 4096 + n * 128;
#pragma unroll
    for (int i = 0; i < 2; ++i) { const int c = tid + 512 * i, j = c >> 3, part = c & 7;
        *(LAS u32x4*)(lds + R3_K + (j >> 6) * R3_KB + (j & 63) * 144 + part * 16) = *(const u32x4*)(PROJ + (size_t)(row0 + j) * ODD_IN + PK_ + h * 64 + part * 8); }
#pragma unroll
    for (int i = 0; i < 4; ++i) { const int c = tid + 512 * i, j = c >> 4, c8 = c & 15;
        *(LAS u32x4*)(lds + R3_V + (j >> 6) * 16384 + v_st<128>(j & 63, c8 * 8)) = *(const u32x4*)(PROJ + (size_t)(row0 + j) * ODD_IN + PV_ + h * 128 + c8 * 8); }
    const bf16_t* SB = (const bf16_t*)P.out;
#pragma unroll
    for (int dir = 0; dir < 2; ++dir) {
#pragma unroll
        for (int i = 0; i < 2; ++i) { const int c = tid + 512 * i, d = c >> 4, c8 = c & 15;
            const u32x4 w = __builtin_nontemporal_load((const u32x4*)(SB + sbf_off((bh * 32 + n) * 2 + dir, d * 128 + c8 * 8)));
            *(LAS u32x4*)(lds + (dir ? R3_SB : R3_SF) + v_st<128>(d, c8 * 8)) = w; } }
    __syncthreads();
    const int qb = wid & 3, dvh = wid >> 2, ipos = 32 * qb + r32;
    bf16x8 qr[4]; att::load_q<64>(qr, PROJ + (size_t)(row0 + ipos) * ODD_IN + PQ + h * 64, hi);
    f32x16 o[2]; o[0] = (f32x16){}; o[1] = (f32x16){};
    const unsigned vbase = (unsigned)(uintptr_t)lds + (unsigned)v_rd_base(lane) + dvh * 1024;
#pragma unroll
    for (int T = 0; T < 2; ++T) {
        f32x16 p0, p1; att::qkt<64>(p0, p1, lds + R3_K + T * R3_KB, qr, r32, hi);
#pragma unroll
        for (int r = 0; r < 16; ++r) {
            const int j0 = 64 * T + crow(r, hi), j1 = j0 + 32;
            const float w0 = (j0 <= ipos) ? __builtin_amdgcn_exp2f(lgf * (float)(ipos - j0)) : __builtin_amdgcn_exp2f(lgb * (float)(j0 - ipos));
            const float w1 = (j1 <= ipos) ? __builtin_amdgcn_exp2f(lgf * (float)(ipos - j1)) : __builtin_amdgcn_exp2f(lgb * (float)(j1 - ipos));
            p0[r] *= KSCALE * w0; p1[r] *= KSCALE * w1;
        }
        bf16x8 pa0, pa1, pa2, pa3; att::pack_p(p0, p1, pa0, pa1, pa2, pa3);
        att::pv_one<128, 0>(o[0], vbase + R3_V + T * 16384, pa0, pa1, pa2, pa3); att::pv_one<128, 1>(o[1], vbase + R3_V + T * 16384, pa0, pa1, pa2, pa3);
    }
#pragma unroll
    for (int dir = 0; dir < 2; ++dir) {
        const float sc = dir ? __builtin_amdgcn_exp2f(lgb * (float)(128 - ipos)) : __builtin_amdgcn_exp2f(lgf * (float)(ipos + 1));
        bf16x8 pa[4];
#pragma unroll
        for (int s = 0; s < 4; ++s) { const u32x4 w = __builtin_bit_cast(u32x4, qr[s]); u32x4 x;
            x.x = cvtpk(bf_lo(w.x) * sc, bf_hi(w.x) * sc); x.y = cvtpk(bf_lo(w.y) * sc, bf_hi(w.y) * sc); x.z = cvtpk(bf_lo(w.z) * sc, bf_hi(w.z) * sc); x.w = cvtpk(bf_lo(w.w) * sc, bf_hi(w.w) * sc);
            pa[s] = __builtin_bit_cast(bf16x8, x); }
        const unsigned sb = vbase + (dir ? R3_SB : R3_SF);
        att::pv_one<128, 0>(o[0], sb, pa[0], pa[1], pa[2], pa[3]); att::pv_one<128, 1>(o[1], sb, pa[0], pa[1], pa[2], pa[3]);
    }
    __syncthreads();
    constexpr int TROW = 128 * 2 + 16;
    LAS unsigned char* tile = lds + R3_V;
#pragma unroll
    for (int r = 0; r < 16; ++r) { LAS unsigned char* rp = tile + (32 * qb + crow(r, hi)) * TROW + (64 * dvh + r32) * 2;
        *(LAS bf16_t*)rp = (bf16_t)f2bf(o[0][r]); *(LAS bf16_t*)(rp + 64) = (bf16_t)f2bf(o[1][r]); }
    __syncthreads();
#pragma unroll
    for (int i = 0; i < 4; ++i) {
        const int idx = i * 512 + tid, row = idx >> 4, ch = idx & 15;
        const u32x4 v = *(const LAS u32x4*)(tile + row * TROW + ch * 16);
        const u32x4 gv = *(const u32x4*)(PROJ + (size_t)(row0 + row) * ODD_IN + PG_ + h * 128 + ch * 8);
        float x[8] = {bf_lo(v.x), bf_hi(v.x), bf_lo(v.y), bf_hi(v.y), bf_lo(v.z), bf_hi(v.z), bf_lo(v.w), bf_hi(v.w)};
        const float g[8] = {bf_lo(gv.x), bf_hi(gv.x), bf_lo(gv.y), bf_hi(gv.y), bf_lo(gv.z), bf_hi(gv.z), bf_lo(gv.w), bf_hi(gv.w)};
        float ss = 0.f;
#pragma unroll
        for (int j = 0; j < 8; ++j) ss += x[j] * x[j];
        ss += xshfl<1>(ss); ss += xshfl<2>(ss); ss += xshfl<4>(ss); ss += xshfl<8>(ss);
        const float rs = rsqrtf(ss * (1.0f / 128.0f) + RMS_EPS);
#pragma unroll
        for (int j = 0; j < 8; ++j) x[j] = x[j] * rs * silu_f(g[j]);
        u32x4 w; w.x = cvtpk(x[0], x[1]); w.y = cvtpk(x[2], x[3]); w.z = cvtpk(x[4], x[5]); w.w = cvtpk(x[6], x[7]);
        *(u32x4*)(ATT + (size_t)(row0 + row) * 1024 + 512 + h * 128 + ch * 8) = w;
    }
    __syncthreads();
}
}
__device__ __forceinline__ void phase_prologue(const Params& P, LAS unsigned char* lds) {
    const int tid = opaque_tid();
    constexpr int N_MODS = 192;
    for (int it = blockIdx.x; it < N_MODS + 2; it += gridDim.x) {
        if (it < N_MODS) mods_item(P, it, (LAS float*)lds, (LAS float*)(lds + 9 * 1024 * 4), tid);
        else if (it == N_MODS) tables_item(P, tid);
        else { u32x4* z = (u32x4*)((bf16_t*)(P.ws + WS_W_OIN) + (size_t)1952 * 1024); for (int i = tid; i < 96 * 1024 / 8; i += NTHREADS) z[i] = (u32x4){0u, 0u, 0u, 0u}; }
    }
    convert_weights(P, 0, true, (LAS float*)lds, tid);
}
__device__ __forceinline__ int xcd_unit(int c, int k) { const int x = c & 7, y = c >> 3; return 256 * k + (((2 * x + (y >> 4)) << 4) | (y & 15)); }
__device__ __forceinline__ void phase_attn_even(const Params& P, LAS unsigned char* lds, int part = 3) {
    constexpr int N_DIFF = 512, N_NA = 1024, N_DIFFC = 32, N_NAC = 64, N_ALL = N_DIFF + N_NA + N_DIFFC + N_NAC;
    const bool remap = (gridDim.x == 256);
    for (int k = 0, u0 = blockIdx.x; u0 < N_ALL; ++k, u0 += gridDim.x) {
        if (u0 < N_DIFF) { if (part & 1) { const int u = remap ? xcd_unit(blockIdx.x, k) : u0; att::diff_unit(P, lds, u >> 6, (u >> 4) & 3, u & 15, false); } }
        else if (u0 < N_DIFF + N_NA) { if (part & 2) { const int r = remap ? xcd_unit(blockIdx.x, k - 2) : u0 - N_DIFF; att::na_unit(P, lds, r >> 7, (r >> 4) & 7, r & 15, false); } }
        else if (u0 < N_DIFF + N_NA + N_DIFFC) { const int r = u0 - N_DIFF - N_NA; att::diff_unit(P, lds, r >> 2, r & 3, 0, true); }
        else { const int r = u0 - N_DIFF - N_NA - N_DIFFC; att::na_unit(P, lds, r >> 3, r & 7, 0, true); }
    }
}
#ifndef ABL_MASK
#define ABL_MASK 0
#endif
#ifndef REPEAT_MASK
#define REPEAT_MASK 0u
#endif
enum { K_PRO = 0, K_NORM1, K_GEMM, K_ATTN_EVEN, K_NORM2, K_TOPK, K_R1, K_MLA, K_R3, K_FINAL };
enum { J_EVEN_IN = 0, J_OUT0, J_UP0, J_DOWN0, J_ODD_IN, J_UPQ, J_UPKV, J_OUT1, J_UP1, J_DOWN1 };
constexpr int NSTEPS = 22;
__device__ __forceinline__ void step_desc(int step, int& kind, int& arg, bool& sync) {
    sync = true;
    switch (step) {
        case 0: kind = K_PRO; arg = 0; break;
        case 1: kind = K_NORM1; arg = 0; break;
        case 2: kind = K_GEMM; arg = J_EVEN_IN; break;
        case 3: kind = K_ATTN_EVEN; arg = 0; break;
        case 4: kind = K_GEMM; arg = J_OUT0; break;
        case 5: kind = K_NORM2; arg = 0; break;
        case 6: kind = K_TOPK; arg = 0; break;
        case 7: kind = K_GEMM; arg = J_UP0; break;
        case 8: kind = K_GEMM; arg = J_DOWN0; break;
        case 9: kind = K_NORM1; arg = 1; break;
        case 10: kind = K_GEMM; arg = J_ODD_IN; break;
        case 11: kind = K_GEMM; arg = J_UPQ; sync = false; break;
        case 12: kind = K_GEMM; arg = J_UPKV; sync = false; break;
        case 13: kind = K_R1; arg = 0; break;
        case 14: kind = K_MLA; arg = 0; break;
        case 15: kind = K_R3; arg = 0; break;
        case 16: kind = K_GEMM; arg = J_OUT1; break;
        case 17: kind = K_NORM2; arg = 1; break;
        case 18: kind = K_TOPK; arg = 1; break;
        case 19: kind = K_GEMM; arg = J_UP1; break;
        case 20: kind = K_GEMM; arg = J_DOWN1; break;
        default: kind = K_FINAL; arg = 0; break;
    }
}
__device__ __forceinline__ void gemm_job(const Params& P, int job, pg8::Gemm& g, pg8::Sched& S, pg8::Epi& E) {
    unsigned char* ws = P.ws;
    g.lda = 1024; g.ldb = 1024; g.K = 1024; E.layer = 0; E.slots = 4352; E.nNe = 1;
    switch (job) {
        case J_EVEN_IN: g.A = (const bf16_t*)(ws + WS_H); g.Bt = (const bf16_t*)(ws + WS_W_EIN); S.init(1, M_ALL / 256, 12); E.mode = pg8::EPI_EVEN_IN; break;
        case J_OUT0: g.A = (const bf16_t*)(ws + WS_ATT); g.Bt = (const bf16_t*)(ws + WS_W_EOUT); S.init(1, M_ALL / 256, 4); E.mode = pg8::EPI_OUT; break;
        case J_UP0: g.A = (const bf16_t*)(ws + WS_H); g.Bt = (const bf16_t*)(ws + WS_W13); S.init(16, 17, 8); E.mode = pg8::EPI_MOE_UP; E.nNe = 8; break;
        case J_DOWN0: g.A = (const bf16_t*)(ws + WS_HID); g.Bt = (const bf16_t*)(ws + WS_W2T); S.init(16, 17, 4); E.mode = pg8::EPI_MOE_DOWN; E.nNe = 4; break;
        case J_ODD_IN: g.A = (const bf16_t*)(ws + WS_H); g.Bt = (const bf16_t*)(ws + WS_W_OIN); S.init(1, M_ALL / 256, 8); E.mode = pg8::EPI_ODD_IN; E.layer = 1; break;
        case J_UPQ: g.A = (const bf16_t*)(ws + WS_PROJ); g.Bt = (const bf16_t*)(ws + WS_W_UQ); g.lda = ODD_IN; g.ldb = 256; g.K = 256; S.init(1, M_LAT / 256, 3); E.mode = pg8::EPI_UPQ; E.layer = 1; break;
        case J_UPKV: g.A = (const bf16_t*)(ws + WS_PROJ) + 256; g.Bt = (const bf16_t*)(ws + WS_W_UKV); g.lda = ODD_IN; g.ldb = 128; g.K = 128; S.init(1, M_ALL / 256, 4); E.mode = pg8::EPI_UPKV; E.layer = 1; break;
        case J_OUT1: g.A = (const bf16_t*)(ws + WS_ATT); g.Bt = (const bf16_t*)(ws + WS_W_OOUT); S.init(1, M_LAT / 256, 4);     E.mode = pg8::EPI_OUT; E.layer = 1; break;
        case J_UP1: g.A = (const bf16_t*)(ws + WS_H); g.Bt = (const bf16_t*)(ws + WS_W13); S.init(16, 16, 8); E.mode = pg8::EPI_MOE_UP; E.nNe = 8; E.layer = 1; E.slots = 4096; break;
        default: g.A = (const bf16_t*)(ws + WS_HID); g.Bt = (const bf16_t*)(ws + WS_W2T); S.init(16, 16, 4); E.mode = pg8::EPI_MOE_DOWN; E.nNe = 4; E.layer = 1; E.slots = 4096; break;
    }
}

__global__ void __launch_bounds__(NTHREADS, 2) mega(KArgs P0) {
    extern __shared__ __attribute__((aligned(16))) unsigned char smem_[];
    LAS unsigned char* lds = (LAS unsigned char*)smem_;
    cg::grid_group grid = cg::this_grid();
    volatile LAS unsigned* st = (volatile LAS unsigned*)(lds + LDS_CTL_OFF);
    if (threadIdx.x < 16) st[threadIdx.x] = 0u;
    if ((threadIdx.x & 63) == 0) ((volatile LAS int*)(uintptr_t)WAVE_TAB_LDS)[hw_wave_slot()] = (int)(threadIdx.x >> 6);
    if (threadIdx.x < 64) ((LAS unsigned*)(lds + att::PROF_LDS_OFF))[threadIdx.x] = 0u;
    __syncthreads();
    XcdBarrier xb = xcd_barrier_post((unsigned*)(P0.ws + WS_CTL), st);
    if (threadIdx.x < 25) ((const float**)(P0.ws + WS_PTRS))[threadIdx.x] = P0.in[threadIdx.x];
    grid.sync();
    {
        Params Q; Q.ws = (GAS unsigned char*)P0.ws; Q.out = (GAS float*)P0.out; asm volatile("" : "+s"(Q.ws), "+s"(Q.out)); Q.in = (const gin_t GAS*)(Q.ws + WS_PTRS);
        const int reps0 = (REPEAT_MASK & 1u) ? 2 : 1;
#pragma unroll 1
        for (int rep = 0; rep < reps0; ++rep) { phase_prologue(Q, lds); xcd_barrier(xb); }
    }
#pragma unroll 1
    for (int step = 1; step < NSTEPS - 1; ++step) {
        int kind, arg; bool sync; step_desc(step, kind, arg, sync);
        Params Q; Q.ws = (GAS unsigned char*)P0.ws; Q.out = (GAS float*)P0.out;
        asm volatile("" : "+s"(Q.ws), "+s"(Q.out));
        Q.in = (const gin_t GAS*)(Q.ws + WS_PTRS);
        const Params& P = Q;
        const int reps = ((REPEAT_MASK >> step) & 1u) ? 2 : 1;
#pragma unroll 1
        for (int rep = 0; rep < reps; ++rep) {
        if (kind == K_GEMM) { pg8::Gemm g; pg8::Sched S; pg8::Epi E; gemm_job(P, arg, g, S, E);
#ifdef GEMM_ABL
            if (rep == 0 && reps == 2) E.mode = 99;
#endif
            pg8::gemm_phase(lds, g, S, P, E); }
        else if (kind == K_NORM1) { phase_norm1(P, arg); if (arg == 1) convert_weights(P, 1, false, (LAS float*)lds, opaque_tid()); }
        else if (kind == K_ATTN_EVEN) {
#ifdef EVEN_PART
            phase_attn_even(P, lds, (rep == 0 && reps == 2) ? EVEN_PART : 3);
#else
            phase_attn_even(P, lds);
#endif
        }
        else if (kind == K_NORM2) phase_norm2(P, arg, lds);
        else if (kind == K_TOPK) { const int ng = arg ? 128 : 256, slots = arg ? 4096 : 4352; for (int gq = blockIdx.x; gq < ng; gq += gridDim.x) topk_item(P, gq, slots, lds); }
        else if (kind == K_R1) { for (int u = blockIdx.x; u < 32 * 34; u += gridDim.x) ret::r1_unit(P, lds, u / 34, u % 34); }
        else if (kind == K_MLA) { if (rep == 0) ret::r2_scan(P);
#if ABL_MASK != 0
            if (rep == 0 && reps == 2) { for (int k = 0; k < 4; ++k) { const int u = xcd_unit(blockIdx.x, k); att::mla_unit<ABL_MASK>(P, lds, u >> 7, (u >> 4) & 7, u & 15); } }
            else
#endif
            { if (gridDim.x == 256) { for (int k = 0; k < 4; ++k) { const int u = xcd_unit(blockIdx.x, k); att::mla_unit(P, lds, u >> 7, (u >> 4) & 7, u & 15); } }
              else for (int u = blockIdx.x; u < 1024; u += gridDim.x) att::mla_unit(P, lds, u >> 7, (u >> 4) & 7, u & 15); } }
        else { for (int u = blockIdx.x; u < 1024; u += gridDim.x) ret::r3_unit(P, lds, u >> 5, u & 31); }
        if (sync || rep + 1 < reps) xcd_barrier(xb);
        }
    }
    {   Params Q; Q.ws = (GAS unsigned char*)P0.ws; Q.out = (GAS float*)P0.out; asm volatile("" : "+s"(Q.ws), "+s"(Q.out)); Q.in = (const gin_t GAS*)(Q.ws + WS_PTRS);
        phase_final(Q); }
#if PROF_SEG >= 0
    {
        const int wid = __builtin_amdgcn_readfirstlane(opaque_tid() >> 6);
        const unsigned want = ((LAS unsigned*)(lds + att::PROF_LDS_OFF))[wid * 8 + (PROF_SEG & 7)] * (PROF_SEG >= 8 ? 0u : 1u);
        const unsigned long long t0 = __builtin_amdgcn_s_memtime();
        while ((unsigned long long)__builtin_amdgcn_s_memtime() - t0 < (unsigned long long)want) __builtin_amdgcn_s_sleep(8);
    }
#endif
}

extern "C" void kernel_launch(void* const* d_in, const int* in_sizes, int n_in, void* d_out, int out_size, void* d_ws, size_t ws_size, hipStream_t stream) {
    static int grid_blocks = 0;
    if (!grid_blocks) {
        int dev = 0, cus = 0, per_cu = 0;
        (void)hipGetDevice(&dev);
        (void)hipDeviceGetAttribute(&cus, hipDeviceAttributeMultiprocessorCount, dev);
        (void)hipFuncSetAttribute((const void*)mega, hipFuncAttributeMaxDynamicSharedMemorySize, LDS_BYTES);
        (void)hipOccupancyMaxActiveBlocksPerMultiprocessor(&per_cu, mega, NTHREADS, LDS_BYTES);
        if (per_cu < 1) { fprintf(stderr, "mega: occupancy query returned %d\n", per_cu); per_cu = 1; }
        grid_blocks = cus;
        if (ws_size < WS_END || n_in != 25) fprintf(stderr, "mega: ws_size %zu < %zu or n_in %d != 25\n", ws_size, (size_t)WS_END, n_in);
    }
    KArgs p{};
    for (int i = 0; i < 25; ++i) p.in[i] = (const float*)d_in[i];
    p.out = (float*)d_out; p.ws = (unsigned char*)d_ws; p.pad = 0;
    (void)hipMemsetAsync(d_ws, 0, 16384, stream);
    void* args[] = {&p};
    hipError_t e = hipLaunchCooperativeKernel((const void*)mega, dim3(grid_blocks), dim3(NTHREADS), args, LDS_BYTES, stream);
    if (e != hipSuccess) fprintf(stderr, "cooperative launch failed: %s (grid %d)\n", hipGetErrorString(e), grid_blocks);
}
```
